# Optimizing an MI355X kernel written in HIP

```python
import functools
import jax
import jax.numpy as jnp
from jax import lax
import numpy as np

D_MODEL = 1024
BATCH = 4
SEQ = 8192
DEPTH = 1
DEC_BATCH = 128
DEC_SEQ = 8
PAST_LEN = 16384
PAGE_SIZE = 128

MLA_HEADS = 8
MLA_NOPE = 64
ROPE_DIM = 32
MLA_V = 64
Q_RANK = 256
KV_RANK = 128
RW_HEADS = 8
RW_HEAD_DIM = 64
RW_DIM = RW_HEADS * RW_HEAD_DIM
D_WLORA = 64
D_ALORA = 64
D_GLORA = 128
RW_COLS = 3 * RW_DIM + D_WLORA + D_ALORA + D_GLORA
D_MIX = MLA_HEADS * MLA_V + RW_DIM
IN_COLS = Q_RANK + KV_RANK + ROPE_DIM + RW_COLS
D_FF = 2816
ROPE_BASE = 10000.0
Q_BLOCK = 128
SM_SCALE = (MLA_NOPE + ROPE_DIM) ** -0.5
ALPHA = (2 * DEPTH) ** 0.25
BETA = (8 * DEPTH) ** -0.25
NEG = -1e30
LN_EPS = 1e-5
RMS_EPS = 1e-6
GN_EPS = 64e-5

kernel_name = 'hybrid_mla_rwkv7_macaron_deepnorm_step'


def _layernorm(x, g, b):
    xf = x.astype(jnp.float32)
    mu = jnp.mean(xf, -1, keepdims=True)
    var = jnp.mean(jnp.square(xf - mu), -1, keepdims=True)
    return ((xf - mu) * lax.rsqrt(var + LN_EPS) * g + b).astype(x.dtype)


def _rmsnorm(x, g):
    xf = x.astype(jnp.float32)
    return (xf * lax.rsqrt(jnp.mean(jnp.square(xf), -1, keepdims=True) + RMS_EPS) * g).astype(x.dtype)


def _swiglu(x, w_gate, w_up, w_down):
    return (jax.nn.silu(x @ w_gate) * (x @ w_up)) @ w_down


def _rope_tables(pos):
    inv = ROPE_BASE ** (-jnp.arange(0, ROPE_DIM, 2, dtype=jnp.float32) / ROPE_DIM)
    ang = pos[:, None] * inv[None, :]
    return jnp.cos(ang), jnp.sin(ang)


def _rope(x, cos, sin):
    xf = x.astype(jnp.float32)
    x1, x2 = jnp.split(xf, 2, axis=-1)
    return jnp.concatenate([x1 * cos - x2 * sin, x1 * sin + x2 * cos], axis=-1).astype(x.dtype)


def _mla_scores(q_lat, q_rope, ckv, krope):
    return (jnp.einsum('bqhr,bkr->bhqk', q_lat, ckv)
            + jnp.einsum('bqhp,bkp->bhqk', q_rope, krope)) * SM_SCALE


def _prompt_attend(q_lat, q_rope, ckv, krope):
    B, S, H, R = q_lat.shape
    qb = min(Q_BLOCK, S)
    nb = S // qb
    ckv_f = ckv.astype(jnp.float32)
    kr_f = krope.astype(jnp.float32)
    ql = q_lat.astype(jnp.float32).reshape(B, nb, qb, H, R).transpose(1, 0, 2, 3, 4)
    qr = q_rope.astype(jnp.float32).reshape(B, nb, qb, H, ROPE_DIM).transpose(1, 0, 2, 3, 4)
    kpos = jnp.arange(S)

    def block(args):
        i, q_i, qr_i = args
        qpos = i * qb + jnp.arange(qb)
        s = _mla_scores(q_i, qr_i, ckv_f, kr_f)
        s = jnp.where((qpos[:, None] >= kpos[None, :])[None, None], s, NEG)
        p = jax.nn.softmax(s, axis=-1)
        return jnp.einsum('bhqk,bkr->bqhr', p, ckv_f)

    o = lax.map(block, (jnp.arange(nb), ql, qr))
    return o.transpose(1, 0, 2, 3, 4).reshape(B, S, H, R).astype(q_lat.dtype)


def _online_update(carry, s, vals):
    m, l, acc = carry
    m_new = jnp.maximum(m, jnp.max(s, axis=-1))
    corr = jnp.exp(m - m_new)
    p = jnp.exp(s - m_new[..., None])
    l = l * corr + jnp.sum(p, axis=-1)
    acc = acc * corr[..., None] + jnp.einsum('bhqk,bkr->bhqr', p, vals)
    return (m_new, l, acc)


def _sample_attend(q_lat, q_rope, ckv_new, kr_new, cache_ckv, cache_krope, page_table):
    B, Q, H, R = q_lat.shape
    qf = q_lat.astype(jnp.float32)
    qr = q_rope.astype(jnp.float32)
    init = (jnp.full((B, H, Q), NEG, jnp.float32), jnp.zeros((B, H, Q), jnp.float32),
            jnp.zeros((B, H, Q, R), jnp.float32))

    def body(carry, pages):
        ckv_b = cache_ckv[pages].astype(jnp.float32)
        kr_b = cache_krope[pages].astype(jnp.float32)
        return _online_update(carry, _mla_scores(qf, qr, ckv_b, kr_b), ckv_b), None

    carry, _ = lax.scan(body, init, page_table.T)
    cn = ckv_new.astype(jnp.float32)
    s = _mla_scores(qf, qr, cn, kr_new.astype(jnp.float32))
    s = jnp.where(jnp.tril(jnp.ones((Q, Q), bool))[None, None], s, NEG)
    m, l, acc = _online_update(carry, s, cn)
    return (acc / l[..., None]).transpose(0, 2, 1, 3).astype(q_lat.dtype)


def _rwkv7_recurrence(state0, r, decay, k, v, a, b):
    def step(S, inp):
        r_t, w_t, k_t, v_t, a_t, b_t = inp
        sa = jnp.einsum('bhvk,bhk->bhv', S, a_t)
        S = S * w_t[:, :, None, :] + sa[..., None] * b_t[:, :, None, :] + v_t[..., None] * k_t[:, :, None, :]
        return S, jnp.einsum('bhvk,bhk->bhv', S, r_t)

    xs = tuple(jnp.moveaxis(t, 1, 0) for t in (r, decay, k, v, a, b))
    S, ys = lax.scan(step, state0, xs)
    return S, jnp.moveaxis(ys, 0, 1)


def _token_mixer(x, pos, shift_buf, wkv0, attend, w_in, q_norm_g, w_uq, kv_norm_g, w_uk, w_uv,
                 shift_mu, w0, w_lora_up, a0, a_lora_up, g_lora_up, k_k, k_a, r_k, lnx_g, lnx_b, w_out):
    B, S, _ = x.shape
    proj = x @ w_in
    c_q, c_kv, k_rope, rw = jnp.split(proj, [Q_RANK, Q_RANK + KV_RANK, Q_RANK + KV_RANK + ROPE_DIM], axis=-1)
    q = jnp.einsum('bsc,chd->bshd', _rmsnorm(c_q, q_norm_g), w_uq)
    q_nope, q_rope = q[..., :MLA_NOPE], q[..., MLA_NOPE:]
    ckv = _rmsnorm(c_kv, kv_norm_g)
    cos, sin = _rope_tables(pos)
    q_rope = _rope(q_rope, cos[:, None], sin[:, None])
    k_rope = _rope(k_rope, cos, sin)
    q_lat = jnp.einsum('bshn,rhn->bshr', q_nope, w_uk)
    o_lat = attend(q_lat, q_rope, ckv, k_rope)
    y_mla = jnp.einsum('bshr,rhv->bshv', o_lat, w_uv).reshape(B, S, MLA_HEADS * MLA_V)
    prev = jnp.concatenate([shift_buf[:, None].astype(rw.dtype), rw[:, :-1]], axis=1)
    rws = (rw + (prev - rw) * shift_mu).astype(jnp.float32)
    r, k, v, dw, da, dg = jnp.split(rws, [RW_DIM, 2 * RW_DIM, 3 * RW_DIM, 3 * RW_DIM + D_WLORA,
                                          3 * RW_DIM + D_WLORA + D_ALORA], axis=-1)
    w = -jax.nn.softplus(-(w0 + jnp.tanh(dw) @ w_lora_up)) - 0.5
    decay = jnp.exp(-jnp.exp(w))
    a = jax.nn.sigmoid(a0 + da @ a_lora_up)
    g = jax.nn.sigmoid(dg) @ g_lora_up

    def heads(t):
        return t.reshape(B, S, RW_HEADS, RW_HEAD_DIM)

    kk = heads(k * k_k)
    kk = kk / jnp.maximum(jnp.sqrt(jnp.sum(jnp.square(kk), -1, keepdims=True)), 1e-12)
    k = k * (1.0 + (a - 1.0) * k_a)
    r_h, k_h, v_h, a_h = heads(r), heads(k), heads(v), heads(a)
    wkv, o = _rwkv7_recurrence(wkv0.astype(jnp.float32), r_h, heads(decay), k_h, v_h, -kk, kk * a_h)
    mu = jnp.mean(o, -1, keepdims=True)
    var = jnp.mean(jnp.square(o - mu), -1, keepdims=True)
    o = (o - mu) * lax.rsqrt(var + GN_EPS) * lnx_g.reshape(RW_HEADS, RW_HEAD_DIM) + lnx_b.reshape(RW_HEADS, RW_HEAD_DIM)
    o = o + jnp.sum(r_h * k_h * r_k, axis=-1, keepdims=True) * v_h
    y_rw = (o.reshape(B, S, RW_DIM) * g).astype(x.dtype)
    y = jnp.concatenate([y_mla, y_rw], axis=-1) @ w_out
    return y, ckv, k_rope, wkv, rw[:, -1]


def _layer(x, pos, shift_buf, wkv0, attend, lp, mp):
    x = _layernorm(ALPHA * x + 0.5 * _swiglu(x, lp['ffa_w_gate'], lp['ffa_w_up'], lp['ffa_w_down']),
                   lp['ln1_g'], lp['ln1_b'])
    m, ckv, kr, wkv, buf = _token_mixer(x, pos, shift_buf, wkv0, attend, **mp)
    x = _layernorm(ALPHA * x + m, lp['ln2_g'], lp['ln2_b'])
    x = _layernorm(ALPHA * x + 0.5 * _swiglu(x, lp['ffb_w_gate'], lp['ffb_w_up'], lp['ffb_w_down']),
                   lp['ln3_g'], lp['ln3_b'])
    return x, ckv, kr, wkv, buf


def setup_inputs(seed: int = 0) -> dict:
    key = jax.random.key(seed)
    ks = iter(jax.random.split(key, 48))
    f32 = jnp.float32

    def nrm(shape, scale):
        return jax.random.normal(next(ks), shape, f32) * scale

    def gain(shape):
        return 1.0 + nrm(shape, 0.05)

    def bias(shape):
        return nrm(shape, 0.02)

    L = DEPTH
    n_pages = PAST_LEN // PAGE_SIZE
    n_used = DEC_BATCH * n_pages
    n_phys = n_used + n_used // 4
    page_table = jax.random.permutation(next(ks), n_phys)[:n_used].reshape(DEC_BATCH, n_pages).astype(jnp.int32)
    return {
        'x_prompt': nrm((BATCH, SEQ, D_MODEL), 1.0),
        'x_sample': nrm((DEC_BATCH, DEC_SEQ, D_MODEL), 1.0),
        'cache_ckv': nrm((L, n_phys, PAGE_SIZE, KV_RANK), 1.0),
        'cache_krope': nrm((L, n_phys, PAGE_SIZE, ROPE_DIM), 1.0),
        'state_wkv': nrm((L, DEC_BATCH, RW_HEADS, RW_HEAD_DIM, RW_HEAD_DIM), 0.3),
        'state_shift': nrm((L, DEC_BATCH, RW_COLS), 1.0),
        'page_table': page_table,
        'ln1_g': gain((L, D_MODEL)),
        'ln1_b': bias((L, D_MODEL)),
        'ffa_w_gate': nrm((L, D_MODEL, D_FF), D_MODEL ** -0.5),
        'ffa_w_up': nrm((L, D_MODEL, D_FF), D_MODEL ** -0.5),
        'ffa_w_down': nrm((L, D_FF, D_MODEL), BETA * D_FF ** -0.5),
        'w_in': nrm((L, D_MODEL, IN_COLS), D_MODEL ** -0.5),
        'q_norm_g': gain((L, Q_RANK)),
        'w_uq': nrm((L, Q_RANK, MLA_HEADS, MLA_NOPE + ROPE_DIM), Q_RANK ** -0.5),
        'kv_norm_g': gain((L, KV_RANK)),
        'w_uk': nrm((L, KV_RANK, MLA_HEADS, MLA_NOPE), KV_RANK ** -0.5),
        'w_uv': nrm((L, KV_RANK, MLA_HEADS, MLA_V), KV_RANK ** -0.5),
        'shift_mu': jax.random.uniform(next(ks), (L, RW_COLS), f32),
        'w0': -1.0 + nrm((L, RW_DIM), 0.5),
        'w_lora_up': nrm((L, D_WLORA, RW_DIM), D_WLORA ** -0.5),
        'a0': nrm((L, RW_DIM), 0.1),
        'a_lora_up': nrm((L, D_ALORA, RW_DIM), D_ALORA ** -0.5),
        'g_lora_up': nrm((L, D_GLORA, RW_DIM), D_GLORA ** -0.5),
        'k_k': 0.85 + nrm((L, RW_DIM), 0.05),
        'k_a': 1.0 + nrm((L, RW_DIM), 0.05),
        'r_k': nrm((L, RW_HEADS, RW_HEAD_DIM), 0.1),
        'lnx_g': gain((L, RW_DIM)),
        'lnx_b': bias((L, RW_DIM)),
        'w_out': nrm((L, D_MIX, D_MODEL), BETA * D_MIX ** -0.5),
        'ln2_g': gain((L, D_MODEL)),
        'ln2_b': bias((L, D_MODEL)),
        'ffb_w_gate': nrm((L, D_MODEL, D_FF), D_MODEL ** -0.5),
        'ffb_w_up': nrm((L, D_MODEL, D_FF), D_MODEL ** -0.5),
        'ffb_w_down': nrm((L, D_FF, D_MODEL), BETA * D_FF ** -0.5),
        'ln3_g': gain((L, D_MODEL)),
        'ln3_b': bias((L, D_MODEL)),
    }


def reference(x_prompt, x_sample, cache_ckv, cache_krope, state_wkv, state_shift, page_table,
              ln1_g, ln1_b, ffa_w_gate, ffa_w_up, ffa_w_down, w_in, q_norm_g, w_uq, kv_norm_g, w_uk, w_uv,
              shift_mu, w0, w_lora_up, a0, a_lora_up, g_lora_up, k_k, k_a, r_k, lnx_g, lnx_b, w_out,
              ln2_g, ln2_b, ffb_w_gate, ffb_w_up, ffb_w_down, ln3_g, ln3_b):
    past_len = page_table.shape[1] * cache_ckv.shape[2]
    pos_p = jnp.arange(x_prompt.shape[1], dtype=jnp.float32)
    pos_s = jnp.arange(x_sample.shape[1], dtype=jnp.float32) + float(past_len)
    bp = x_prompt.shape[0]
    xp, xs = x_prompt, x_sample
    ckv_p, kr_p, wkv_p, sh_p = [], [], [], []
    ckv_s, kr_s, wkv_s, sh_s = [], [], [], []
    for l in range(DEPTH):
        lp = dict(ln1_g=ln1_g[l], ln1_b=ln1_b[l], ffa_w_gate=ffa_w_gate[l], ffa_w_up=ffa_w_up[l],
                  ffa_w_down=ffa_w_down[l], ln2_g=ln2_g[l], ln2_b=ln2_b[l], ffb_w_gate=ffb_w_gate[l],
                  ffb_w_up=ffb_w_up[l], ffb_w_down=ffb_w_down[l], ln3_g=ln3_g[l], ln3_b=ln3_b[l])
        mp = dict(w_in=w_in[l], q_norm_g=q_norm_g[l], w_uq=w_uq[l], kv_norm_g=kv_norm_g[l], w_uk=w_uk[l],
                  w_uv=w_uv[l], shift_mu=shift_mu[l], w0=w0[l], w_lora_up=w_lora_up[l], a0=a0[l],
                  a_lora_up=a_lora_up[l], g_lora_up=g_lora_up[l], k_k=k_k[l], k_a=k_a[l], r_k=r_k[l],
                  lnx_g=lnx_g[l], lnx_b=lnx_b[l], w_out=w_out[l])
        buf0 = jnp.zeros((bp, RW_COLS), xp.dtype)
        wkv0 = jnp.zeros((bp, RW_HEADS, RW_HEAD_DIM, RW_HEAD_DIM), jnp.float32)
        xp, c1, k1, s1, b1 = _layer(xp, pos_p, buf0, wkv0, _prompt_attend, lp, mp)
        attend_s = functools.partial(_sample_attend, cache_ckv=cache_ckv[l], cache_krope=cache_krope[l],
                                     page_table=page_table)
        xs, c2, k2, s2, b2 = _layer(xs, pos_s, state_shift[l], state_wkv[l], attend_s, lp, mp)
        ckv_p.append(c1); kr_p.append(k1); wkv_p.append(s1); sh_p.append(b1)
        ckv_s.append(c2); kr_s.append(k2); wkv_s.append(s2); sh_s.append(b2)
    return (xp, xs, jnp.stack(ckv_p), jnp.stack(kr_p), jnp.stack(wkv_p), jnp.stack(sh_p),
            jnp.stack(ckv_s), jnp.stack(kr_s), jnp.stack(wkv_s), jnp.stack(sh_s))
```

```cpp
#include <hip/hip_runtime.h>
#include <cstdio>
#include <cstdint>
namespace pg8 {
#define PG8_LAS __attribute__((address_space(3)))
typedef unsigned short bf16_t;
typedef short bf16x8 __attribute__((ext_vector_type(8)));
typedef float f32x4 __attribute__((ext_vector_type(4)));
typedef unsigned u32x4 __attribute__((ext_vector_type(4)));
constexpr int BM = 256, BK = 64, HALF = 128, HTB = HALF * BK * 2  , STAGE_BYTES = 8 * HTB, NXCD = 8, WGM = 8;

__host__ __device__ __forceinline__ int lds_byte(int r, int c) { const int st = (r >> 4) * 2 + (c >> 5), rr = r & 15, cc = c & 31, ob = rr * 64 + cc * 2; return st * 1024 + (ob ^ (((ob >> 9) & 1) << 5)); }
__host__ __device__ __forceinline__ void stage_rc(int b, int& R, int& C) { const int st = b / 1024, sb = b % 1024, swz = sb ^ (((sb >> 9) & 1) << 5); R = (st >> 1) * 16 + swz / 64; C = (st & 1) * 32 + (swz % 64) / 2; }
__host__ __device__ __forceinline__ int perm32(int rho) { const int n = rho >> 4, i = rho & 15; return 8 * (i >> 2) + 4 * n + (i & 3); }

struct Unit { int pm, pn; };
struct Gemm { const bf16_t* A; const bf16_t* Bt; int M, N, K; };

struct StaticOrder {
    int nM, nN, nwg, G, c;
    __host__ __device__ void init(int M, int N, int G_, int c_) { nM = M / BM; nN = N / BM; nwg = nM * nN; G = G_; c = c_; }
    __host__ __device__ bool next(int i, Unit& u) const {
        const long L = (long)i * G + c; if (L >= nwg) return false;
        int wgid = (int)L; { const int q = nwg / NXCD, r = nwg % NXCD, xcd = wgid % NXCD, off = wgid / NXCD; wgid = (xcd < r ? xcd * (q + 1) : r * (q + 1) + (xcd - r) * q) + off; }
        const int nig = WGM * nN, gid = wgid / nig, fm = gid * WGM, gsz = (nM - fm) < WGM ? (nM - fm) : WGM;
        u.pm = fm + ((wgid % nig) % gsz); u.pn = (wgid % nig) / gsz; return true;
    }
    __device__ __forceinline__ void a_ready(const Unit&) const {}
    __device__ __forceinline__ void done(const Unit&) const {}
};
__device__ __forceinline__ unsigned cvt_pk_bf16(float lo, float hi) { unsigned r; asm volatile("v_cvt_pk_bf16_f32 %0, %1, %2" : "=v"(r) : "v"(lo), "v"(hi)); return r; }
__device__ __forceinline__ float silu_mul(float g, float u) { const float e = __builtin_amdgcn_exp2f(-1.4426950408889634f * g); return g * __builtin_amdgcn_rcpf(1.0f + e) * u; }

struct EpiSwiGLU {
    static constexpr bool PERM = true, AFTER_DRAIN = false;
    bf16_t* O; int ldo;
    __device__ __forceinline__ void operator()(const f32x4 (&acc)[2][2][4][2], const Unit& u, int wr, int wc, int fr, int fq) const {
        const int row0 = u.pm * BM + wr * 64 + fr, col0 = u.pn * HALF + wc * 32 + 8 * fq;
#pragma unroll
        for (int ai = 0; ai < 2; ++ai)
#pragma unroll
            for (int m = 0; m < 4; ++m) {
                bf16_t* rowp = O + (size_t)(row0 + ai * HALF + m * 16) * ldo + col0;
                const f32x4 g0 = acc[ai][0][m][0], g1 = acc[ai][0][m][1], u0 = acc[ai][1][m][0], u1 = acc[ai][1][m][1];
                u32x4 w;
                w.x = cvt_pk_bf16(silu_mul(g0[0], u0[0]), silu_mul(g0[1], u0[1])); w.y = cvt_pk_bf16(silu_mul(g0[2], u0[2]), silu_mul(g0[3], u0[3]));
                w.z = cvt_pk_bf16(silu_mul(g1[0], u1[0]), silu_mul(g1[1], u1[1])); w.w = cvt_pk_bf16(silu_mul(g1[2], u1[2]), silu_mul(g1[3], u1[3]));
                *(u32x4*)rowp = w;
            }
    }
};
struct EpiResid {
    static constexpr bool PERM = false, AFTER_DRAIN = false;
    const float* base0; const float* base1; int split; float* Z; int ldc; float alpha, sc;
    __device__ __forceinline__ void operator()(const f32x4 (&acc)[2][2][4][2], const Unit& u, int wr, int wc, int fr, int fq) const {
        const int row0 = u.pm * BM + wr * 64 + fr, col0 = u.pn * BM + wc * 32 + 4 * fq;
        const float* bp = (u.pm * BM < split) ? base0 : base1 - (size_t)split * ldc;
#pragma unroll
        for (int ai = 0; ai < 2; ++ai)
#pragma unroll
            for (int m = 0; m < 4; ++m) {
                const size_t off = (size_t)(row0 + ai * HALF + m * 16) * ldc + col0;
#pragma unroll
                for (int bj = 0; bj < 2; ++bj)
#pragma unroll
                    for (int n = 0; n < 2; ++n) { const size_t o = off + bj * HALF + n * 16; const f32x4 b = *(const f32x4*)(bp + o); *(f32x4*)(Z + o) = b * alpha + acc[ai][bj][m][n] * sc; }
            }
    }
};
struct EpiF32 {
    static constexpr bool PERM = false, AFTER_DRAIN = false;
    float* O; int ldc;
    __device__ __forceinline__ void operator()(const f32x4 (&acc)[2][2][4][2], const Unit& u, int wr, int wc, int fr, int fq) const {
        const int row0 = u.pm * BM + wr * 64 + fr, col0 = u.pn * BM + wc * 32 + 4 * fq;
#pragma unroll
        for (int ai = 0; ai < 2; ++ai)
#pragma unroll
            for (int m = 0; m < 4; ++m) {
                const size_t off = (size_t)(row0 + ai * HALF + m * 16) * ldc + col0;
#pragma unroll
                for (int bj = 0; bj < 2; ++bj)
#pragma unroll
                    for (int n = 0; n < 2; ++n) *(f32x4*)(O + off + bj * HALF + n * 16) = acc[ai][bj][m][n];
            }
    }
};
struct EpiQ {
    static constexpr bool PERM = true, AFTER_DRAIN = false;
    bf16_t* Q; const float* cosT; const float* sinT; float qscale;
    __device__ __forceinline__ void operator()(const f32x4 (&acc)[2][2][4][2], const Unit& u, int wr, int wc, int fr, int fq) const {
        const int row0 = u.pm * BM + wr * 64 + fr;
        if (u.pn < 4) {
#pragma unroll
            for (int ai = 0; ai < 2; ++ai)
#pragma unroll
                for (int m = 0; m < 4; ++m) {
                    const int row = row0 + ai * HALF + m * 16;
#pragma unroll
                    for (int bj = 0; bj < 2; ++bj) {
                        bf16_t* p = Q + (size_t)row * 1280 + (2 * u.pn + bj) * 160 + wc * 32 + 8 * fq;
                        const f32x4 v0 = acc[ai][bj][m][0] * qscale, v1 = acc[ai][bj][m][1] * qscale;
                        u32x4 w; w.x = cvt_pk_bf16(v0[0], v0[1]); w.y = cvt_pk_bf16(v0[2], v0[3]); w.z = cvt_pk_bf16(v1[0], v1[1]); w.w = cvt_pk_bf16(v1[2], v1[3]);
                        *(u32x4*)p = w;
                    }
                }
        } else {
#pragma unroll
            for (int ai = 0; ai < 2; ++ai)
#pragma unroll
                for (int m = 0; m < 4; ++m) {
                    const int row = row0 + ai * HALF + m * 16;
                    const int tix = row < 32768 ? (row & 8191) : 8192 + ((row - 32768) & 7);
                    const f32x4 c = *(const f32x4*)(cosT + tix * 16 + 4 * fq), s = *(const f32x4*)(sinT + tix * 16 + 4 * fq);
#pragma unroll
                    for (int bj = 0; bj < 2; ++bj) {
                        bf16_t* p = Q + (size_t)row * 1280 + (4 * bj + wc) * 160 + 128 + 8 * fq;
                        const f32x4 v0 = acc[ai][bj][m][0], v1 = acc[ai][bj][m][1];
                        u32x4 w;
                        w.x = cvt_pk_bf16((v0[0] * c[0] - v0[1] * s[0]) * qscale, (v0[0] * s[0] + v0[1] * c[0]) * qscale);
                        w.y = cvt_pk_bf16((v0[2] * c[1] - v0[3] * s[1]) * qscale, (v0[2] * s[1] + v0[3] * c[1]) * qscale);
                        w.z = cvt_pk_bf16((v1[0] * c[2] - v1[1] * s[2]) * qscale, (v1[0] * s[2] + v1[1] * c[2]) * qscale);
                        w.w = cvt_pk_bf16((v1[2] * c[3] - v1[3] * s[3]) * qscale, (v1[2] * s[3] + v1[3] * c[3]) * qscale);
                        *(u32x4*)p = w;
                    }
                }
        }
    }
};
template <class Epi, class Sched, bool ALIGN_EPI = false, bool SP2 = false>
__device__ __forceinline__ void gemm_phase(PG8_LAS unsigned char* lds, const Gemm g, const Sched& S, const Epi& E) {
    const int tid = threadIdx.x, wid = __builtin_amdgcn_readfirstlane(tid >> 6), lane = tid & 63, wr = wid >> 2, wc = wid & 3, fr = lane & 15, fq = lane >> 4;
    const int K = g.K, nt = K / BK;
    unsigned voffA[2], voffB[2];
#pragma unroll
    for (int i = 0; i < 2; ++i) { int R, C; stage_rc(tid * 16 + i * 8192, R, C); const int Rb = Epi::PERM ? ((R & ~31) + perm32(R & 31)) : R;
        voffA[i] = (unsigned)(R * K + C) * 2u; voffB[i] = (unsigned)(Rb * K + C) * 2u; }
    const size_t kstep = (size_t)(BK * 2);
    const size_t hstep = (size_t)HALF * K * 2;
    const size_t tstep = 2 * hstep;
    const unsigned ldsw = (unsigned)wid * 1024u;
    const int aoff = lds_byte(wr * 64 + fr, fq * 8), boff = lds_byte(wc * 32 + fr, fq * 8);
#define PG8_SA(b, h) (((b) * 2 + (h)) * HTB)
#define PG8_SB(b, h) ((4 + (b) * 2 + (h)) * HTB)
#define PG8_STAGE(bufoff, gbase, voff) do { _Pragma("unroll") for (int _i = 0; _i < 2; ++_i) \
        __builtin_amdgcn_global_load_lds((const unsigned*)((const char*)(gbase) + (voff)[_i]), (PG8_LAS unsigned*)(lds + (bufoff) + ldsw + _i * 8192), 16, 0, 0); } while (0)
#define PG8_LDA(dst, b, h) do { _Pragma("unroll") for (int m = 0; m < 4; ++m) _Pragma("unroll") for (int k = 0; k < 2; ++k) dst[m][k] = *(const PG8_LAS bf16x8*)(lds + PG8_SA(b, h) + aoff + m * 2048 + k * 1024); } while (0)
#define PG8_LDB(dst, b, h) do { _Pragma("unroll") for (int n = 0; n < 2; ++n) _Pragma("unroll") for (int k = 0; k < 2; ++k) dst[n][k] = *(const PG8_LAS bf16x8*)(lds + PG8_SB(b, h) + boff + n * 2048 + k * 1024); } while (0)
#define PG8_MMA(ai, bj, At, Bt) do { __builtin_amdgcn_s_setprio(1); _Pragma("unroll") for (int m = 0; m < 4; ++m) _Pragma("unroll") for (int n = 0; n < 2; ++n) _Pragma("unroll") for (int k = 0; k < 2; ++k) \
        acc[ai][bj][m][n] = __builtin_amdgcn_mfma_f32_16x16x32_bf16(Bt[n][k], At[m][k], acc[ai][bj][m][n], 0, 0, 0); __builtin_amdgcn_s_setprio(0); } while (0)
#define PG8_WAIT_V(n) asm volatile("s_waitcnt vmcnt(" #n ")" ::: "memory")
#define PG8_WAIT_L(n) asm volatile("s_waitcnt lgkmcnt(" #n ")" ::: "memory")
#define PG8_BAR __builtin_amdgcn_s_barrier()
#define PG8_SCHED __builtin_amdgcn_sched_barrier(0)
    Unit cur, nxt; int ui = 0;
    if (!S.next(0, cur)) return;
    f32x4 acc[2][2][4][2];
#pragma unroll
    for (int a = 0; a < 2; ++a)
#pragma unroll
        for (int b = 0; b < 2; ++b)
#pragma unroll
            for (int m = 0; m < 4; ++m)
#pragma unroll
                for (int n = 0; n < 2; ++n) acc[a][b][m][n] = (f32x4){0.f, 0.f, 0.f, 0.f};
    bf16x8 At[4][2], B0[2][2], B1[2][2];
    const char* cA = (const char*)g.A + (size_t)cur.pm * tstep; const char* cB = (const char*)g.Bt + (size_t)cur.pn * tstep;
    S.a_ready(cur);
    if constexpr (SP2) {
        PG8_STAGE(PG8_SB(0, 0), cB, voffB); PG8_STAGE(PG8_SB(0, 1), cB + hstep, voffB); PG8_STAGE(PG8_SA(0, 0), cA, voffA); PG8_STAGE(PG8_SA(0, 1), cA + hstep, voffA);
        if (wr == 1) PG8_BAR;
        PG8_WAIT_V(2); PG8_BAR;
        PG8_STAGE(PG8_SB(1, 0), cB + kstep, voffB); PG8_STAGE(PG8_SA(1, 0), cA + kstep, voffA); PG8_STAGE(PG8_SB(1, 1), cB + hstep + kstep, voffB);
        PG8_WAIT_V(6); PG8_BAR;
    } else {
        PG8_STAGE(PG8_SB(0, 0), cB, voffB); PG8_STAGE(PG8_SA(0, 0), cA, voffA); PG8_STAGE(PG8_SB(0, 1), cB + hstep, voffB); PG8_STAGE(PG8_SA(0, 1), cA + hstep, voffA);
        if (wr == 1) PG8_BAR;
        PG8_WAIT_V(4); PG8_BAR;
        PG8_STAGE(PG8_SB(1, 0), cB + kstep, voffB); PG8_STAGE(PG8_SA(1, 0), cA + kstep, voffA); PG8_STAGE(PG8_SB(1, 1), cB + hstep + kstep, voffB);
        PG8_WAIT_V(6); PG8_BAR;
    }
    for (;;) {
        const bool has_next = S.next(ui + 1, nxt);
        const char* nA = has_next ? (const char*)g.A + (size_t)nxt.pm * tstep : cA; const char* nB = has_next ? (const char*)g.Bt + (size_t)nxt.pn * tstep : cB;
        for (int t = 0; t < nt; t += 2) {
            const bool last = (t == nt - 2);
            const char* a1 = cA + (size_t)(t + 1) * kstep;
            const char* a2 = last ? nA : cA + (size_t)(t + 2) * kstep; const char* b2 = last ? nB : cB + (size_t)(t + 2) * kstep;
            const char* a3 = a2 + kstep; const char* b3 = b2 + kstep;
            if (last && has_next) S.a_ready(nxt);
            if constexpr (SP2) {
            PG8_LDB(B0, 0, 0); PG8_LDB(B1, 0, 1); PG8_SCHED; PG8_LDA(At, 0, 0); PG8_STAGE(PG8_SA(1, 1), a1 + hstep, voffA);
            PG8_WAIT_V(8); PG8_WAIT_L(0); PG8_BAR; PG8_MMA(0, 0, At, B0); PG8_MMA(0, 1, At, B1); PG8_BAR; PG8_SCHED;
            PG8_LDA(At, 0, 1); PG8_STAGE(PG8_SB(0, 0), b2, voffB); PG8_STAGE(PG8_SB(0, 1), b2 + hstep, voffB); PG8_STAGE(PG8_SA(0, 0), a2, voffA);
            PG8_WAIT_V(8); PG8_WAIT_L(0); PG8_BAR; PG8_MMA(1, 0, At, B0); PG8_MMA(1, 1, At, B1); PG8_BAR; PG8_SCHED;
            PG8_LDB(B0, 1, 0); PG8_LDB(B1, 1, 1); PG8_SCHED; PG8_LDA(At, 1, 0); PG8_STAGE(PG8_SA(0, 1), a2 + hstep, voffA);
            PG8_WAIT_V(8); PG8_WAIT_L(0); PG8_BAR; PG8_MMA(0, 0, At, B0); PG8_MMA(0, 1, At, B1); PG8_BAR; PG8_SCHED;
            PG8_LDA(At, 1, 1); PG8_STAGE(PG8_SB(1, 0), b3, voffB); PG8_STAGE(PG8_SB(1, 1), b3 + hstep, voffB); PG8_STAGE(PG8_SA(1, 0), a3, voffA);
            PG8_WAIT_V(8); PG8_WAIT_L(0); PG8_BAR; PG8_MMA(1, 0, At, B0); PG8_MMA(1, 1, At, B1); PG8_BAR; PG8_SCHED;
            } else {
            PG8_LDB(B0, 0, 0); PG8_SCHED; PG8_LDA(At, 0, 0); PG8_STAGE(PG8_SA(1, 1), a1 + hstep, voffA);
            PG8_WAIT_L(8); PG8_BAR; PG8_WAIT_L(0); PG8_MMA(0, 0, At, B0); PG8_BAR; PG8_SCHED;
            PG8_LDB(B1, 0, 1); PG8_STAGE(PG8_SB(0, 0), b2, voffB);
            PG8_BAR; PG8_WAIT_L(0); PG8_MMA(0, 1, At, B1); PG8_BAR;
            PG8_LDA(At, 0, 1); PG8_STAGE(PG8_SA(0, 0), a2, voffA);
            PG8_BAR; PG8_WAIT_L(0); PG8_MMA(1, 0, At, B0); PG8_BAR; PG8_SCHED;
            PG8_STAGE(PG8_SB(0, 1), b2 + hstep, voffB);
            PG8_WAIT_V(6); PG8_BAR; PG8_MMA(1, 1, At, B1); PG8_BAR;
            PG8_LDB(B0, 1, 0); PG8_SCHED; PG8_LDA(At, 1, 0); PG8_STAGE(PG8_SA(0, 1), a2 + hstep, voffA);
            PG8_WAIT_L(8); PG8_BAR; PG8_WAIT_L(0); PG8_MMA(0, 0, At, B0); PG8_BAR; PG8_SCHED;
            PG8_LDB(B1, 1, 1); PG8_STAGE(PG8_SB(1, 0), b3, voffB);
            PG8_BAR; PG8_WAIT_L(0); PG8_MMA(0, 1, At, B1); PG8_BAR;
            PG8_LDA(At, 1, 1); PG8_STAGE(PG8_SA(1, 0), a3, voffA);
            PG8_BAR; PG8_WAIT_L(0); PG8_MMA(1, 0, At, B0); PG8_BAR; PG8_SCHED;
            PG8_STAGE(PG8_SB(1, 1), b3 + hstep, voffB);
            PG8_WAIT_V(6); PG8_BAR; PG8_MMA(1, 1, At, B1); PG8_BAR;
            }
        }
        if constexpr (ALIGN_EPI) { if (wr == 0) PG8_BAR; }
        if constexpr (!Epi::AFTER_DRAIN) { E(acc, cur, wr, wc, fr, fq); S.done(cur); }
        if (!has_next) break;
#pragma unroll
        for (int a = 0; a < 2; ++a)
#pragma unroll
            for (int b = 0; b < 2; ++b)
#pragma unroll
                for (int m = 0; m < 4; ++m)
#pragma unroll
                    for (int n = 0; n < 2; ++n) acc[a][b][m][n] = (f32x4){0.f, 0.f, 0.f, 0.f};
        cur = nxt; cA = nA; cB = nB; ++ui;
        if constexpr (ALIGN_EPI) { if (wr == 1) PG8_BAR; }
    }
    PG8_WAIT_V(0);
    if constexpr (!ALIGN_EPI) { if (wr == 0) PG8_BAR; }
    PG8_BAR;
    if constexpr (Epi::AFTER_DRAIN) { E.fused(acc, cur, wr, wc, fr, fq, lds, wid, lane); S.done(cur); }
#undef PG8_SA
#undef PG8_SB
#undef PG8_STAGE
#undef PG8_LDA
#undef PG8_LDB
#undef PG8_MMA
#undef PG8_WAIT_V
#undef PG8_WAIT_L
#undef PG8_BAR
#undef PG8_SCHED
}
}
constexpr int NWAVES = 8;
constexpr int DM = 1024, SEQ = 8192, NB = 4, DB = 128, DS = 8, FF = 2816;
constexpr int MP = NB * SEQ, MS = DB * DS, M = MP + MS;
constexpr int QR = 256, KVR = 128, RD = 32, RWC = 1792, INC = 2208, INP = 2304, RWD = 512;
constexpr int NPAGE = 128, PAGE = 128;
constexpr float ALPHA = 1.189207115002721f;
constexpr float QSCALE = 0.10206207261596577f * 1.4426950408889634f;
constexpr float LN_EPS = 1e-5f, RMS_EPS = 1e-6f, GN_EPS = 64e-5f;
constexpr size_t O_YP = 0, O_YS = 33554432, O_CKVP = 34603008, O_KRP = 38797312, O_WKVP = 39845888, O_SHP = 39976960,
                 O_CKVS = 39984128, O_KRS = 40115200, O_WKVS = 40147968, O_SHS = 44342272, O_END = 44571648;
constexpr size_t MiB = 1u << 20;
constexpr size_t WS_CTL = 0, CTL_ZERO_BYTES = 1 * MiB;
constexpr size_t WS_WGUA = 2 * MiB, WS_WDA = 13 * MiB, WS_WGUB = 19 * MiB, WS_WDB = 30 * MiB, WS_WIN = 36 * MiB, WS_WQ = 41 * MiB, WS_WO = 42 * MiB, WS_WL = 45 * MiB, WS_ROPE = 46 * MiB;
constexpr size_t WS_XNB = 48 * MiB, WS_HB = 114 * MiB, WS_Z = 296 * MiB, WS_X1 = 428 * MiB, WS_X2 = 560 * MiB, WS_PROJ = 692 * MiB, WS_CQN = 989 * MiB, WS_QB = 1006 * MiB;
constexpr size_t WS_CKVB = 1089 * MiB, WS_KRB = 1098 * MiB, WS_RKV = 1101 * MiB, WS_LA = 1299 * MiB, WS_LO = 1316 * MiB, WS_SC5 = 1514 * MiB, WS_G = 1844 * MiB, WS_SCAL = 1910 * MiB;
constexpr size_t WS_Y = 1915 * MiB, WS_OM = 1981 * MiB, WS_PO = 2080 * MiB, WS_PML = 2112 * MiB, WS_END = 2113 * MiB;
constexpr int ROPE_N = 8200;
constexpr int CW_TMO = 0, CW_QHEAD = 64, CW_BAR = 4096;
constexpr int RING_OFF = 0, RING_BYTES = 131072, LDSCTL_OFF = RING_BYTES, MISC_OFF = LDSCTL_OFF + 320, LDS_BYTES = 147456;

#define GAS __attribute__((address_space(1)))
#define LAS __attribute__((address_space(3)))
typedef unsigned short bf16;
typedef unsigned v4u __attribute__((ext_vector_type(4)));
typedef unsigned v2u __attribute__((ext_vector_type(2)));
typedef float f32x4 __attribute__((ext_vector_type(4)));
typedef float f32x2 __attribute__((ext_vector_type(2)));
typedef short bf16x8 __attribute__((ext_vector_type(8)));
typedef short s16x4 __attribute__((ext_vector_type(4)));
typedef float f32x16 __attribute__((ext_vector_type(16)));
typedef GAS unsigned gu32;
#define RLX_AGENT __ATOMIC_RELAXED, __HIP_MEMORY_SCOPE_AGENT
#define DI __device__ __forceinline__
DI unsigned f2bf(float f) { unsigned u = __builtin_bit_cast(unsigned, f); return (u + 0x7fffu + ((u >> 16) & 1u)) >> 16; }
DI unsigned pk2(float lo, float hi) { return f2bf(lo) | (f2bf(hi) << 16); }
DI float wave_sum(float v) {
#pragma unroll
    for (int o = 1; o < 64; o <<= 1) v += __shfl_xor(v, o);
    return v;
}
#define XB_TMO      128
#define XB_XCNT(j)  (256  + 64 * (j))
#define XB_XSUB(j)  (1280 + 64 * (j))
#define XB_XGEN(j)  (2304 + 64 * (j))
#define XB_TOP      3328
#define XB_TOPGEN   3392
#define XCD_BAR_WORDS 3456
#define XB_SPIN_CAP (1u << 18)

__device__ __forceinline__ unsigned xb_ld(unsigned* p)              { return __hip_atomic_load(p, __ATOMIC_RELAXED, __HIP_MEMORY_SCOPE_AGENT); }
__device__ __forceinline__ unsigned xb_add(unsigned* p, unsigned v) { return __hip_atomic_fetch_add(p, v, __ATOMIC_RELAXED, __HIP_MEMORY_SCOPE_AGENT); }
__device__ __forceinline__ unsigned xb_xcc_id() { return (unsigned)__builtin_amdgcn_s_getreg((3 << 11) | 20) & 0xFu; }
#define XB_SPIN(cond, bar) do { unsigned _sp = 0; while (cond) { __builtin_amdgcn_s_sleep(1); \
    if ((++_sp & 255u) == 0u) { if (xb_ld(&(bar)[XB_TMO])) break; if (_sp > XB_SPIN_CAP) { atomicAdd(&(bar)[XB_TMO], 1u); break; } } } } while (0)

struct XcdBarrier {
    unsigned* bar; unsigned x;
    volatile LAS unsigned* st;
};

__device__ __forceinline__ XcdBarrier xcd_barrier_post(unsigned* bar, volatile LAS unsigned* st) {
    XcdBarrier b; b.bar = bar; b.x = xb_xcc_id(); b.st = st;
    if (threadIdx.x == 0) (void)xb_add(&bar[XB_XCNT(b.x)], 1u);
    return b;
}
__device__ __forceinline__ void xcd_barrier_complete(unsigned* bar, unsigned x, unsigned& nloc, unsigned& nx) {
    const unsigned G = gridDim.x * gridDim.y * gridDim.z;
    unsigned sum, cnt, mine, sp = 0u;
    for (;;) {
        sum = 0u; cnt = 0u; mine = 0u;
#pragma unroll
        for (unsigned j = 0; j < 16; ++j) { const unsigned c = xb_ld(&bar[XB_XCNT(j)]); sum += c; cnt += (c > 0u) ? 1u : 0u; mine = (j == x) ? c : mine; }
        if (sum == G) break;
        __builtin_amdgcn_s_sleep(1);
        if ((++sp & 255u) == 0u) { if (xb_ld(&bar[XB_TMO])) break; if (sp > XB_SPIN_CAP) { atomicAdd(&bar[XB_TMO], 1u); break; } }
    }
    nloc = mine > 0u ? mine : 1u; nx = cnt > 0u ? cnt : 1u;
}

__device__ __forceinline__ void xcd_barrier(const XcdBarrier& b) {
    asm volatile("s_waitcnt vmcnt(0)" ::: "memory");
    __syncthreads();
    if (threadIdx.x == 0) {
        unsigned* bar = b.bar;
        __builtin_amdgcn_s_waitcnt(0);
        unsigned nloc = b.st[0], nx = b.st[1];
        if (nloc == 0u) { xcd_barrier_complete(bar, b.x, nloc, nx); b.st[0] = nloc; b.st[1] = nx; }
        const unsigned old = xb_add(&bar[XB_XSUB(b.x)], 1u);
        const unsigned gen = old / nloc;
        if (old + 1u == (gen + 1u) * nloc) {
            __builtin_amdgcn_fence(__ATOMIC_RELEASE, "agent");
            asm volatile("s_waitcnt vmcnt(0)" ::: "memory");
            const unsigned og = xb_add(&bar[XB_TOP], 1u);
            const unsigned tg = og / nx;
            if (og + 1u == (tg + 1u) * nx) xb_add(&bar[XB_TOPGEN], 1u);
            else XB_SPIN(xb_ld(&bar[XB_TOPGEN]) == tg, bar);
            __builtin_amdgcn_fence(__ATOMIC_ACQUIRE, "agent");
            xb_add(&bar[XB_XGEN(b.x)], 1u);
            asm volatile("s_waitcnt vmcnt(0)" ::: "memory");
        } else {
            XB_SPIN(xb_ld(&bar[XB_XGEN(b.x)]) == gen, bar);
            __builtin_amdgcn_fence(__ATOMIC_ACQUIRE, "agent");
            asm volatile("s_waitcnt vmcnt(0)" ::: "memory");
        }
    }
    __syncthreads();
}
DI void p0_transpose_item(const float* W, int K, int N, bf16* WT, int kb, int nb, int drow0, LAS float* scr, int lane) {
    const int k0 = 64 * kb, n0 = 32 * nb;
#pragma unroll 8
    for (int i = 0; i < 32; ++i) { const int kk = 2 * i + (lane >> 5); scr[kk * 33 + (lane & 31)] = W[(size_t)(k0 + kk) * N + n0 + (lane & 31)]; }
    asm volatile("s_waitcnt lgkmcnt(0)" ::: "memory");
    const int c = lane & 7;
#pragma unroll
    for (int j = 0; j < 4; ++j) { const int n = (lane >> 3) + 8 * j; const LAS float* s = scr + (8 * c) * 33 + n;
        v4u o; o.x = pk2(s[0 * 33], s[1 * 33]); o.y = pk2(s[2 * 33], s[3 * 33]); o.z = pk2(s[4 * 33], s[5 * 33]); o.w = pk2(s[6 * 33], s[7 * 33]);
        *(GAS v4u*)(WT + (size_t)(drow0 + n) * K + k0 + 8 * c) = o; }
    asm volatile("s_waitcnt lgkmcnt(0)" ::: "memory");
}
DI int gu_row(int n, int up) { return 256 * (n >> 7) + (n & 127) + (up ? 128 : 0); }

DI void sincos_d(double r, double& s, double& c) {
    const double z = r * r;
    double ps = -9.18368986379554601e-29; ps = ps * z + 6.44695028438447359e-26; ps = ps * z - 3.86817017063068413e-23; ps = ps * z + 1.95729410633912626e-20; ps = ps * z - 8.22063524662432950e-18;
    ps = ps * z + 2.81145725434552060e-15; ps = ps * z - 7.64716373181981641e-13; ps = ps * z + 1.60590438368216133e-10; ps = ps * z - 2.50521083854417202e-08; ps = ps * z + 2.75573192239858925e-06;
    ps = ps * z - 1.98412698412698413e-04; ps = ps * z + 8.33333333333333322e-03; ps = ps * z - 1.66666666666666657e-01; ps = ps * z + 1.0; s = ps * r;
    double pc = 3.27988923706983776e-30; pc = pc * z - 2.47959626322479759e-27; pc = pc * z + 1.61173757109611839e-24; pc = pc * z - 8.89679139245057408e-22; pc = pc * z + 4.11031762331216484e-19;
    pc = pc * z - 1.56192069685862253e-16; pc = pc * z + 4.77947733238738525e-14; pc = pc * z - 1.14707455977297245e-11; pc = pc * z + 2.08767569878681002e-09; pc = pc * z - 2.75573192239858883e-07;
    pc = pc * z + 2.48015873015873016e-05; pc = pc * z - 1.38888888888888894e-03; pc = pc * z + 4.16666666666666644e-02; pc = pc * z - 0.5; pc = pc * z + 1.0; c = pc;
}

struct Args { const float* in[37]; float* out; unsigned char* ws; int ph_lo, ph_hi; };
static_assert(sizeof(Args) == 37 * 8 + 8 + 8 + 8, "Args has no padding");
typedef const __attribute__((address_space(4))) Args Ptrs;
DI Ptrs* args_here() { Ptrs* p = (Ptrs*)__builtin_amdgcn_kernarg_segment_ptr(); asm volatile("" : "+s"(p)); return p; }

DI void p0_prologue(const Ptrs& P, LAS unsigned char* lds, int gw, int NGW, int wave, int lane) {
    unsigned char* ws = P.ws;
    LAS float* scr = (LAS float*)(lds + RING_OFF + wave * 16384);
    constexpr int I_GU = (DM / 64) * (FF / 32), I_D = (FF / 64) * (DM / 32), I_IN = (DM / 64) * (INC / 32);
    constexpr int NITEMS = 6 * I_GU + I_IN;
    for (int it = gw; it < NITEMS; it += NGW) {
        int r = it;
        if (r < 4 * I_GU) {
            const int which = r / I_GU; r -= which * I_GU; const int nblk = FF / 32, kb = r / nblk, nb = r % nblk;
            const float* W = which == 0 ? P.in[9] : which == 1 ? P.in[10] : which == 2 ? P.in[32] : P.in[33];
            bf16* WT = (bf16*)(ws + (which < 2 ? WS_WGUA : WS_WGUB));
            p0_transpose_item(W, DM, FF, WT, kb, nb, gu_row(32 * nb, which & 1), scr, lane); continue; }
        r -= 4 * I_GU;
        if (r < 2 * I_D) { const int which = r / I_D; r -= which * I_D; const int nblk = DM / 32, kb = r / nblk, nb = r % nblk;
            p0_transpose_item(which ? P.in[34] : P.in[11], FF, DM, (bf16*)(ws + (which ? WS_WDB : WS_WDA)), kb, nb, 32 * nb, scr, lane); continue; }
        r -= 2 * I_D;
        { const int nblk = INC / 32, kb = r / nblk, nb = r % nblk; p0_transpose_item(P.in[12], DM, INC, (bf16*)(ws + WS_WIN), kb, nb, 32 * nb, scr, lane); }
    }
    const int gt = gw * 64 + lane, NGT = NGW * 64;
    { GAS v4u* z = (GAS v4u*)(ws + WS_WIN + (size_t)INC * DM * 2); for (int i = gt; i < (INP - INC) * DM * 2 / 16; i += NGT) z[i] = (v4u){0u, 0u, 0u, 0u}; }
    { bf16* WL = (bf16*)(ws + WS_WL); const float* wl = P.in[20]; const float* al = P.in[22]; const float* gl = P.in[23];
      for (int i = gt; i < 1536 * 256; i += NGT) { const int n = i >> 8, k = i & 255; float v = 0.f;
          if (n < 512) { if (k < 64) v = wl[k * 512 + n]; }
          else if (n < 1024) { if (k >= 64 && k < 128) v = al[(k - 64) * 512 + (n - 512)]; }
          else { if (k >= 128) v = gl[(k - 128) * 512 + (n - 1024)]; }
          WL[i] = (bf16)f2bf(v); } }
    { bf16* WQ = (bf16*)(ws + WS_WQ); const float* uq = P.in[14]; const float* uk = P.in[16];
      for (int i = gt; i < 1280 * 256; i += NGT) { const int n = i >> 8, c = i & 255; float v;
          if (n < 1024) { const int hd = n >> 7, r = n & 127; const float* a = uq + c * 768 + hd * 96; const float* b = uk + r * 512 + hd * 64; float s = 0.f;
              for (int j = 0; j < 64; ++j) s += a[j] * b[j]; v = s; }
          else { const int hd = (n - 1024) >> 5, cp = (n - 1024) & 31, p = (cp >> 1) + 16 * (cp & 1); v = uq[c * 768 + hd * 96 + 64 + p]; }
          WQ[i] = (bf16)f2bf(v); } }
    { bf16* WO = (bf16*)(ws + WS_WO); const float* uv = P.in[17]; const float* wo = P.in[29];
      for (int i = gt; i < 1536 * 1024; i += NGT) { const int k = i >> 10, n = i & 1023; float v;
          if (k < 1024) { const int hd = k >> 7, r = k & 127; const float* a = uv + r * 512 + hd * 64; const float* b = wo + (size_t)(hd * 64) * 1024 + n; float s = 0.f;
              for (int j = 0; j < 64; ++j) s += a[j] * b[(size_t)j * 1024]; v = s; }
          else v = wo[(size_t)(512 + k - 1024) * 1024 + n];
          WO[(size_t)n * 1536 + k] = (bf16)f2bf(v); } }
    { float* ct = (float*)(ws + WS_ROPE); float* st = ct + ROPE_N * 16;
      for (int i = gt; i < ROPE_N * 16; i += NGT) { const int tix = i >> 4, f = i & 15; const double pos = (double)(tix < 8192 ? tix : 16384 + (tix - 8192));
          double inv = 1.0; for (int q = 0; q < f; ++q) inv *= 0.5623413251903491;
          const double ang = pos * inv; const double kq = __builtin_rint(ang * 0.15915494309189535); const double r = __builtin_fma(-kq, 6.283185307179586, ang) - kq * 2.4492935982947064e-16;
          double s, c; sincos_d(r, s, c); ct[i] = (float)c; st[i] = (float)s; } }
    { bf16* XNB = (bf16*)(ws + WS_XNB);
      for (int m = gw; m < M; m += NGW) { const float* xr = m < MP ? P.in[0] + (size_t)m * DM : P.in[1] + (size_t)(m - MP) * DM;
          const GAS f32x4* x4 = (const GAS f32x4*)xr + lane; GAS v2u* o = (GAS v2u*)(XNB + (size_t)m * DM) + lane;
#pragma unroll
          for (int j = 0; j < 4; ++j) { const f32x4 v = x4[64 * j]; o[64 * j] = (v2u){pk2(v.x, v.y), pk2(v.z, v.w)}; } } }
}

DI void ln_phase(const float* Z, const float* g, const float* b, float* Xf, bf16* Xb, int gw, int NGW, int lane) {
    f32x4 gv[4], bv[4];
#pragma unroll
    for (int j = 0; j < 4; ++j) { gv[j] = ((const GAS f32x4*)g)[lane + 64 * j]; bv[j] = ((const GAS f32x4*)b)[lane + 64 * j]; }
    for (int m = gw; m < M; m += NGW) {
        const GAS f32x4* zr = (const GAS f32x4*)(Z + (size_t)m * DM) + lane;
        f32x4 v[4]; float s = 0.f;
#pragma unroll
        for (int j = 0; j < 4; ++j) { v[j] = zr[64 * j]; s += (v[j].x + v[j].y) + (v[j].z + v[j].w); }
        const float mean = wave_sum(s) * (1.f / DM); float s2 = 0.f;
#pragma unroll
        for (int j = 0; j < 4; ++j) { v[j] = v[j] - mean; s2 += (v[j].x * v[j].x + v[j].y * v[j].y) + (v[j].z * v[j].z + v[j].w * v[j].w); }
        const float rstd = 1.f / sqrtf(wave_sum(s2) * (1.f / DM) + LN_EPS);
#pragma unroll
        for (int j = 0; j < 4; ++j) { v[j] = v[j] * rstd * gv[j] + bv[j]; }
        if (Xf) { GAS f32x4* o = (GAS f32x4*)(Xf + (size_t)m * DM) + lane;
#pragma unroll
            for (int j = 0; j < 4; ++j) o[64 * j] = v[j]; }
        if (Xb) { GAS v2u* o = (GAS v2u*)(Xb + (size_t)m * DM) + lane;
#pragma unroll
            for (int j = 0; j < 4; ++j) o[64 * j] = (v2u){pk2(v[j].x, v[j].y), pk2(v[j].z, v[j].w)}; }
    }
}

DI void prep_a(const Ptrs& P, int gw, int NGW, int lane) {
    unsigned char* ws = P.ws;
    const float* PROJ = (const float*)(ws + WS_PROJ);
    bf16* CQN = (bf16*)(ws + WS_CQN); bf16* CKVB = (bf16*)(ws + WS_CKVB); bf16* KRB = (bf16*)(ws + WS_KRB);
    float* RKV = (float*)(ws + WS_RKV); bf16* LA = (bf16*)(ws + WS_LA);
    const float* ct = (const float*)(ws + WS_ROPE); const float* st = ct + ROPE_N * 16;
    const float* qg = P.in[13]; const float* kg = P.in[15]; const float* mu = P.in[18]; const float* sshift = P.in[5];
    const f32x4 qg4 = ((const GAS f32x4*)qg)[lane]; const f32x2 kg2 = ((const GAS f32x2*)kg)[lane];
    f32x4 mu4[7];
#pragma unroll
    for (int i = 0; i < 7; ++i) mu4[i] = ((const GAS f32x4*)mu)[lane + 64 * i];
    for (int m = gw; m < M; m += NGW) {
        const bool samp = m >= MP; const int ms = m - MP;
        const int bb = samp ? (ms >> 3) : (m >> 13), t = samp ? (ms & 7) : (m & 8191), tix = samp ? 8192 + t : t;
        const float* pr = PROJ + (size_t)m * INP;
        { const f32x4 v = ((const GAS f32x4*)pr)[lane]; const float ss = wave_sum((v.x * v.x + v.y * v.y) + (v.z * v.z + v.w * v.w));
          const float rs = 1.f / sqrtf(ss * (1.f / QR) + RMS_EPS);
          ((GAS v2u*)(CQN + (size_t)m * QR))[lane] = (v2u){pk2(v.x * rs * qg4.x, v.y * rs * qg4.y), pk2(v.z * rs * qg4.z, v.w * rs * qg4.w)}; }
        { const f32x2 v = ((const GAS f32x2*)(pr + QR))[lane]; const float ss = wave_sum(v.x * v.x + v.y * v.y);
          const float rs = 1.f / sqrtf(ss * (1.f / KVR) + RMS_EPS); const float a = v.x * rs * kg2.x, b = v.y * rs * kg2.y;
          float* o = samp ? P.out + O_CKVS + (size_t)ms * KVR : P.out + O_CKVP + (size_t)m * KVR;
          ((GAS f32x2*)o)[lane] = (f32x2){a, b}; ((GAS unsigned*)(CKVB + (size_t)m * KVR))[lane] = pk2(a, b); }
        { const int l31 = lane & 31; const float v = pr[QR + KVR + l31]; const float pv = __shfl_xor(v, 16); const int p = lane & 15;
          const float c = ct[tix * 16 + p], s = st[tix * 16 + p];
          const float o = (l31 < 16) ? v * c - pv * s : pv * s + v * c;
          if (lane < 32) { float* op = samp ? P.out + O_KRS + (size_t)ms * RD : P.out + O_KRP + (size_t)m * RD; op[lane] = o; }
          const float ohi = __shfl_down(o, 16);
          if (lane < 16) ((GAS unsigned*)(KRB + (size_t)m * RD))[lane] = pk2(o, ohi); }
        { const GAS f32x4* rw4 = (const GAS f32x4*)(pr + (INC - RWC));
          const GAS f32x4* pv4 = (t == 0) ? (samp ? (const GAS f32x4*)(sshift + (size_t)bb * RWC) : (const GAS f32x4*)nullptr) : (const GAS f32x4*)(pr - INP + (INC - RWC));
          const bool last = samp ? (t == DS - 1) : (t == SEQ - 1);
          float* sh = samp ? P.out + O_SHS + (size_t)bb * RWC : P.out + O_SHP + (size_t)bb * RWC;
#pragma unroll
          for (int i = 0; i < 7; ++i) {
              const f32x4 r = rw4[lane + 64 * i]; const f32x4 pv = pv4 ? pv4[lane + 64 * i] : (f32x4){0.f, 0.f, 0.f, 0.f};
              const f32x4 x = r + (pv - r) * mu4[i];
              if (last) ((GAS f32x4*)sh)[lane + 64 * i] = r;
              if (i < 6) ((GAS f32x4*)(RKV + (size_t)m * 1536))[lane + 64 * i] = x;
              else { f32x4 y;
                  if (lane < 16) { for (int j = 0; j < 4; ++j) { const float e = __expf(2.f * x[j]); y[j] = 1.f - 2.f / (e + 1.f); } }
                  else if (lane < 32) y = x;
                  else { for (int j = 0; j < 4; ++j) y[j] = 1.f / (1.f + __expf(-x[j])); }
                  ((GAS v2u*)(LA + (size_t)m * 256))[lane] = (v2u){pk2(y.x, y.y), pk2(y.z, y.w)}; }
          } }
    }
}

DI float red8(float v) { v += __shfl_xor(v, 1); v += __shfl_xor(v, 2); v += __shfl_xor(v, 4); return v; }
DI void prep_c(const Ptrs& P, int gw, int NGW, int lane) {
    unsigned char* ws = P.ws;
    const float* RKV = (const float*)(ws + WS_RKV); const float* LO = (const float*)(ws + WS_LO);
    float* SC5 = (float*)(ws + WS_SC5); float* G = (float*)(ws + WS_G); float* SCAL = (float*)(ws + WS_SCAL);
    constexpr size_t ASZ = (size_t)M * RWD;
    const int c0 = lane * 8;
    float w0v[8], a0v[8], kkv[8], kav[8], rkv[8];
#pragma unroll
    for (int j = 0; j < 8; ++j) { w0v[j] = P.in[19][c0 + j]; a0v[j] = P.in[21][c0 + j]; kkv[j] = P.in[24][c0 + j]; kav[j] = P.in[25][c0 + j]; rkv[j] = P.in[26][c0 + j]; }
    for (int m = gw; m < M; m += NGW) {
        const float* rk = RKV + (size_t)m * 1536 + c0; const float* lo = LO + (size_t)m * 1536 + c0;
        float r[8], k[8], wl[8], al[8], gl[8];
        { const f32x4 a = ((const GAS f32x4*)rk)[0], b = ((const GAS f32x4*)rk)[1]; r[0]=a.x; r[1]=a.y; r[2]=a.z; r[3]=a.w; r[4]=b.x; r[5]=b.y; r[6]=b.z; r[7]=b.w; }
        { const f32x4 a = ((const GAS f32x4*)(rk + 512))[0], b = ((const GAS f32x4*)(rk + 512))[1]; k[0]=a.x; k[1]=a.y; k[2]=a.z; k[3]=a.w; k[4]=b.x; k[5]=b.y; k[6]=b.z; k[7]=b.w; }
        { const f32x4 a = ((const GAS f32x4*)lo)[0], b = ((const GAS f32x4*)lo)[1]; wl[0]=a.x; wl[1]=a.y; wl[2]=a.z; wl[3]=a.w; wl[4]=b.x; wl[5]=b.y; wl[6]=b.z; wl[7]=b.w; }
        { const f32x4 a = ((const GAS f32x4*)(lo + 512))[0], b = ((const GAS f32x4*)(lo + 512))[1]; al[0]=a.x; al[1]=a.y; al[2]=a.z; al[3]=a.w; al[4]=b.x; al[5]=b.y; al[6]=b.z; al[7]=b.w; }
        { const f32x4 a = ((const GAS f32x4*)(lo + 1024))[0], b = ((const GAS f32x4*)(lo + 1024))[1]; gl[0]=a.x; gl[1]=a.y; gl[2]=a.z; gl[3]=a.w; gl[4]=b.x; gl[5]=b.y; gl[6]=b.z; gl[7]=b.w; }
        float dec[8], av[8], kk[8], kp[8]; float nn = 0.f;
#pragma unroll
        for (int j = 0; j < 8; ++j) {
            const float z = -(w0v[j] + wl[j]);
            const float sp = fmaxf(z, 0.f) + log1pf(__expf(-fabsf(z)));
            const float w = -sp - 0.5f; dec[j] = __expf(-__expf(w));
            av[j] = 1.f / (1.f + __expf(-(a0v[j] + al[j])));
            kk[j] = k[j] * kkv[j]; nn += kk[j] * kk[j];
            kp[j] = k[j] * (1.f + (av[j] - 1.f) * kav[j]);
        }
        nn = red8(nn); const float inv = 1.f / fmaxf(sqrtf(nn), 1e-12f);
        float as[8], bs[8], wr[8]; float br = 0.f, kr = 0.f, bon = 0.f;
#pragma unroll
        for (int j = 0; j < 8; ++j) { const float kn = kk[j] * inv; as[j] = -kn; bs[j] = kn * av[j]; wr[j] = dec[j] * r[j]; br += bs[j] * r[j]; kr += kp[j] * r[j]; bon += r[j] * kp[j] * rkv[j]; }
        br = red8(br); kr = red8(kr); bon = red8(bon);
        float* o = SC5 + (size_t)m * RWD + c0;
        ((GAS f32x4*)o)[0] = (f32x4){as[0], as[1], as[2], as[3]}; ((GAS f32x4*)o)[1] = (f32x4){as[4], as[5], as[6], as[7]}; o += ASZ;
        ((GAS f32x4*)o)[0] = (f32x4){wr[0], wr[1], wr[2], wr[3]}; ((GAS f32x4*)o)[1] = (f32x4){wr[4], wr[5], wr[6], wr[7]}; o += ASZ;
        ((GAS f32x4*)o)[0] = (f32x4){dec[0], dec[1], dec[2], dec[3]}; ((GAS f32x4*)o)[1] = (f32x4){dec[4], dec[5], dec[6], dec[7]}; o += ASZ;
        ((GAS f32x4*)o)[0] = (f32x4){bs[0], bs[1], bs[2], bs[3]}; ((GAS f32x4*)o)[1] = (f32x4){bs[4], bs[5], bs[6], bs[7]}; o += ASZ;
        ((GAS f32x4*)o)[0] = (f32x4){kp[0], kp[1], kp[2], kp[3]}; ((GAS f32x4*)o)[1] = (f32x4){kp[4], kp[5], kp[6], kp[7]};
        float* go = G + (size_t)m * RWD + c0;
        ((GAS f32x4*)go)[0] = (f32x4){gl[0], gl[1], gl[2], gl[3]}; ((GAS f32x4*)go)[1] = (f32x4){gl[4], gl[5], gl[6], gl[7]};
        if ((lane & 7) == 0) ((GAS f32x4*)(SCAL + ((size_t)m * 8 + (lane >> 3)) * 4))[0] = (f32x4){br, kr, bon, 0.f};
    }
}

DI void post_phase(const Ptrs& P, int gw, int NGW, int lane) {
    unsigned char* ws = P.ws;
    bf16* OM = (bf16*)(ws + WS_OM);
    { const float* PO = (const float*)(ws + WS_PO); const float* PML = (const float*)(ws + WS_PML);
      for (int it = gw; it < DB * 64; it += NGW) { const int b = it >> 6, qr = it & 63;
          float mi[8], li[8]; float mx = -3.0e38f;
#pragma unroll
          for (int s = 0; s < 8; ++s) { const f32x2 ml = ((const GAS f32x2*)PML)[(size_t)(b * 8 + s) * 64 + qr]; mi[s] = ml.x; li[s] = ml.y; mx = fmaxf(mx, ml.x); }
          float L = 0.f; f32x2 acc = {0.f, 0.f};
#pragma unroll
          for (int s = 0; s < 8; ++s) { const float w = __builtin_amdgcn_exp2f(mi[s] - mx); L += li[s] * w;
              const f32x2 o = ((const GAS f32x2*)(PO + ((size_t)(b * 8 + s) * 64 + qr) * 128))[lane]; acc += o * w; }
          const float inv = 1.f / L; const int tq = qr >> 3, hd = qr & 7;
          ((GAS unsigned*)(OM + (size_t)(MP + b * 8 + tq) * 1536 + hd * 128))[lane] = pk2(acc.x * inv, acc.y * inv); } }
    { const float* Y = (const float*)(ws + WS_Y); const float* RKV = (const float*)(ws + WS_RKV); const float* G = (const float*)(ws + WS_G); const float* SCAL = (const float*)(ws + WS_SCAL);
      const int c0 = lane * 8; float lg[8], lb[8];
#pragma unroll
      for (int j = 0; j < 8; ++j) { lg[j] = P.in[27][c0 + j]; lb[j] = P.in[28][c0 + j]; }
      for (int m = gw; m < M; m += NGW) {
          float y[8], v[8], g[8];
          { const GAS f32x4* p = (const GAS f32x4*)(Y + (size_t)m * RWD + c0); const f32x4 a = p[0], b = p[1]; y[0]=a.x; y[1]=a.y; y[2]=a.z; y[3]=a.w; y[4]=b.x; y[5]=b.y; y[6]=b.z; y[7]=b.w; }
          { const GAS f32x4* p = (const GAS f32x4*)(RKV + (size_t)m * 1536 + 1024 + c0); const f32x4 a = p[0], b = p[1]; v[0]=a.x; v[1]=a.y; v[2]=a.z; v[3]=a.w; v[4]=b.x; v[5]=b.y; v[6]=b.z; v[7]=b.w; }
          { const GAS f32x4* p = (const GAS f32x4*)(G + (size_t)m * RWD + c0); const f32x4 a = p[0], b = p[1]; g[0]=a.x; g[1]=a.y; g[2]=a.z; g[3]=a.w; g[4]=b.x; g[5]=b.y; g[6]=b.z; g[7]=b.w; }
          const float bon = SCAL[((size_t)m * 8 + (lane >> 3)) * 4 + 2];
          float s = 0.f;
#pragma unroll
          for (int j = 0; j < 8; ++j) s += y[j];
          const float mean = red8(s) * (1.f / 64.f); float q = 0.f;
#pragma unroll
          for (int j = 0; j < 8; ++j) { y[j] -= mean; q += y[j] * y[j]; }
          const float rstd = 1.f / sqrtf(red8(q) * (1.f / 64.f) + GN_EPS);
          float o[8];
#pragma unroll
          for (int j = 0; j < 8; ++j) o[j] = (y[j] * rstd * lg[j] + lb[j] + bon * v[j]) * g[j];
          *(GAS v4u*)(OM + (size_t)m * 1536 + 1024 + c0) = (v4u){pk2(o[0], o[1]), pk2(o[2], o[3]), pk2(o[4], o[5]), pk2(o[6], o[7])};
      } }
}
namespace att {
constexpr int KSTEP_B = 1152, SUB_BYTES = 10 * KSTEP_B;
DI unsigned img_off(unsigned row, unsigned ch) { return (unsigned)KSTEP_B * (ch >> 1) + 32u * row + 16u * ((ch & 1u) ^ ((row >> 3) & 1u)); }
DI unsigned kvmap(unsigned r) { return (r & ~12u) | ((r & 4u) << 1) | ((r & 8u) >> 1); }
DI unsigned row_base(unsigned lane) { const unsigned kr = kvmap(lane & 31u), h = lane >> 5; return 32u * kr + 16u * (h ^ ((kr >> 3) & 1u)); }
DI unsigned tr_base(unsigned lane) { const unsigned h = lane >> 5, blk = (lane >> 4) & 1u, q = (lane & 15u) >> 2, p = lane & 3u;
    return (unsigned)KSTEP_B * blk + 32u * (8u * h + q) + 16u * ((p >> 1) ^ h) + 8u * (p & 1u); }
DI unsigned cvtpk(float lo, float hi) { typedef float f2 __attribute__((ext_vector_type(2))); typedef __bf16 b2 __attribute__((ext_vector_type(2))); f2 v = {lo, hi}; b2 b = __builtin_convertvector(v, b2); return __builtin_bit_cast(unsigned, b); }
DI s16x4 vtr(const LAS unsigned char* p) { typedef short v4i16_t __attribute__((ext_vector_type(4))); return __builtin_bit_cast(s16x4, __builtin_amdgcn_ds_read_tr16_b64_v4i16((LAS v4i16_t*)p)); }
#define ATT_MFMA(a, b, c) __builtin_amdgcn_mfma_f32_32x32x16_bf16((a), (b), (c), 0, 0, 0)

template <bool MASK>
DI void subtile(const LAS unsigned char* img, const bf16x8 (&qf)[10], float& mrun, float& lrun, f32x16 (&o)[4], int lane, int qlim) {
    __builtin_amdgcn_sched_barrier(0);
    const unsigned h = lane >> 5;
    const LAS unsigned char* rb = img + row_base(lane); const LAS unsigned char* tb = img + tr_base(lane);
    f32x16 x;
#pragma unroll
    for (int i = 0; i < 16; ++i) x[i] = 0.f;
#pragma unroll
    for (int s = 0; s < 10; ++s) { const bf16x8 a = *(const LAS bf16x8*)(rb + KSTEP_B * s); x = ATT_MFMA(a, qf[s], x); }
    if (MASK) {
#pragma unroll
        for (int i = 0; i < 16; ++i) { const int kv = 16 * (i >> 3) + 8 * (int)h + (i & 7); if (kv > qlim) x[i] = -1e30f; }
    }
    float mx = x[0];
#pragma unroll
    for (int i = 1; i < 16; ++i) mx = fmaxf(mx, x[i]);
    mx = fmaxf(mx, __shfl_xor(mx, 32));
    const float mn = fmaxf(mrun, mx), corr = __builtin_amdgcn_exp2f(mrun - mn); mrun = mn;
    float ls = 0.f;
#pragma unroll
    for (int i = 0; i < 16; ++i) { x[i] = __builtin_amdgcn_exp2f(x[i] - mn); ls += x[i]; }
    lrun = lrun * corr + ls;
#pragma unroll
    for (int d = 0; d < 4; ++d)
#pragma unroll
        for (int i = 0; i < 16; ++i) o[d][i] *= corr;
    bf16x8 pb[2];
#pragma unroll
    for (int s = 0; s < 2; ++s) { v4u w; w.x = cvtpk(x[8 * s], x[8 * s + 1]); w.y = cvtpk(x[8 * s + 2], x[8 * s + 3]); w.z = cvtpk(x[8 * s + 4], x[8 * s + 5]); w.w = cvtpk(x[8 * s + 6], x[8 * s + 7]); pb[s] = __builtin_bit_cast(bf16x8, w); }
#pragma unroll
    for (int d = 0; d < 4; ++d)
#pragma unroll
        for (int s = 0; s < 2; ++s) {
            const s16x4 lo = vtr(tb + 2 * KSTEP_B * d + 512 * s), hi = vtr(tb + 2 * KSTEP_B * d + 512 * s + 128);
            const bf16x8 a = __builtin_shufflevector(lo, hi, 0, 1, 2, 3, 4, 5, 6, 7);
            o[d] = ATT_MFMA(a, pb[s], o[d]);
        }
}

DI void prompt_unit(LAS unsigned char* lds, const bf16* QB, const bf16* CKVB, const bf16* KRB, bf16* OM, int b, int qblk, int tid, int wave, int lane) {
    const int r = lane & 31, h = lane >> 5;
    const int row0 = b * SEQ + qblk * 32, kb = b * SEQ;
    bf16x8 qf[10];
    { const bf16* qp = QB + (size_t)(row0 + r) * 1280 + wave * 160 + 8 * h;
#pragma unroll
      for (int s = 0; s < 10; ++s) qf[s] = *(const GAS bf16x8*)(qp + 16 * s); }
    f32x16 o[4];
#pragma unroll
    for (int d = 0; d < 4; ++d)
#pragma unroll
        for (int i = 0; i < 16; ++i) o[d][i] = 0.f;
    float mrun = -1e30f, lrun = 0.f;
    const int nsub = qblk + 1, ntile = (nsub + 1) >> 1;
    const int lrow0 = tid >> 4, lch = tid & 15, lrow1 = lrow0 + 32;
    const unsigned ld0 = (unsigned)(lrow0 >> 5) * SUB_BYTES + img_off(lrow0 & 31, lch), ld1 = (unsigned)(lrow1 >> 5) * SUB_BYTES + img_off(lrow1 & 31, lch);
    const int rrow = tid >> 2, rc = tid & 3; const unsigned rd = (unsigned)(rrow >> 5) * SUB_BYTES + img_off(rrow & 31, 16 + rc);
    const bf16* g0 = CKVB + (size_t)(kb + lrow0) * KVR + lch * 8; const bf16* g1 = CKVB + (size_t)(kb + lrow1) * KVR + lch * 8; const bf16* g2 = KRB + (size_t)(kb + rrow) * RD + rc * 8;
    v4u s0 = *(const GAS v4u*)g0, s1 = *(const GAS v4u*)g1, s2 = (tid < 256) ? *(const GAS v4u*)g2 : (v4u){0u, 0u, 0u, 0u};
    *(LAS v4u*)(lds + ld0) = s0; *(LAS v4u*)(lds + ld1) = s1; if (tid < 256) *(LAS v4u*)(lds + rd) = s2;
    __syncthreads();
    const int nfull = qblk >> 1;
#define PU_LOAD(tn) do { const size_t adv = (size_t)(tn) * 64; s0 = *(const GAS v4u*)(g0 + adv * KVR); s1 = *(const GAS v4u*)(g1 + adv * KVR); if (tid < 256) s2 = *(const GAS v4u*)(g2 + adv * RD); } while (0)
#define PU_WRITE(par) do { LAS unsigned char* nb = lds + (par) * (2 * SUB_BYTES); *(LAS v4u*)(nb + ld0) = s0; *(LAS v4u*)(nb + ld1) = s1; if (tid < 256) *(LAS v4u*)(nb + rd) = s2; } while (0)
    for (int t = 0; t < nfull; ++t) {
        PU_LOAD(t + 1);
        const LAS unsigned char* img = lds + (t & 1) * (2 * SUB_BYTES);
        subtile<false>(img, qf, mrun, lrun, o, lane, 0); subtile<false>(img + SUB_BYTES, qf, mrun, lrun, o, lane, 0);
        PU_WRITE((t + 1) & 1); __syncthreads();
    }
    { const LAS unsigned char* img = lds + (nfull & 1) * (2 * SUB_BYTES);
      if (qblk & 1) { subtile<false>(img, qf, mrun, lrun, o, lane, 0); img += SUB_BYTES; }
      subtile<true>(img, qf, mrun, lrun, o, lane, r);
      __syncthreads(); }
#undef PU_LOAD
#undef PU_WRITE
    const float inv = 1.f / (lrun + __shfl_xor(lrun, 32));
    bf16* op = OM + (size_t)(row0 + r) * 1536 + wave * 128 + 4 * h;
#pragma unroll
    for (int d = 0; d < 4; ++d)
#pragma unroll
        for (int g = 0; g < 4; ++g)
            *(GAS v2u*)(op + 32 * d + 8 * g) = (v2u){pk2(o[d][4 * g] * inv, o[d][4 * g + 1] * inv), pk2(o[d][4 * g + 2] * inv, o[d][4 * g + 3] * inv)};
}

DI void sample_unit(LAS unsigned char* lds, const bf16* QB, const bf16* CKVB, const bf16* KRB, const float* cckv, const float* ckr, const int* ptab, float* PO, float* PML,
                    int b, int sp, int tid, int wave, int lane) {
    const int r = lane & 31, h = lane >> 5, qt = wave & 1, ks = wave >> 1;
    const int qr = 32 * qt + r, tq = qr >> 3, hd = qr & 7;
    bf16x8 qf[10];
    { const bf16* qp = QB + (size_t)(MP + b * DS + tq) * 1280 + hd * 160 + 8 * h;
#pragma unroll
      for (int s = 0; s < 10; ++s) qf[s] = *(const GAS bf16x8*)(qp + 16 * s); }
    f32x16 o[4];
#pragma unroll
    for (int d = 0; d < 4; ++d)
#pragma unroll
        for (int i = 0; i < 16; ++i) o[d][i] = 0.f;
    float mrun = -1e30f, lrun = 0.f;
    constexpr int PBUF = 4 * SUB_BYTES;
    unsigned ldl[4];
#pragma unroll
    for (int i = 0; i < 4; ++i) { const int row = (tid >> 4) + 32 * i; ldl[i] = (unsigned)(row >> 5) * SUB_BYTES + img_off(row & 31, tid & 15); }
    const int rrow = tid >> 2; const unsigned ldr = (unsigned)(rrow >> 5) * SUB_BYTES + img_off(rrow & 31, 16 + (tid & 3));
    const int* pt = ptab + b * NPAGE + sp * 64;
    f32x4 sl[8], sr[2];
    { const int pg = pt[0]; const float* pl = cckv + (size_t)pg * (PAGE * KVR) + (size_t)(tid >> 4) * KVR + (tid & 15) * 8; const float* prp = ckr + (size_t)pg * (PAGE * RD) + (size_t)rrow * RD + (tid & 3) * 4;
#pragma unroll
      for (int i = 0; i < 4; ++i) { sl[2 * i] = *(const GAS f32x4*)(pl + (size_t)i * 32 * KVR); sl[2 * i + 1] = *(const GAS f32x4*)(pl + (size_t)i * 32 * KVR + 4); }
      sr[0] = *(const GAS f32x4*)prp; sr[1] = *(const GAS f32x4*)(prp + 16); }
#define SAMP_WRITE(buf) do { _Pragma("unroll") for (int i = 0; i < 4; ++i) *(LAS v4u*)((buf) + ldl[i]) = (v4u){cvtpk(sl[2*i].x, sl[2*i].y), cvtpk(sl[2*i].z, sl[2*i].w), cvtpk(sl[2*i+1].x, sl[2*i+1].y), cvtpk(sl[2*i+1].z, sl[2*i+1].w)}; \
        *(LAS v4u*)((buf) + ldr) = (v4u){cvtpk(sr[0].x, sr[1].x), cvtpk(sr[0].y, sr[1].y), cvtpk(sr[0].z, sr[1].z), cvtpk(sr[0].w, sr[1].w)}; } while (0)
    SAMP_WRITE(lds);
    __syncthreads();
    for (int p = 0; p < 64; ++p) {
        const bool more = p + 1 < 64;
        if (more) { const int pg = pt[p + 1]; const float* pl = cckv + (size_t)pg * (PAGE * KVR) + (size_t)(tid >> 4) * KVR + (tid & 15) * 8; const float* prp = ckr + (size_t)pg * (PAGE * RD) + (size_t)rrow * RD + (tid & 3) * 4;
#pragma unroll
            for (int i = 0; i < 4; ++i) { sl[2 * i] = *(const GAS f32x4*)(pl + (size_t)i * 32 * KVR); sl[2 * i + 1] = *(const GAS f32x4*)(pl + (size_t)i * 32 * KVR + 4); }
            sr[0] = *(const GAS f32x4*)prp; sr[1] = *(const GAS f32x4*)(prp + 16); }
        subtile<false>(lds + (p & 1) * PBUF + ks * SUB_BYTES, qf, mrun, lrun, o, lane, 0);
        if (more) { LAS unsigned char* nb = lds + ((p + 1) & 1) * PBUF; SAMP_WRITE(nb); }
        __syncthreads();
    }
#undef SAMP_WRITE
    if (sp == 0) {
        LAS unsigned char* nb = lds;
        { const int row = tid >> 4, ch = tid & 15; v4u v = {0u, 0u, 0u, 0u}; if (row < DS) v = *(const GAS v4u*)(CKVB + (size_t)(MP + b * DS + row) * KVR + ch * 8); *(LAS v4u*)(nb + img_off(row, ch)) = v; }
        if (tid < 128) { const int row = tid >> 2, c = tid & 3; v4u v = {0u, 0u, 0u, 0u}; if (row < DS) v = *(const GAS v4u*)(KRB + (size_t)(MP + b * DS + row) * RD + c * 8); *(LAS v4u*)(nb + img_off(row, 16 + c)) = v; }
        __syncthreads();
        if (ks == 0) subtile<true>(nb, qf, mrun, lrun, o, lane, tq);
        __syncthreads();
    }
    const float lt = lrun + __shfl_xor(lrun, 32);
    const int idx = b * 8 + sp * 4 + ks;
    if (h == 0) ((GAS f32x2*)PML)[(size_t)idx * 64 + qr] = (f32x2){mrun, lt};
    float* op = PO + ((size_t)idx * 64 + qr) * 128 + 4 * h;
#pragma unroll
    for (int d = 0; d < 4; ++d)
#pragma unroll
        for (int g = 0; g < 4; ++g) *(GAS f32x4*)(op + 32 * d + 8 * g) = (f32x4){o[d][4 * g], o[d][4 * g + 1], o[d][4 * g + 2], o[d][4 * g + 3]};
}
}

DI float rowsum16(float v) {
    v += __builtin_bit_cast(float, __builtin_amdgcn_update_dpp(0, __builtin_bit_cast(int, v), 0x128, 0xf, 0xf, false));
    v += __builtin_bit_cast(float, __builtin_amdgcn_update_dpp(0, __builtin_bit_cast(int, v), 0x124, 0xf, 0xf, false));
    v += __builtin_bit_cast(float, __builtin_amdgcn_update_dpp(0, __builtin_bit_cast(int, v), 0x122, 0xf, 0xf, false));
    v += __builtin_bit_cast(float, __builtin_amdgcn_update_dpp(0, __builtin_bit_cast(int, v), 0x121, 0xf, 0xf, false));
    return v;
}
constexpr int SCAN_STRIDE = 356, SCAN_CHUNK = 32, SCAN_PIECES = 89;
DI void scan_item(LAS unsigned char* lds, const float* SC5, const float* RKV, const float* SCAL, float* Y, const float* init, float* fin, int m0, int T, int hd, int half, int tid, int wave, int lane) {
    constexpr size_t ASZ = (size_t)M * RWD;
    const int j = lane & 15, rowl = wave * 4 + (lane >> 4), row = half * 32 + rowl;
    f32x4 s = init ? *(const GAS f32x4*)(init + (size_t)row * 64 + 4 * j) : (f32x4){0.f, 0.f, 0.f, 0.f};
    const int nchunk = (T + SCAN_CHUNK - 1) / SCAN_CHUNK;
    f32x4 stg[6];
#define SCAN_LOAD(c) do { const int nst_ = min(SCAN_CHUNK, T - (c) * SCAN_CHUNK); _Pragma("unroll") for (int i = 0; i < 6; ++i) { const int q = tid + 512 * i; if (q < nst_ * SCAN_PIECES) { \
        const int st = q / SCAN_PIECES, pc = q - st * SCAN_PIECES; const size_t mm = (size_t)(m0 + (c) * SCAN_CHUNK + st); const float* src; \
        if (pc < 80) src = SC5 + (size_t)(pc >> 4) * ASZ + mm * RWD + hd * 64 + (pc & 15) * 4; else if (pc < 88) src = RKV + mm * 1536 + 1024 + hd * 64 + half * 32 + (pc - 80) * 4; else src = SCAL + (mm * 8 + hd) * 4; \
        stg[i] = *(const GAS f32x4*)src; } } } while (0)
#define SCAN_WRITE(buf, c) do { const int nst_ = min(SCAN_CHUNK, T - (c) * SCAN_CHUNK); _Pragma("unroll") for (int i = 0; i < 6; ++i) { const int q = tid + 512 * i; if (q < nst_ * SCAN_PIECES) { \
        const int st = q / SCAN_PIECES, pc = q - st * SCAN_PIECES; const int dst = st * SCAN_STRIDE + (pc < 80 ? (pc >> 4) * 64 + (pc & 15) * 4 : pc < 88 ? 320 + (pc - 80) * 4 : 352); \
        *(LAS f32x4*)((LAS float*)(buf) + dst) = stg[i]; } } } while (0)
    constexpr int SBUF = SCAN_CHUNK * SCAN_STRIDE * 4;
    SCAN_LOAD(0); SCAN_WRITE(lds, 0);
    __syncthreads();
    for (int c = 0; c < nchunk; ++c) {
        const bool more = c + 1 < nchunk;
        if (more) SCAN_LOAD(c + 1);
        const LAS float* cb = (const LAS float*)(lds + (c & 1) * SBUF);
        const int nst = min(SCAN_CHUNK, T - c * SCAN_CHUNK);
        for (int st = 0; st < nst; ++st) {
            const LAS float* sb = cb + st * SCAN_STRIDE;
            const f32x4 a4 = *(const LAS f32x4*)(sb + 4 * j), wr4 = *(const LAS f32x4*)(sb + 64 + 4 * j), w4 = *(const LAS f32x4*)(sb + 128 + 4 * j), b4 = *(const LAS f32x4*)(sb + 192 + 4 * j), k4 = *(const LAS f32x4*)(sb + 256 + 4 * j);
            const float vv = sb[320 + rowl], br = sb[352], kr = sb[353];
            float sa = (s.x * a4.x + s.y * a4.y) + (s.z * a4.z + s.w * a4.w);
            float y1 = (s.x * wr4.x + s.y * wr4.y) + (s.z * wr4.z + s.w * wr4.w);
            sa = rowsum16(sa); y1 = rowsum16(y1);
            s = s * w4 + b4 * sa + k4 * vv;
            if (j == 0) Y[(size_t)(m0 + c * SCAN_CHUNK + st) * RWD + hd * 64 + row] = y1 + sa * br + vv * kr;
        }
        if (more) { LAS unsigned char* nb = lds + ((c + 1) & 1) * SBUF; SCAN_WRITE(nb, c + 1); }
        __syncthreads();
    }
#undef SCAN_LOAD
#undef SCAN_WRITE
    *(GAS f32x4*)(fin + (size_t)row * 64 + 4 * j) = s;
}

constexpr int Q_PSCAN = 64, Q_SATT = 256, Q_PATT = 1024, Q_SSCAN = 2048, Q_TOTAL = Q_PSCAN + Q_SATT + Q_PATT + Q_SSCAN;
DI void mixer_phase(const Ptrs& P, LAS unsigned char* lds, volatile LAS unsigned* MISC, gu32* ctl, int tid, int wave, int lane) {
    unsigned char* ws = P.ws;
    const bf16* QB = (const bf16*)(ws + WS_QB); const bf16* CKVB = (const bf16*)(ws + WS_CKVB); const bf16* KRB = (const bf16*)(ws + WS_KRB); bf16* OM = (bf16*)(ws + WS_OM);
    const float* SC5 = (const float*)(ws + WS_SC5); const float* RKV = (const float*)(ws + WS_RKV); const float* SCAL = (const float*)(ws + WS_SCAL); float* Y = (float*)(ws + WS_Y);
#define Q_POP() do { if (tid == 0) MISC[0] = __hip_atomic_fetch_add(ctl + CW_QHEAD, 1u, RLX_AGENT); __syncthreads(); it = (int)MISC[0]; __syncthreads(); it = __builtin_amdgcn_readfirstlane(it); } while (0)
    int it; Q_POP();
#ifndef MK_SKIP_PSCAN
    while (it < Q_PSCAN) {
        const int ch = it >> 1, half = it & 1, b = ch >> 3, hd = ch & 7;
        scan_item(lds, SC5, RKV, SCAL, Y, nullptr, P.out + O_WKVP + (size_t)ch * 4096, b * SEQ, SEQ, hd, half, tid, wave, lane);
        Q_POP(); }
#endif
#ifndef MK_SKIP_SATT
    while (it < Q_PSCAN + Q_SATT) {
        const int u = it - Q_PSCAN; att::sample_unit(lds, QB, CKVB, KRB, P.in[2], P.in[3], (const int*)P.in[6], (float*)(ws + WS_PO), (float*)(ws + WS_PML), u >> 1, u & 1, tid, wave, lane);
        Q_POP(); }
#endif
#ifndef MK_SKIP_PATT
    while (it < Q_PSCAN + Q_SATT + Q_PATT) {
        const int u = it - Q_PSCAN - Q_SATT; att::prompt_unit(lds, QB, CKVB, KRB, OM, u & 3, 255 - (u >> 2), tid, wave, lane);
        Q_POP(); }
#endif
#ifndef MK_SKIP_SSCAN
    while (it < Q_TOTAL) {
        const int u = it - Q_PSCAN - Q_SATT - Q_PATT, ch = u >> 1, half = u & 1, b = ch >> 3, hd = ch & 7;
        scan_item(lds, SC5, RKV, SCAL, Y, P.in[4] + (size_t)ch * 4096, P.out + O_WKVS + (size_t)ch * 4096, MP + b * DS, DS, hd, half, tid, wave, lane);
        Q_POP(); }
#endif
#undef Q_POP
}
constexpr int N_PHASES = 15;

__global__ void __launch_bounds__(NWAVES * 64, 2) mk_fwd(Args args) {
    extern __shared__ __attribute__((aligned(16))) unsigned char lds_raw[];
    LAS unsigned char* lds = (LAS unsigned char*)lds_raw;
    volatile LAS unsigned* MISC = (volatile LAS unsigned*)(lds + MISC_OFF);
    const int tid = threadIdx.x, lane = tid & 63, wave = __builtin_amdgcn_readfirstlane(tid >> 6);
    const int G = gridDim.x, bx = blockIdx.x;
    const int gw = bx * NWAVES + wave, NGW = G * NWAVES;
    unsigned char* ws = args.ws;
#define P (*args_here())
    gu32* ctl = (gu32*)(ws + WS_CTL);
    for (int u = tid; u < (LDS_BYTES - LDSCTL_OFF) / 4; u += NWAVES * 64) ((LAS unsigned*)(lds + LDSCTL_OFF))[u] = 0u;
    __syncthreads();
    const int lo = args.ph_lo, hi = args.ph_hi;
    const bool one_launch = (hi - lo) > 1;
    XcdBarrier bar; bar.bar = (unsigned*)(ctl + CW_BAR); bar.x = 0; bar.st = nullptr;
    if (one_launch) bar = xcd_barrier_post((unsigned*)(ctl + CW_BAR), MISC + 8);
#ifndef MK_ONLY
#define MK_ONLY -1
#endif
#define IN(k) ((MK_ONLY < 0 || (k) == MK_ONLY) && lo <= (k) && (k) < hi)
#define SEAM(k) do { if (IN(k) && IN((k) + 1)) xcd_barrier(bar); } while (0)
    bf16* XNB = (bf16*)(ws + WS_XNB); bf16* HB = (bf16*)(ws + WS_HB); float* Z = (float*)(ws + WS_Z); float* X1 = (float*)(ws + WS_X1); float* X2 = (float*)(ws + WS_X2);
    const float* cosT = (const float*)(ws + WS_ROPE); const float* sinT = cosT + ROPE_N * 16;

    if (IN(0)) { p0_prologue(P, lds, gw, NGW, wave, lane); SEAM(0); }
    if (IN(1)) {
        pg8::Gemm g{XNB, (const bf16*)(ws + WS_WGUA), M, 2 * FF, DM}; pg8::StaticOrder S; S.init(M, 2 * FF, G, bx);
        pg8::EpiSwiGLU E{HB, FF};
        pg8::gemm_phase<pg8::EpiSwiGLU, pg8::StaticOrder, true, true>(lds + RING_OFF, g, S, E); SEAM(1); }
    if (IN(2)) {
        pg8::Gemm g{HB, (const bf16*)(ws + WS_WDA), M, DM, FF}; pg8::StaticOrder S; S.init(M, DM, G, bx);
        pg8::EpiResid E{P.in[0], P.in[1], MP, Z, DM, ALPHA, 0.5f};
        pg8::gemm_phase<pg8::EpiResid, pg8::StaticOrder, true, true>(lds + RING_OFF, g, S, E); SEAM(2); }
    if (IN(3)) { ln_phase(Z, P.in[7], P.in[8], X1, XNB, gw, NGW, lane); SEAM(3); }
    if (IN(4)) {
        pg8::Gemm g{XNB, (const bf16*)(ws + WS_WIN), M, INP, DM}; pg8::StaticOrder S; S.init(M, INP, G, bx);
        pg8::EpiF32 E{(float*)(ws + WS_PROJ), INP};
        pg8::gemm_phase<pg8::EpiF32, pg8::StaticOrder, true, true>(lds + RING_OFF, g, S, E); SEAM(4); }
    if (IN(5)) { prep_a(P, gw, NGW, lane); SEAM(5); }
    if (IN(6)) {
#ifndef MK_P6_NOQ
        int k256 = 256; asm volatile("" : "+s"(k256));
        { pg8::Gemm g{(const bf16*)(ws + WS_CQN), (const bf16*)(ws + WS_WQ), M, 1280, k256}; pg8::StaticOrder S; S.init(M, 1280, G, bx);
          pg8::EpiQ E{(bf16*)(ws + WS_QB), cosT, sinT, QSCALE};
          pg8::gemm_phase<pg8::EpiQ, pg8::StaticOrder, true, true>(lds + RING_OFF, g, S, E); }
#endif
#ifndef MK_P6_NOL
        { pg8::Gemm g{(const bf16*)(ws + WS_LA), (const bf16*)(ws + WS_WL), M, 1536, k256}; pg8::StaticOrder S; S.init(M, 1536, G, bx);
          pg8::EpiF32 E{(float*)(ws + WS_LO), 1536};
          pg8::gemm_phase<pg8::EpiF32, pg8::StaticOrder, true, true>(lds + RING_OFF, g, S, E); }
#endif
        SEAM(6); }
    if (IN(7)) { prep_c(P, gw, NGW, lane); SEAM(7); }
    if (IN(8)) { mixer_phase(P, lds, MISC, ctl, tid, wave, lane); SEAM(8); }
    if (IN(9)) { post_phase(P, gw, NGW, lane); SEAM(9); }
    if (IN(10)) {
        pg8::Gemm g{(const bf16*)(ws + WS_OM), (const bf16*)(ws + WS_WO), M, DM, 1536}; pg8::StaticOrder S; S.init(M, DM, G, bx);
        pg8::EpiResid E{X1, X1, M, Z, DM, ALPHA, 1.0f};
        pg8::gemm_phase<pg8::EpiResid, pg8::StaticOrder, true, true>(lds + RING_OFF, g, S, E); SEAM(10); }
    if (IN(11)) { ln_phase(Z, P.in[30], P.in[31], X2, XNB, gw, NGW, lane); SEAM(11); }
    if (IN(12)) {
        pg8::Gemm g{XNB, (const bf16*)(ws + WS_WGUB), M, 2 * FF, DM}; pg8::StaticOrder S; S.init(M, 2 * FF, G, bx);
        pg8::EpiSwiGLU E{HB, FF};
        pg8::gemm_phase<pg8::EpiSwiGLU, pg8::StaticOrder, true, true>(lds + RING_OFF, g, S, E); SEAM(12); }
    if (IN(13)) {
        pg8::Gemm g{HB, (const bf16*)(ws + WS_WDB), M, DM, FF}; pg8::StaticOrder S; S.init(M, DM, G, bx);
        pg8::EpiResid E{X2, X2, M, Z, DM, ALPHA, 0.5f};
        pg8::gemm_phase<pg8::EpiResid, pg8::StaticOrder, true, true>(lds + RING_OFF, g, S, E); SEAM(13); }
    if (IN(14)) { ln_phase(Z, P.in[35], P.in[36], P.out + O_YP, nullptr, gw, NGW, lane); }
#undef IN
#undef SEAM
#undef P
}

#ifndef MK_PER_PHASE
#define MK_PER_PHASE 0
#endif
extern "C" void kernel_launch(void* const* d_in, const int* in_sizes, int n_in, void* d_out, int out_size, void* d_ws, size_t ws_size, hipStream_t stream) {
    static int grid = 0;
    if (grid == 0) {
        if (n_in != 37 || (size_t)out_size != O_END || ws_size < WS_END) { fprintf(stderr, "kernel_launch: unexpected shapes: n_in %d out %d ws %zu\n", n_in, out_size, ws_size); grid = -1; return; }
        int dev = 0, cus = 0, per_cu = 0;
        if (hipGetDevice(&dev) != hipSuccess || hipDeviceGetAttribute(&cus, hipDeviceAttributeMultiprocessorCount, dev) != hipSuccess) { grid = -1; return; }
        if (hipFuncSetAttribute((const void*)mk_fwd, hipFuncAttributeMaxDynamicSharedMemorySize, LDS_BYTES) != hipSuccess) { fprintf(stderr, "kernel_launch: hipFuncSetAttribute failed\n"); grid = -1; return; }
        if (hipOccupancyMaxActiveBlocksPerMultiprocessor(&per_cu, (const void*)mk_fwd, NWAVES * 64, LDS_BYTES) != hipSuccess || per_cu < 1) { fprintf(stderr, "kernel_launch: occupancy query says %d\n", per_cu); }
        (void)hipGetLastError();
        grid = cus;
    }
    if (grid < 0) return;
    if (hipMemsetAsync((char*)d_ws + WS_CTL, 0, CTL_ZERO_BYTES, stream) != hipSuccess) return;
    Args a{};
    for (int i = 0; i < 37; ++i) a.in[i] = (const float*)d_in[i];
    a.out = (float*)d_out; a.ws = (unsigned char*)d_ws;
#if MK_PER_PHASE
    for (int p = 0; p < N_PHASES; ++p) { a.ph_lo = p; a.ph_hi = p + 1; hipLaunchKernelGGL(mk_fwd, dim3(grid), dim3(NWAVES * 64), LDS_BYTES, stream, a); }
#else
    a.ph_lo = 0; a.ph_hi = N_PHASES;
    hipLaunchKernelGGL(mk_fwd, dim3(grid), dim3(NWAVES * 64), LDS_BYTES, stream, a);
#endif
    const hipError_t le = hipPeekAtLastError();
    if (le != hipSuccess) fprintf(stderr, "kernel_launch: launch failed: %s\n", hipGetErrorName(le));
}
```

```cpp
#include <hip/hip_runtime.h>
#include <cstdio>
#include <cstdint>
namespace pg8 {
#define PG8_LAS __attribute__((address_space(3)))
typedef unsigned short bf16_t;
typedef short bf16x8 __attribute__((ext_vector_type(8)));
typedef float f32x4 __attribute__((ext_vector_type(4)));
typedef unsigned u32x4 __attribute__((ext_vector_type(4)));
constexpr int BM = 256, BK = 64, HALF = 128, HTB = HALF * BK * 2  , STAGE_BYTES = 8 * HTB, NXCD = 8, WGM = 8;

__host__ __device__ __forceinline__ int lds_byte(int r, int c) { const int st = (r >> 4) * 2 + (c >> 5), rr = r & 15, cc = c & 31, ob = rr * 64 + cc * 2; return st * 1024 + (ob ^ (((ob >> 9) & 1) << 5)); }
__host__ __device__ __forceinline__ void stage_rc(int b, int& R, int& C) { const int st = b / 1024, sb = b % 1024, swz = sb ^ (((sb >> 9) & 1) << 5); R = (st >> 1) * 16 + swz / 64; C = (st & 1) * 32 + (swz % 64) / 2; }
__host__ __device__ __forceinline__ int perm32(int rho) { const int n = rho >> 4, i = rho & 15; return 8 * (i >> 2) + 4 * n + (i & 3); }

struct Unit { int pm, pn; };
struct Gemm { const bf16_t* A; const bf16_t* Bt; int M, N, K; };

struct StaticOrder {
    int nM, nN, nwg, G, c;
    __host__ __device__ void init(int M, int N, int G_, int c_) { nM = M / BM; nN = N / BM; nwg = nM * nN; G = G_; c = c_; }
    __host__ __device__ bool next(int i, Unit& u) const {
        const long L = (long)i * G + c; if (L >= nwg) return false;
        int wgid = (int)L; { const int q = nwg / NXCD, r = nwg % NXCD, xcd = wgid % NXCD, off = wgid / NXCD; wgid = (xcd < r ? xcd * (q + 1) : r * (q + 1) + (xcd - r) * q) + off; }
        const int nig = WGM * nN, gid = wgid / nig, fm = gid * WGM, gsz = (nM - fm) < WGM ? (nM - fm) : WGM;
        u.pm = fm + ((wgid % nig) % gsz); u.pn = (wgid % nig) / gsz; return true;
    }
    __device__ __forceinline__ void a_ready(const Unit&) const {}
    __device__ __forceinline__ void done(const Unit&) const {}
};
__device__ __forceinline__ unsigned cvt_pk_bf16(float lo, float hi) { unsigned r; asm volatile("v_cvt_pk_bf16_f32 %0, %1, %2" : "=v"(r) : "v"(lo), "v"(hi)); return r; }
__device__ __forceinline__ float silu_mul(float g, float u) { const float e = __builtin_amdgcn_exp2f(-1.4426950408889634f * g); return g * __builtin_amdgcn_rcpf(1.0f + e) * u; }

struct EpiSwiGLU {
    static constexpr bool PERM = true, AFTER_DRAIN = false;
    bf16_t* O; int ldo;
    __device__ __forceinline__ void operator()(const f32x4 (&acc)[2][2][4][2], const Unit& u, int wr, int wc, int fr, int fq) const {
        const int row0 = u.pm * BM + wr * 64 + fr, col0 = u.pn * HALF + wc * 32 + 8 * fq;
#pragma unroll
        for (int ai = 0; ai < 2; ++ai)
#pragma unroll
            for (int m = 0; m < 4; ++m) {
                bf16_t* rowp = O + (size_t)(row0 + ai * HALF + m * 16) * ldo + col0;
                const f32x4 g0 = acc[ai][0][m][0], g1 = acc[ai][0][m][1], u0 = acc[ai][1][m][0], u1 = acc[ai][1][m][1];
                u32x4 w;
                w.x = cvt_pk_bf16(silu_mul(g0[0], u0[0]), silu_mul(g0[1], u0[1])); w.y = cvt_pk_bf16(silu_mul(g0[2], u0[2]), silu_mul(g0[3], u0[3]));
                w.z = cvt_pk_bf16(silu_mul(g1[0], u1[0]), silu_mul(g1[1], u1[1])); w.w = cvt_pk_bf16(silu_mul(g1[2], u1[2]), silu_mul(g1[3], u1[3]));
                *(u32x4*)rowp = w;
            }
    }
};
struct EpiResid {
    static constexpr bool PERM = false, AFTER_DRAIN = false;
    const float* base0; const float* base1; int split; float* Z; int ldc; float alpha, sc;
    __device__ __forceinline__ void operator()(const f32x4 (&acc)[2][2][4][2], const Unit& u, int wr, int wc, int fr, int fq) const {
        const int row0 = u.pm * BM + wr * 64 + fr, col0 = u.pn * BM + wc * 32 + 4 * fq;
        const float* bp = (u.pm * BM < split) ? base0 : base1 - (size_t)split * ldc;
#pragma unroll
        for (int ai = 0; ai < 2; ++ai)
#pragma unroll
            for (int m = 0; m < 4; ++m) {
                const size_t off = (size_t)(row0 + ai * HALF + m * 16) * ldc + col0;
#pragma unroll
                for (int bj = 0; bj < 2; ++bj)
#pragma unroll
                    for (int n = 0; n < 2; ++n) { const size_t o = off + bj * HALF + n * 16; const f32x4 b = *(const f32x4*)(bp + o); *(f32x4*)(Z + o) = b * alpha + acc[ai][bj][m][n] * sc; }
            }
    }
};
struct EpiF32 {
    static constexpr bool PERM = false, AFTER_DRAIN = false;
    float* O; int ldc;
    __device__ __forceinline__ void operator()(const f32x4 (&acc)[2][2][4][2], const Unit& u, int wr, int wc, int fr, int fq) const {
        const int row0 = u.pm * BM + wr * 64 + fr, col0 = u.pn * BM + wc * 32 + 4 * fq;
#pragma unroll
        for (int ai = 0; ai < 2; ++ai)
#pragma unroll
            for (int m = 0; m < 4; ++m) {
                const size_t off = (size_t)(row0 + ai * HALF + m * 16) * ldc + col0;
#pragma unroll
                for (int bj = 0; bj < 2; ++bj)
#pragma unroll
                    for (int n = 0; n < 2; ++n) *(f32x4*)(O + off + bj * HALF + n * 16) = acc[ai][bj][m][n];
            }
    }
};
struct EpiQ {
    static constexpr bool PERM = true, AFTER_DRAIN = false;
    bf16_t* Q; const float* cosT; const float* sinT; float qscale;
    __device__ __forceinline__ void operator()(const f32x4 (&acc)[2][2][4][2], const Unit& u, int wr, int wc, int fr, int fq) const {
        const int row0 = u.pm * BM + wr * 64 + fr;
        if (u.pn < 4) {
#pragma unroll
            for (int ai = 0; ai < 2; ++ai)
#pragma unroll
                for (int m = 0; m < 4; ++m) {
                    const int row = row0 + ai * HALF + m * 16;
#pragma unroll
                    for (int bj = 0; bj < 2; ++bj) {
                        bf16_t* p = Q + (size_t)row * 1280 + (2 * u.pn + bj) * 160 + wc * 32 + 8 * fq;
                        const f32x4 v0 = acc[ai][bj][m][0] * qscale, v1 = acc[ai][bj][m][1] * qscale;
                        u32x4 w; w.x = cvt_pk_bf16(v0[0], v0[1]); w.y = cvt_pk_bf16(v0[2], v0[3]); w.z = cvt_pk_bf16(v1[0], v1[1]); w.w = cvt_pk_bf16(v1[2], v1[3]);
                        *(u32x4*)p = w;
                    }
                }
        } else {
#pragma unroll
            for (int ai = 0; ai < 2; ++ai)
#pragma unroll
                for (int m = 0; m < 4; ++m) {
                    const int row = row0 + ai * HALF + m * 16;
                    const int tix = row < 32768 ? (row & 8191) : 8192 + ((row - 32768) & 7);
                    const f32x4 c = *(const f32x4*)(cosT + tix * 16 + 4 * fq), s = *(const f32x4*)(sinT + tix * 16 + 4 * fq);
#pragma unroll
                    for (int bj = 0; bj < 2; ++bj) {
                        bf16_t* p = Q + (size_t)row * 1280 + (4 * bj + wc) * 160 + 128 + 8 * fq;
                        const f32x4 v0 = acc[ai][bj][m][0], v1 = acc[ai][bj][m][1];
                        u32x4 w;
                        w.x = cvt_pk_bf16((v0[0] * c[0] - v0[1] * s[0]) * qscale, (v0[0] * s[0] + v0[1] * c[0]) * qscale);
                        w.y = cvt_pk_bf16((v0[2] * c[1] - v0[3] * s[1]) * qscale, (v0[2] * s[1] + v0[3] * c[1]) * qscale);
                        w.z = cvt_pk_bf16((v1[0] * c[2] - v1[1] * s[2]) * qscale, (v1[0] * s[2] + v1[1] * c[2]) * qscale);
                        w.w = cvt_pk_bf16((v1[2] * c[3] - v1[3] * s[3]) * qscale, (v1[2] * s[3] + v1[3] * c[3]) * qscale);
                        *(u32x4*)p = w;
                    }
                }
        }
    }
};
template <class Epi, class Sched, bool ALIGN_EPI = false, bool SP2 = false>
__device__ __forceinline__ void gemm_phase(PG8_LAS unsigned char* lds, const Gemm g, const Sched& S, const Epi& E) {
    const int tid = threadIdx.x, wid = __builtin_amdgcn_readfirstlane(tid >> 6), lane = tid & 63, wr = wid >> 2, wc = wid & 3, fr = lane & 15, fq = lane >> 4;
    const int K = g.K, nt = K / BK;
    unsigned voffA[2], voffB[2];
#pragma unroll
    for (int i = 0; i < 2; ++i) { int R, C; stage_rc(tid * 16 + i * 8192, R, C); const int Rb = Epi::PERM ? ((R & ~31) + perm32(R & 31)) : R;
        voffA[i] = (unsigned)(R * K + C) * 2u; voffB[i] = (unsigned)(Rb * K + C) * 2u; }
    const size_t kstep = (size_t)(BK * 2);
    const size_t hstep = (size_t)HALF * K * 2;
    const size_t tstep = 2 * hstep;
    const unsigned ldsw = (unsigned)wid * 1024u;
    const int aoff = lds_byte(wr * 64 + fr, fq * 8), boff = lds_byte(wc * 32 + fr, fq * 8);
#define PG8_SA(b, h) (((b) * 2 + (h)) * HTB)
#define PG8_SB(b, h) ((4 + (b) * 2 + (h)) * HTB)
#define PG8_STAGE(bufoff, gbase, voff) do { _Pragma("unroll") for (int _i = 0; _i < 2; ++_i) \
        __builtin_amdgcn_global_load_lds((const unsigned*)((const char*)(gbase) + (voff)[_i]), (PG8_LAS unsigned*)(lds + (bufoff) + ldsw + _i * 8192), 16, 0, 0); } while (0)
#define PG8_LDA(dst, b, h) do { _Pragma("unroll") for (int m = 0; m < 4; ++m) _Pragma("unroll") for (int k = 0; k < 2; ++k) dst[m][k] = *(const PG8_LAS bf16x8*)(lds + PG8_SA(b, h) + aoff + m * 2048 + k * 1024); } while (0)
#define PG8_LDB(dst, b, h) do { _Pragma("unroll") for (int n = 0; n < 2; ++n) _Pragma("unroll") for (int k = 0; k < 2; ++k) dst[n][k] = *(const PG8_LAS bf16x8*)(lds + PG8_SB(b, h) + boff + n * 2048 + k * 1024); } while (0)
#define PG8_MMA(ai, bj, At, Bt) do { __builtin_amdgcn_s_setprio(1); _Pragma("unroll") for (int m = 0; m < 4; ++m) _Pragma("unroll") for (int n = 0; n < 2; ++n) _Pragma("unroll") for (int k = 0; k < 2; ++k) \
        acc[ai][bj][m][n] = __builtin_amdgcn_mfma_f32_16x16x32_bf16(Bt[n][k], At[m][k], acc[ai][bj][m][n], 0, 0, 0); __builtin_amdgcn_s_setprio(0); } while (0)
#define PG8_WAIT_V(n) asm volatile("s_waitcnt vmcnt(" #n ")" ::: "memory")
#define PG8_WAIT_L(n) asm volatile("s_waitcnt lgkmcnt(" #n ")" ::: "memory")
#define PG8_BAR __builtin_amdgcn_s_barrier()
#define PG8_SCHED __builtin_amdgcn_sched_barrier(0)
    Unit cur, nxt; int ui = 0;
    if (!S.next(0, cur)) return;
    f32x4 acc[2][2][4][2];
#pragma unroll
    for (int a = 0; a < 2; ++a)
#pragma unroll
        for (int b = 0; b < 2; ++b)
#pragma unroll
            for (int m = 0; m < 4; ++m)
#pragma unroll
                for (int n = 0; n < 2; ++n) acc[a][b][m][n] = (f32x4){0.f, 0.f, 0.f, 0.f};
    bf16x8 At[4][2], B0[2][2], B1[2][2];
    const char* cA = (const char*)g.A + (size_t)cur.pm * tstep; const char* cB = (const char*)g.Bt + (size_t)cur.pn * tstep;
    S.a_ready(cur);
    if constexpr (SP2) {
        PG8_STAGE(PG8_SB(0, 0), cB, voffB); PG8_STAGE(PG8_SB(0, 1), cB + hstep, voffB); PG8_STAGE(PG8_SA(0, 0), cA, voffA); PG8_STAGE(PG8_SA(0, 1), cA + hstep, voffA);
        if (wr == 1) PG8_BAR;
        PG8_WAIT_V(2); PG8_BAR;
        PG8_STAGE(PG8_SB(1, 0), cB + kstep, voffB); PG8_STAGE(PG8_SA(1, 0), cA + kstep, voffA); PG8_STAGE(PG8_SB(1, 1), cB + hstep + kstep, voffB);
        PG8_WAIT_V(6); PG8_BAR;
    } else {
        PG8_STAGE(PG8_SB(0, 0), cB, voffB); PG8_STAGE(PG8_SA(0, 0), cA, voffA); PG8_STAGE(PG8_SB(0, 1), cB + hstep, voffB); PG8_STAGE(PG8_SA(0, 1), cA + hstep, voffA);
        if (wr == 1) PG8_BAR;
        PG8_WAIT_V(4); PG8_BAR;
        PG8_STAGE(PG8_SB(1, 0), cB + kstep, voffB); PG8_STAGE(PG8_SA(1, 0), cA + kstep, voffA); PG8_STAGE(PG8_SB(1, 1), cB + hstep + kstep, voffB);
        PG8_WAIT_V(6); PG8_BAR;
    }
    for (;;) {
        const bool has_next = S.next(ui + 1, nxt);
        const char* nA = has_next ? (const char*)g.A + (size_t)nxt.pm * tstep : cA; const char* nB = has_next ? (const char*)g.Bt + (size_t)nxt.pn * tstep : cB;
        for (int t = 0; t < nt; t += 2) {
            const bool last = (t == nt - 2);
            const char* a1 = cA + (size_t)(t + 1) * kstep;
            const char* a2 = last ? nA : cA + (size_t)(t + 2) * kstep; const char* b2 = last ? nB : cB + (size_t)(t + 2) * kstep;
            const char* a3 = a2 + kstep; const char* b3 = b2 + kstep;
            if (last && has_next) S.a_ready(nxt);
            if constexpr (SP2) {
            PG8_LDB(B0, 0, 0); PG8_LDB(B1, 0, 1); PG8_SCHED; PG8_LDA(At, 0, 0); PG8_STAGE(PG8_SA(1, 1), a1 + hstep, voffA);
            PG8_WAIT_V(8); PG8_WAIT_L(0); PG8_BAR; PG8_MMA(0, 0, At, B0); PG8_MMA(0, 1, At, B1); PG8_BAR; PG8_SCHED;
            PG8_LDA(At, 0, 1); PG8_STAGE(PG8_SB(0, 0), b2, voffB); PG8_STAGE(PG8_SB(0, 1), b2 + hstep, voffB); PG8_STAGE(PG8_SA(0, 0), a2, voffA);
            PG8_WAIT_V(8); PG8_WAIT_L(0); PG8_BAR; PG8_MMA(1, 0, At, B0); PG8_MMA(1, 1, At, B1); PG8_BAR; PG8_SCHED;
            PG8_LDB(B0, 1, 0); PG8_LDB(B1, 1, 1); PG8_SCHED; PG8_LDA(At, 1, 0); PG8_STAGE(PG8_SA(0, 1), a2 + hstep, voffA);
            PG8_WAIT_V(8); PG8_WAIT_L(0); PG8_BAR; PG8_MMA(0, 0, At, B0); PG8_MMA(0, 1, At, B1); PG8_BAR; PG8_SCHED;
            PG8_LDA(At, 1, 1); PG8_STAGE(PG8_SB(1, 0), b3, voffB); PG8_STAGE(PG8_SB(1, 1), b3 + hstep, voffB); PG8_STAGE(PG8_SA(1, 0), a3, voffA);
            PG8_WAIT_V(8); PG8_WAIT_L(0); PG8_BAR; PG8_MMA(1, 0, At, B0); PG8_MMA(1, 1, At, B1); PG8_BAR; PG8_SCHED;
            } else {
            PG8_LDB(B0, 0, 0); PG8_SCHED; PG8_LDA(At, 0, 0); PG8_STAGE(PG8_SA(1, 1), a1 + hstep, voffA);
            PG8_WAIT_L(8); PG8_BAR; PG8_WAIT_L(0); PG8_MMA(0, 0, At, B0); PG8_BAR; PG8_SCHED;
            PG8_LDB(B1, 0, 1); PG8_STAGE(PG8_SB(0, 0), b2, voffB);
            PG8_BAR; PG8_WAIT_L(0); PG8_MMA(0, 1, At, B1); PG8_BAR;
            PG8_LDA(At, 0, 1); PG8_STAGE(PG8_SA(0, 0), a2, voffA);
            PG8_BAR; PG8_WAIT_L(0); PG8_MMA(1, 0, At, B0); PG8_BAR; PG8_SCHED;
            PG8_STAGE(PG8_SB(0, 1), b2 + hstep, voffB);
            PG8_WAIT_V(6); PG8_BAR; PG8_MMA(1, 1, At, B1); PG8_BAR;
            PG8_LDB(B0, 1, 0); PG8_SCHED; PG8_LDA(At, 1, 0); PG8_STAGE(PG8_SA(0, 1), a2 + hstep, voffA);
            PG8_WAIT_L(8); PG8_BAR; PG8_WAIT_L(0); PG8_MMA(0, 0, At, B0); PG8_BAR; PG8_SCHED;
            PG8_LDB(B1, 1, 1); PG8_STAGE(PG8_SB(1, 0), b3, voffB);
            PG8_BAR; PG8_WAIT_L(0); PG8_MMA(0, 1, At, B1); PG8_BAR;
            PG8_LDA(At, 1, 1); PG8_STAGE(PG8_SA(1, 0), a3, voffA);
            PG8_BAR; PG8_WAIT_L(0); PG8_MMA(1, 0, At, B0); PG8_BAR; PG8_SCHED;
            PG8_STAGE(PG8_SB(1, 1), b3 + hstep, voffB);
            PG8_WAIT_V(6); PG8_BAR; PG8_MMA(1, 1, At, B1); PG8_BAR;
            }
        }
        if constexpr (ALIGN_EPI) { if (wr == 0) PG8_BAR; }
        if constexpr (!Epi::AFTER_DRAIN) { E(acc, cur, wr, wc, fr, fq); S.done(cur); }
        if (!has_next) break;
#pragma unroll
        for (int a = 0; a < 2; ++a)
#pragma unroll
            for (int b = 0; b < 2; ++b)
#pragma unroll
                for (int m = 0; m < 4; ++m)
#pragma unroll
                    for (int n = 0; n < 2; ++n) acc[a][b][m][n] = (f32x4){0.f, 0.f, 0.f, 0.f};
        cur = nxt; cA = nA; cB = nB; ++ui;
        if constexpr (ALIGN_EPI) { if (wr == 1) PG8_BAR; }
    }
    PG8_WAIT_V(0);
    if constexpr (!ALIGN_EPI) { if (wr == 0) PG8_BAR; }
    PG8_BAR;
    if constexpr (Epi::AFTER_DRAIN) { E.fused(acc, cur, wr, wc, fr, fq, lds, wid, lane); S.done(cur); }
#undef PG8_SA
#undef PG8_SB
#undef PG8_STAGE
#undef PG8_LDA
#undef PG8_LDB
#undef PG8_MMA
#undef PG8_WAIT_V
#undef PG8_WAIT_L
#undef PG8_BAR
#undef PG8_SCHED
}
}
constexpr int NWAVES = 8;
constexpr int DM = 1024, SEQ = 8192, NB = 4, DB = 128, DS = 8, FF = 2816;
constexpr int MP = NB * SEQ, MS = DB * DS, M = MP + MS;
constexpr int QR = 256, KVR = 128, RD = 32, RWC = 1792, INC = 2208, INP = 2304, RWD = 512;
constexpr int NPAGE = 128, PAGE = 128;
constexpr float ALPHA = 1.189207115002721f;
constexpr float QSCALE = 0.10206207261596577f * 1.4426950408889634f;
constexpr float LN_EPS = 1e-5f, RMS_EPS = 1e-6f, GN_EPS = 64e-5f;
constexpr size_t O_YP = 0, O_YS = 33554432, O_CKVP = 34603008, O_KRP = 38797312, O_WKVP = 39845888, O_SHP = 39976960,
                 O_CKVS = 39984128, O_KRS = 40115200, O_WKVS = 40147968, O_SHS = 44342272, O_END = 44571648;
constexpr size_t MiB = 1u << 20;
constexpr size_t WS_CTL = 0, CTL_ZERO_BYTES = 1 * MiB;
constexpr size_t WS_WGUA = 2 * MiB, WS_WDA = 13 * MiB, WS_WGUB = 19 * MiB, WS_WDB = 30 * MiB, WS_WIN = 36 * MiB, WS_WQ = 41 * MiB, WS_WO = 42 * MiB, WS_WL = 45 * MiB, WS_ROPE = 46 * MiB;
constexpr size_t WS_XNB = 48 * MiB, WS_HB = 114 * MiB, WS_Z = 296 * MiB, WS_X1 = 428 * MiB, WS_X2 = 560 * MiB, WS_PROJ = 692 * MiB, WS_CQN = 989 * MiB, WS_QB = 1006 * MiB;
constexpr size_t WS_CKVB = 1089 * MiB, WS_KRB = 1098 * MiB, WS_RKV = 1101 * MiB, WS_LA = 1299 * MiB, WS_LO = 1316 * MiB, WS_SC5 = 1514 * MiB, WS_G = 1844 * MiB, WS_SCAL = 1910 * MiB;
constexpr size_t WS_Y = 1915 * MiB, WS_OM = 1981 * MiB, WS_PO = 2080 * MiB, WS_PML = 2112 * MiB, WS_END = 2113 * MiB;
constexpr int ROPE_N = 8200;
constexpr int CW_TMO = 0, CW_QHEAD = 64, CW_BAR = 4096;
constexpr int RING_OFF = 0, RING_BYTES = 131072, LDSCTL_OFF = RING_BYTES, MISC_OFF = LDSCTL_OFF + 320, LDS_BYTES = 147456;

#define GAS __attribute__((address_space(1)))
#define LAS __attribute__((address_space(3)))
typedef unsigned short bf16;
typedef unsigned v4u __attribute__((ext_vector_type(4)));
typedef unsigned v2u __attribute__((ext_vector_type(2)));
typedef float f32x4 __attribute__((ext_vector_type(4)));
typedef float f32x2 __attribute__((ext_vector_type(2)));
typedef short bf16x8 __attribute__((ext_vector_type(8)));
typedef short s16x4 __attribute__((ext_vector_type(4)));
typedef float f32x16 __attribute__((ext_vector_type(16)));
typedef GAS unsigned gu32;
#define RLX_AGENT __ATOMIC_RELAXED, __HIP_MEMORY_SCOPE_AGENT
#define DI __device__ __forceinline__
DI unsigned f2bf(float f) { unsigned u = __builtin_bit_cast(unsigned, f); return (u + 0x7fffu + ((u >> 16) & 1u)) >> 16; }
DI unsigned pk2(float lo, float hi) { return f2bf(lo) | (f2bf(hi) << 16); }
DI float wave_sum(float v) {
#pragma unroll
    for (int o = 1; o < 64; o <<= 1) v += __shfl_xor(v, o);
    return v;
}
#define XB_TMO      128
#define XB_XCNT(j)  (256  + 64 * (j))
#define XB_XSUB(j)  (1280 + 64 * (j))
#define XB_XGEN(j)  (2304 + 64 * (j))
#define XB_TOP      3328
#define XB_TOPGEN   3392
#define XCD_BAR_WORDS 3456
#define XB_SPIN_CAP (1u << 18)

__device__ __forceinline__ unsigned xb_ld(unsigned* p)              { return __hip_atomic_load(p, __ATOMIC_RELAXED, __HIP_MEMORY_SCOPE_AGENT); }
__device__ __forceinline__ unsigned xb_add(unsigned* p, unsigned v) { return __hip_atomic_fetch_add(p, v, __ATOMIC_RELAXED, __HIP_MEMORY_SCOPE_AGENT); }
__device__ __forceinline__ unsigned xb_xcc_id() { return (unsigned)__builtin_amdgcn_s_getreg((3 << 11) | 20) & 0xFu; }
#define XB_SPIN(cond, bar) do { unsigned _sp = 0; while (cond) { __builtin_amdgcn_s_sleep(1); \
    if ((++_sp & 255u) == 0u) { if (xb_ld(&(bar)[XB_TMO])) break; if (_sp > XB_SPIN_CAP) { atomicAdd(&(bar)[XB_TMO], 1u); break; } } } } while (0)

struct XcdBarrier {
    unsigned* bar; unsigned x;
    volatile LAS unsigned* st;
};

__device__ __forceinline__ XcdBarrier xcd_barrier_post(unsigned* bar, volatile LAS unsigned* st) {
    XcdBarrier b; b.bar = bar; b.x = xb_xcc_id(); b.st = st;
    if (threadIdx.x == 0) (void)xb_add(&bar[XB_XCNT(b.x)], 1u);
    return b;
}
__device__ __forceinline__ void xcd_barrier_complete(unsigned* bar, unsigned x, unsigned& nloc, unsigned& nx) {
    const unsigned G = gridDim.x * gridDim.y * gridDim.z;
    unsigned sum, cnt, mine, sp = 0u;
    for (;;) {
        sum = 0u; cnt = 0u; mine = 0u;
#pragma unroll
        for (unsigned j = 0; j < 16; ++j) { const unsigned c = xb_ld(&bar[XB_XCNT(j)]); sum += c; cnt += (c > 0u) ? 1u : 0u; mine = (j == x) ? c : mine; }
        if (sum == G) break;
        __builtin_amdgcn_s_sleep(1);
        if ((++sp & 255u) == 0u) { if (xb_ld(&bar[XB_TMO])) break; if (sp > XB_SPIN_CAP) { atomicAdd(&bar[XB_TMO], 1u); break; } }
    }
    nloc = mine > 0u ? mine : 1u; nx = cnt > 0u ? cnt : 1u;
}

__device__ __forceinline__ void xcd_barrier(const XcdBarrier& b) {
    asm volatile("s_waitcnt vmcnt(0)" ::: "memory");
    __syncthreads();
    if (threadIdx.x == 0) {
        unsigned* bar = b.bar;
        __builtin_amdgcn_s_waitcnt(0);
        unsigned nloc = b.st[0], nx = b.st[1];
        if (nloc == 0u) { xcd_barrier_complete(bar, b.x, nloc, nx); b.st[0] = nloc; b.st[1] = nx; }
        const unsigned old = xb_add(&bar[XB_XSUB(b.x)], 1u);
        const unsigned gen = old / nloc;
        if (old + 1u == (gen + 1u) * nloc) {
            __builtin_amdgcn_fence(__ATOMIC_RELEASE, "agent");
            asm volatile("s_waitcnt vmcnt(0)" ::: "memory");
            const unsigned og = xb_add(&bar[XB_TOP], 1u);
            const unsigned tg = og / nx;
            if (og + 1u == (tg + 1u) * nx) xb_add(&bar[XB_TOPGEN], 1u);
            else XB_SPIN(xb_ld(&bar[XB_TOPGEN]) == tg, bar);
            __builtin_amdgcn_fence(__ATOMIC_ACQUIRE, "agent");
            xb_add(&bar[XB_XGEN(b.x)], 1u);
            asm volatile("s_waitcnt vmcnt(0)" ::: "memory");
        } else {
            XB_SPIN(xb_ld(&bar[XB_XGEN(b.x)]) == gen, bar);
            __builtin_amdgcn_fence(__ATOMIC_ACQUIRE, "agent");
            asm volatile("s_waitcnt vmcnt(0)" ::: "memory");
        }
    }
    __syncthreads();
}
DI void p0_transpose_item(const float* W, int K, int N, bf16* WT, int kb, int nb, int drow0, LAS float* scr, int lane) {
    const int k0 = 64 * kb, n0 = 32 * nb;
#pragma unroll 8
    for (int i = 0; i < 32; ++i) { const int kk = 2 * i + (lane >> 5); scr[kk * 33 + (lane & 31)] = W[(size_t)(k0 + kk) * N + n0 + (lane & 31)]; }
    asm volatile("s_waitcnt lgkmcnt(0)" ::: "memory");
    const int c = lane & 7;
#pragma unroll
    for (int j = 0; j < 4; ++j) { const int n = (lane >> 3) + 8 * j; const LAS float* s = scr + (8 * c) * 33 + n;
        v4u o; o.x = pk2(s[0 * 33], s[1 * 33]); o.y = pk2(s[2 * 33], s[3 * 33]); o.z = pk2(s[4 * 33], s[5 * 33]); o.w = pk2(s[6 * 33], s[7 * 33]);
        *(GAS v4u*)(WT + (size_t)(drow0 + n) * K + k0 + 8 * c) = o; }
    asm volatile("s_waitcnt lgkmcnt(0)" ::: "memory");
}
DI int gu_row(int n, int up) { return 256 * (n >> 7) + (n & 127) + (up ? 128 : 0); }

DI void sincos_d(double r, double& s, double& c) {
    const double z = r * r;
    double ps = -9.18368986379554601e-29; ps = ps * z + 6.44695028438447359e-26; ps = ps * z - 3.86817017063068413e-23; ps = ps * z + 1.95729410633912626e-20; ps = ps * z - 8.22063524662432950e-18;
    ps = ps * z + 2.81145725434552060e-15; ps = ps * z - 7.64716373181981641e-13; ps = ps * z + 1.60590438368216133e-10; ps = ps * z - 2.50521083854417202e-08; ps = ps * z + 2.75573192239858925e-06;
    ps = ps * z - 1.98412698412698413e-04; ps = ps * z + 8.33333333333333322e-03; ps = ps * z - 1.66666666666666657e-01; ps = ps * z + 1.0; s = ps * r;
    double pc = 3.27988923706983776e-30; pc = pc * z - 2.47959626322479759e-27; pc = pc * z + 1.61173757109611839e-24; pc = pc * z - 8.89679139245057408e-22; pc = pc * z + 4.11031762331216484e-19;
    pc = pc * z - 1.56192069685862253e-16; pc = pc * z + 4.77947733238738525e-14; pc = pc * z - 1.14707455977297245e-11; pc = pc * z + 2.08767569878681002e-09; pc = pc * z - 2.75573192239858883e-07;
    pc = pc * z + 2.48015873015873016e-05; pc = pc * z - 1.38888888888888894e-03; pc = pc * z + 4.16666666666666644e-02; pc = pc * z - 0.5; pc = pc * z + 1.0; c = pc;
}

struct Args { const float* in[37]; float* out; unsigned char* ws; int ph_lo, ph_hi; };
static_assert(sizeof(Args) == 37 * 8 + 8 + 8 + 8, "Args has no padding");
typedef const __attribute__((address_space(4))) Args Ptrs;
DI Ptrs* args_here() { Ptrs* p = (Ptrs*)__builtin_amdgcn_kernarg_segment_ptr(); asm volatile("" : "+s"(p)); return p; }

DI void p0_prologue(const Ptrs& P, LAS unsigned char* lds, int gw, int NGW, int wave, int lane) {
    unsigned char* ws = P.ws;
    LAS float* scr = (LAS float*)(lds + RING_OFF + wave * 16384);
    constexpr int I_GU = (DM / 64) * (FF / 32), I_D = (FF / 64) * (DM / 32), I_IN = (DM / 64) * (INC / 32);
    constexpr int NITEMS = 6 * I_GU + I_IN;
    for (int it = gw; it < NITEMS; it += NGW) {
        int r = it;
        if (r < 4 * I_GU) {
            const int which = r / I_GU; r -= which * I_GU; const int nblk = FF / 32, kb = r / nblk, nb = r % nblk;
            const float* W = which == 0 ? P.in[9] : which == 1 ? P.in[10] : which == 2 ? P.in[32] : P.in[33];
            bf16* WT = (bf16*)(ws + (which < 2 ? WS_WGUA : WS_WGUB));
            p0_transpose_item(W, DM, FF, WT, kb, nb, gu_row(32 * nb, which & 1), scr, lane); continue; }
        r -= 4 * I_GU;
        if (r < 2 * I_D) { const int which = r / I_D; r -= which * I_D; const int nblk = DM / 32, kb = r / nblk, nb = r % nblk;
            p0_transpose_item(which ? P.in[34] : P.in[11], FF, DM, (bf16*)(ws + (which ? WS_WDB : WS_WDA)), kb, nb, 32 * nb, scr, lane); continue; }
        r -= 2 * I_D;
        { const int nblk = INC / 32, kb = r / nblk, nb = r % nblk; p0_transpose_item(P.in[12], DM, INC, (bf16*)(ws + WS_WIN), kb, nb, 32 * nb, scr, lane); }
    }
    const int gt = gw * 64 + lane, NGT = NGW * 64;
    { GAS v4u* z = (GAS v4u*)(ws + WS_WIN + (size_t)INC * DM * 2); for (int i = gt; i < (INP - INC) * DM * 2 / 16; i += NGT) z[i] = (v4u){0u, 0u, 0u, 0u}; }
    { bf16* WL = (bf16*)(ws + WS_WL); const float* wl = P.in[20]; const float* al = P.in[22]; const float* gl = P.in[23];
      for (int i = gt; i < 1536 * 256; i += NGT) { const int n = i >> 8, k = i & 255; float v = 0.f;
          if (n < 512) { if (k < 64) v = wl[k * 512 + n]; }
          else if (n < 1024) { if (k >= 64 && k < 128) v = al[(k - 64) * 512 + (n - 512)]; }
          else { if (k >= 128) v = gl[(k - 128) * 512 + (n - 1024)]; }
          WL[i] = (bf16)f2bf(v); } }
    { bf16* WQ = (bf16*)(ws + WS_WQ); const float* uq = P.in[14]; const float* uk = P.in[16];
      for (int i = gt; i < 1280 * 256; i += NGT) { const int n = i >> 8, c = i & 255; float v;
          if (n < 1024) { const int hd = n >> 7, r = n & 127; const float* a = uq + c * 768 + hd * 96; const float* b = uk + r * 512 + hd * 64; float s = 0.f;
              for (int j = 0; j < 64; ++j) s += a[j] * b[j]; v = s; }
          else { const int hd = (n - 1024) >> 5, cp = (n - 1024) & 31, p = (cp >> 1) + 16 * (cp & 1); v = uq[c * 768 + hd * 96 + 64 + p]; }
          WQ[i] = (bf16)f2bf(v); } }
    { bf16* WO = (bf16*)(ws + WS_WO); const float* uv = P.in[17]; const float* wo = P.in[29];
      for (int i = gt; i < 1536 * 1024; i += NGT) { const int k = i >> 10, n = i & 1023; float v;
          if (k < 1024) { const int hd = k >> 7, r = k & 127; const float* a = uv + r * 512 + hd * 64; const float* b = wo + (size_t)(hd * 64) * 1024 + n; float s = 0.f;
              for (int j = 0; j < 64; ++j) s += a[j] * b[(size_t)j * 1024]; v = s; }
          else v = wo[(size_t)(512 + k - 1024) * 1024 + n];
          WO[(size_t)n * 1536 + k] = (bf16)f2bf(v); } }
    { float* ct = (float*)(ws + WS_ROPE); float* st = ct + ROPE_N * 16;
      for (int i = gt; i < ROPE_N * 16; i += NGT) { const int tix = i >> 4, f = i & 15; const double pos = (double)(tix < 8192 ? tix : 16384 + (tix - 8192));
          double inv = 1.0; for (int q = 0; q < f; ++q) inv *= 0.5623413251903491;
          const double ang = pos * inv; const double kq = __builtin_rint(ang * 0.15915494309189535); const double r = __builtin_fma(-kq, 6.283185307179586, ang) - kq * 2.4492935982947064e-16;
          double s, c; sincos_d(r, s, c); ct[i] = (float)c; st[i] = (float)s; } }
    { bf16* XNB = (bf16*)(ws + WS_XNB);
      for (int m = gw; m < M; m += NGW) { const float* xr = m < MP ? P.in[0] + (size_t)m * DM : P.in[1] + (size_t)(m - MP) * DM;
          const GAS f32x4* x4 = (const GAS f32x4*)xr + lane; GAS v2u* o = (GAS v2u*)(XNB + (size_t)m * DM) + lane;
#pragma unroll
          for (int j = 0; j < 4; ++j) { const f32x4 v = x4[64 * j]; o[64 * j] = (v2u){pk2(v.x, v.y), pk2(v.z, v.w)}; } } }
}

DI void ln_phase(const float* Z, const float* g, const float* b, float* Xf, bf16* Xb, int gw, int NGW, int lane) {
    f32x4 gv[4], bv[4];
#pragma unroll
    for (int j = 0; j < 4; ++j) { gv[j] = ((const GAS f32x4*)g)[lane + 64 * j]; bv[j] = ((const GAS f32x4*)b)[lane + 64 * j]; }
    for (int m = gw; m < M; m += NGW) {
        const GAS f32x4* zr = (const GAS f32x4*)(Z + (size_t)m * DM) + lane;
        f32x4 v[4]; float s = 0.f;
#pragma unroll
        for (int j = 0; j < 4; ++j) { v[j] = zr[64 * j]; s += (v[j].x + v[j].y) + (v[j].z + v[j].w); }
        const float mean = wave_sum(s) * (1.f / DM); float s2 = 0.f;
#pragma unroll
        for (int j = 0; j < 4; ++j) { v[j] = v[j] - mean; s2 += (v[j].x * v[j].x + v[j].y * v[j].y) + (v[j].z * v[j].z + v[j].w * v[j].w); }
        const float rstd = 1.f / sqrtf(wave_sum(s2) * (1.f / DM) + LN_EPS);
#pragma unroll
        for (int j = 0; j < 4; ++j) { v[j] = v[j] * rstd * gv[j] + bv[j]; }
        if (Xf) { GAS f32x4* o = (GAS f32x4*)(Xf + (size_t)m * DM) + lane;
#pragma unroll
            for (int j = 0; j < 4; ++j) o[64 * j] = v[j]; }
        if (Xb) { GAS v2u* o = (GAS v2u*)(Xb + (size_t)m * DM) + lane;
#pragma unroll
            for (int j = 0; j < 4; ++j) o[64 * j] = (v2u){pk2(v[j].x, v[j].y), pk2(v[j].z, v[j].w)}; }
    }
}

DI void prep_a(const Ptrs& P, int gw, int NGW, int lane) {
    unsigned char* ws = P.ws;
    const float* PROJ = (const float*)(ws + WS_PROJ);
    bf16* CQN = (bf16*)(ws + WS_CQN); bf16* CKVB = (bf16*)(ws + WS_CKVB); bf16* KRB = (bf16*)(ws + WS_KRB);
    float* RKV = (float*)(ws + WS_RKV); bf16* LA = (bf16*)(ws + WS_LA);
    const float* ct = (const float*)(ws + WS_ROPE); const float* st = ct + ROPE_N * 16;
    const float* qg = P.in[13]; const float* kg = P.in[15]; const float* mu = P.in[18]; const float* sshift = P.in[5];
    const f32x4 qg4 = ((const GAS f32x4*)qg)[lane]; const f32x2 kg2 = ((const GAS f32x2*)kg)[lane];
    f32x4 mu4[7];
#pragma unroll
    for (int i = 0; i < 7; ++i) mu4[i] = ((const GAS f32x4*)mu)[lane + 64 * i];
    for (int m = gw; m < M; m += NGW) {
        const bool samp = m >= MP; const int ms = m - MP;
        const int bb = samp ? (ms >> 3) : (m >> 13), t = samp ? (ms & 7) : (m & 8191), tix = samp ? 8192 + t : t;
        const float* pr = PROJ + (size_t)m * INP;
        { const f32x4 v = ((const GAS f32x4*)pr)[lane]; const float ss = wave_sum((v.x * v.x + v.y * v.y) + (v.z * v.z + v.w * v.w));
          const float rs = 1.f / sqrtf(ss * (1.f / QR) + RMS_EPS);
          ((GAS v2u*)(CQN + (size_t)m * QR))[lane] = (v2u){pk2(v.x * rs * qg4.x, v.y * rs * qg4.y), pk2(v.z * rs * qg4.z, v.w * rs * qg4.w)}; }
        { const f32x2 v = ((const GAS f32x2*)(pr + QR))[lane]; const float ss = wave_sum(v.x * v.x + v.y * v.y);
          const float rs = 1.f / sqrtf(ss * (1.f / KVR) + RMS_EPS); const float a = v.x * rs * kg2.x, b = v.y * rs * kg2.y;
          float* o = samp ? P.out + O_CKVS + (size_t)ms * KVR : P.out + O_CKVP + (size_t)m * KVR;
          ((GAS f32x2*)o)[lane] = (f32x2){a, b}; ((GAS unsigned*)(CKVB + (size_t)m * KVR))[lane] = pk2(a, b); }
        { const int l31 = lane & 31; const float v = pr[QR + KVR + l31]; const float pv = __shfl_xor(v, 16); const int p = lane & 15;
          const float c = ct[tix * 16 + p], s = st[tix * 16 + p];
          const float o = (l31 < 16) ? v * c - pv * s : pv * s + v * c;
          if (lane < 32) { float* op = samp ? P.out + O_KRS + (size_t)ms * RD : P.out + O_KRP + (size_t)m * RD; op[lane] = o; }
          const float ohi = __shfl_down(o, 16);
          if (lane < 16) ((GAS unsigned*)(KRB + (size_t)m * RD))[lane] = pk2(o, ohi); }
        { const GAS f32x4* rw4 = (const GAS f32x4*)(pr + (INC - RWC));
          const GAS f32x4* pv4 = (t == 0) ? (samp ? (const GAS f32x4*)(sshift + (size_t)bb * RWC) : (const GAS f32x4*)nullptr) : (const GAS f32x4*)(pr - INP + (INC - RWC));
          const bool last = samp ? (t == DS - 1) : (t == SEQ - 1);
          float* sh = samp ? P.out + O_SHS + (size_t)bb * RWC : P.out + O_SHP + (size_t)bb * RWC;
#pragma unroll
          for (int i = 0; i < 7; ++i) {
              const f32x4 r = rw4[lane + 64 * i]; const f32x4 pv = pv4 ? pv4[lane + 64 * i] : (f32x4){0.f, 0.f, 0.f, 0.f};
              const f32x4 x = r + (pv - r) * mu4[i];
              if (last) ((GAS f32x4*)sh)[lane + 64 * i] = r;
              if (i < 6) ((GAS f32x4*)(RKV + (size_t)m * 1536))[lane + 64 * i] = x;
              else { f32x4 y;
                  if (lane < 16) { for (int j = 0; j < 4; ++j) { const float e = __expf(2.f * x[j]); y[j] = 1.f - 2.f / (e + 1.f); } }
                  else if (lane < 32) y = x;
                  else { for (int j = 0; j < 4; ++j) y[j] = 1.f / (1.f + __expf(-x[j])); }
                  ((GAS v2u*)(LA + (size_t)m * 256))[lane] = (v2u){pk2(y.x, y.y), pk2(y.z, y.w)}; }
          } }
    }
}

DI float red8(float v) { v += __shfl_xor(v, 1); v += __shfl_xor(v, 2); v += __shfl_xor(v, 4); return v; }
DI void prep_c(const Ptrs& P, int gw, int NGW, int lane) {
    unsigned char* ws = P.ws;
    const float* RKV = (const float*)(ws + WS_RKV); const float* LO = (const float*)(ws + WS_LO);
    float* SC5 = (float*)(ws + WS_SC5); float* G = (float*)(ws + WS_G); float* SCAL = (float*)(ws + WS_SCAL);
    constexpr size_t ASZ = (size_t)M * RWD;
    const int c0 = lane * 8;
    float w0v[8], a0v[8], kkv[8], kav[8], rkv[8];
#pragma unroll
    for (int j = 0; j < 8; ++j) { w0v[j] = P.in[19][c0 + j]; a0v[j] = P.in[21][c0 + j]; kkv[j] = P.in[24][c0 + j]; kav[j] = P.in[25][c0 + j]; rkv[j] = P.in[26][c0 + j]; }
    for (int m = gw; m < M; m += NGW) {
        const float* rk = RKV + (size_t)m * 1536 + c0; const float* lo = LO + (size_t)m * 1536 + c0;
        float r[8], k[8], wl[8], al[8], gl[8];
        { const f32x4 a = ((const GAS f32x4*)rk)[0], b = ((const GAS f32x4*)rk)[1]; r[0]=a.x; r[1]=a.y; r[2]=a.z; r[3]=a.w; r[4]=b.x; r[5]=b.y; r[6]=b.z; r[7]=b.w; }
        { const f32x4 a = ((const GAS f32x4*)(rk + 512))[0], b = ((const GAS f32x4*)(rk + 512))[1]; k[0]=a.x; k[1]=a.y; k[2]=a.z; k[3]=a.w; k[4]=b.x; k[5]=b.y; k[6]=b.z; k[7]=b.w; }
        { const f32x4 a = ((const GAS f32x4*)lo)[0], b = ((const GAS f32x4*)lo)[1]; wl[0]=a.x; wl[1]=a.y; wl[2]=a.z; wl[3]=a.w; wl[4]=b.x; wl[5]=b.y; wl[6]=b.z; wl[7]=b.w; }
        { const f32x4 a = ((const GAS f32x4*)(lo + 512))[0], b = ((const GAS f32x4*)(lo + 512))[1]; al[0]=a.x; al[1]=a.y; al[2]=a.z; al[3]=a.w; al[4]=b.x; al[5]=b.y; al[6]=b.z; al[7]=b.w; }
        { const f32x4 a = ((const GAS f32x4*)(lo + 1024))[0], b = ((const GAS f32x4*)(lo + 1024))[1]; gl[0]=a.x; gl[1]=a.y; gl[2]=a.z; gl[3]=a.w; gl[4]=b.x; gl[5]=b.y; gl[6]=b.z; gl[7]=b.w; }
        float dec[8], av[8], kk[8], kp[8]; float nn = 0.f;
#pragma unroll
        for (int j = 0; j < 8; ++j) {
            const float z = -(w0v[j] + wl[j]);
            const float sp = fmaxf(z, 0.f) + log1pf(__expf(-fabsf(z)));
            const float w = -sp - 0.5f; dec[j] = __expf(-__expf(w));
            av[j] = 1.f / (1.f + __expf(-(a0v[j] + al[j])));
            kk[j] = k[j] * kkv[j]; nn += kk[j] * kk[j];
            kp[j] = k[j] * (1.f + (av[j] - 1.f) * kav[j]);
        }
        nn = red8(nn); const float inv = 1.f / fmaxf(sqrtf(nn), 1e-12f);
        float as[8], bs[8], wr[8]; float br = 0.f, kr = 0.f, bon = 0.f;
#pragma unroll
        for (int j = 0; j < 8; ++j) { const float kn = kk[j] * inv; as[j] = -kn; bs[j] = kn * av[j]; wr[j] = dec[j] * r[j]; br += bs[j] * r[j]; kr += kp[j] * r[j]; bon += r[j] * kp[j] * rkv[j]; }
        br = red8(br); kr = red8(kr); bon = red8(bon);
        float* o = SC5 + (size_t)m * RWD + c0;
        ((GAS f32x4*)o)[0] = (f32x4){as[0], as[1], as[2], as[3]}; ((GAS f32x4*)o)[1] = (f32x4){as[4], as[5], as[6], as[7]}; o += ASZ;
        ((GAS f32x4*)o)[0] = (f32x4){wr[0], wr[1], wr[2], wr[3]}; ((GAS f32x4*)o)[1] = (f32x4){wr[4], wr[5], wr[6], wr[7]}; o += ASZ;
        ((GAS f32x4*)o)[0] = (f32x4){dec[0], dec[1], dec[2], dec[3]}; ((GAS f32x4*)o)[1] = (f32x4){dec[4], dec[5], dec[6], dec[7]}; o += ASZ;
        ((GAS f32x4*)o)[0] = (f32x4){bs[0], bs[1], bs[2], bs[3]}; ((GAS f32x4*)o)[1] = (f32x4){bs[4], bs[5], bs[6], bs[7]}; o += ASZ;
        ((GAS f32x4*)o)[0] = (f32x4){kp[0], kp[1], kp[2], kp[3]}; ((GAS f32x4*)o)[1] = (f32x4){kp[4], kp[5], kp[6], kp[7]};
        float* go = G + (size_t)m * RWD + c0;
        ((GAS f32x4*)go)[0] = (f32x4){gl[0], gl[1], gl[2], gl[3]}; ((GAS f32x4*)go)[1] = (f32x4){gl[4], gl[5], gl[6], gl[7]};
        if ((lane & 7) == 0) ((GAS f32x4*)(SCAL + ((size_t)m * 8 + (lane >> 3)) * 4))[0] = (f32x4){br, kr, bon, 0.f};
    }
}

DI void post_phase(const Ptrs& P, int gw, int NGW, int lane) {
    unsigned char* ws = P.ws;
    bf16* OM = (bf16*)(ws + WS_OM);
    { const float* PO = (const float*)(ws + WS_PO); const float* PML = (const float*)(ws + WS_PML);
      for (int it = gw; it < DB * 64; it += NGW) { const int b = it >> 6, qr = it & 63;
          float mi[8], li[8]; float mx = -3.0e38f;
#pragma unroll
          for (int s = 0; s < 8; ++s) { const f32x2 ml = ((const GAS f32x2*)PML)[(size_t)(b * 8 + s) * 64 + qr]; mi[s] = ml.x; li[s] = ml.y; mx = fmaxf(mx, ml.x); }
          float L = 0.f; f32x2 acc = {0.f, 0.f};
#pragma unroll
          for (int s = 0; s < 8; ++s) { const float w = __builtin_amdgcn_exp2f(mi[s] - mx); L += li[s] * w;
              const f32x2 o = ((const GAS f32x2*)(PO + ((size_t)(b * 8 + s) * 64 + qr) * 128))[lane]; acc += o * w; }
          const float inv = 1.f / L; const int tq = qr >> 3, hd = qr & 7;
          ((GAS unsigned*)(OM + (size_t)(MP + b * 8 + tq) * 1536 + hd * 128))[lane] = pk2(acc.x * inv, acc.y * inv); } }
    { const float* Y = (const float*)(ws + WS_Y); const float* RKV = (const float*)(ws + WS_RKV); const float* G = (const float*)(ws + WS_G); const float* SCAL = (const float*)(ws + WS_SCAL);
      const int c0 = lane * 8; float lg[8], lb[8];
#pragma unroll
      for (int j = 0; j < 8; ++j) { lg[j] = P.in[27][c0 + j]; lb[j] = P.in[28][c0 + j]; }
      for (int m = gw; m < M; m += NGW) {
          float y[8], v[8], g[8];
          { const GAS f32x4* p = (const GAS f32x4*)(Y + (size_t)m * RWD + c0); const f32x4 a = p[0], b = p[1]; y[0]=a.x; y[1]=a.y; y[2]=a.z; y[3]=a.w; y[4]=b.x; y[5]=b.y; y[6]=b.z; y[7]=b.w; }
          { const GAS f32x4* p = (const GAS f32x4*)(RKV + (size_t)m * 1536 + 1024 + c0); const f32x4 a = p[0], b = p[1]; v[0]=a.x; v[1]=a.y; v[2]=a.z; v[3]=a.w; v[4]=b.x; v[5]=b.y; v[6]=b.z; v[7]=b.w; }
          { const GAS f32x4* p = (const GAS f32x4*)(G + (size_t)m * RWD + c0); const f32x4 a = p[0], b = p[1]; g[0]=a.x; g[1]=a.y; g[2]=a.z; g[3]=a.w; g[4]=b.x; g[5]=b.y; g[6]=b.z; g[7]=b.w; }
          const float bon = SCAL[((size_t)m * 8 + (lane >> 3)) * 4 + 2];
          float s = 0.f;
#pragma unroll
          for (int j = 0; j < 8; ++j) s += y[j];
          const float mean = red8(s) * (1.f / 64.f); float q = 0.f;
#pragma unroll
          for (int j = 0; j < 8; ++j) { y[j] -= mean; q += y[j] * y[j]; }
          const float rstd = 1.f / sqrtf(red8(q) * (1.f / 64.f) + GN_EPS);
          float o[8];
#pragma unroll
          for (int j = 0; j < 8; ++j) o[j] = (y[j] * rstd * lg[j] + lb[j] + bon * v[j]) * g[j];
          *(GAS v4u*)(OM + (size_t)m * 1536 + 1024 + c0) = (v4u){pk2(o[0], o[1]), pk2(o[2], o[3]), pk2(o[4], o[5]), pk2(o[6], o[7])};
      } }
}
namespace att {
constexpr int KSTEP_B = 1152, SUB_BYTES = 10 * KSTEP_B;
DI unsigned img_off(unsigned row, unsigned ch) { return (unsigned)KSTEP_B * (ch >> 1) + 32u * row + 16u * ((ch & 1u) ^ ((row >> 3) & 1u)); }
DI unsigned kvmap(unsigned r) { return (r & ~12u) | ((r & 4u) << 1) | ((r & 8u) >> 1); }
DI unsigned row_base(unsigned lane) { const unsigned kr = kvmap(lane & 31u), h = lane >> 5; return 32u * kr + 16u * (h ^ ((kr >> 3) & 1u)); }
DI unsigned tr_base(unsigned lane) { const unsigned h = lane >> 5, blk = (lane >> 4) & 1u, q = (lane & 15u) >> 2, p = lane & 3u;
    return (unsigned)KSTEP_B * blk + 32u * (8u * h + q) + 16u * ((p >> 1) ^ h) + 8u * (p & 1u); }
DI unsigned cvtpk(float lo, float hi) { typedef float f2 __attribute__((ext_vector_type(2))); typedef __bf16 b2 __attribute__((ext_vector_type(2))); f2 v = {lo, hi}; b2 b = __builtin_convertvector(v, b2); return __builtin_bit_cast(unsigned, b); }
DI s16x4 vtr(const LAS unsigned char* p) { typedef short v4i16_t __attribute__((ext_vector_type(4))); return __builtin_bit_cast(s16x4, __builtin_amdgcn_ds_read_tr16_b64_v4i16((LAS v4i16_t*)p)); }
#define ATT_MFMA(a, b, c) __builtin_amdgcn_mfma_f32_32x32x16_bf16((a), (b), (c), 0, 0, 0)

constexpr float DEFER_THR = 8.0f;
DI float xhalf_max(float v) { auto rr = __builtin_amdgcn_permlane32_swap(__float_as_uint(v), __float_as_uint(v), false, false); return fmaxf(__uint_as_float(rr[0]), __uint_as_float(rr[1])); }
DI float xhalf_sum(float v) { auto rr = __builtin_amdgcn_permlane32_swap(__float_as_uint(v), __float_as_uint(v), false, false); return __uint_as_float(rr[0]) + __uint_as_float(rr[1]); }
DI bf16x8 pack8(const f32x16& x, int s) { v4u w; w.x = cvtpk(x[8 * s], x[8 * s + 1]); w.y = cvtpk(x[8 * s + 2], x[8 * s + 3]); w.z = cvtpk(x[8 * s + 4], x[8 * s + 5]); w.w = cvtpk(x[8 * s + 6], x[8 * s + 7]); return __builtin_bit_cast(bf16x8, w); }

template <bool MASK>
DI void subtile(const LAS unsigned char* img, const bf16x8 (&qf)[10], float& mrun, float& lrun, f32x16 (&o)[4], int lane, int qlim) {
    __builtin_amdgcn_sched_barrier(0);
    const unsigned h = lane >> 5;
    const LAS unsigned char* rb = img + row_base(lane); const LAS unsigned char* tb = img + tr_base(lane);
    f32x16 x;
#pragma unroll
    for (int i = 0; i < 16; ++i) x[i] = 0.f;
#pragma unroll
    for (int s = 0; s < 10; ++s) { const bf16x8 a = *(const LAS bf16x8*)(rb + KSTEP_B * s); x = ATT_MFMA(a, qf[s], x); }
    if (MASK) {
#pragma unroll
        for (int i = 0; i < 16; ++i) { const int kv = 16 * (i >> 3) + 8 * (int)h + (i & 7); if (kv > qlim) x[i] = -1e30f; }
    }
    float mx = x[0];
#pragma unroll
    for (int i = 1; i < 16; ++i) mx = fmaxf(mx, x[i]);
    mx = xhalf_max(mx);
    if (!__all(mx - mrun <= DEFER_THR)) {
        const float mn = fmaxf(mrun, mx), corr = __builtin_amdgcn_exp2f(mrun - mn); mrun = mn; lrun *= corr;
#pragma unroll
        for (int d = 0; d < 4; ++d)
#pragma unroll
            for (int i = 0; i < 16; ++i) o[d][i] *= corr;
    }
    float ls = 0.f;
#pragma unroll
    for (int i = 0; i < 16; ++i) { x[i] = __builtin_amdgcn_exp2f(x[i] - mrun); ls += x[i]; }
    lrun += ls;
    const bf16x8 pb0 = pack8(x, 0), pb1 = pack8(x, 1);
#pragma unroll
    for (int d = 0; d < 4; ++d) {
        { const s16x4 lo = vtr(tb + 2 * KSTEP_B * d), hi = vtr(tb + 2 * KSTEP_B * d + 128); o[d] = ATT_MFMA(__builtin_shufflevector(lo, hi, 0, 1, 2, 3, 4, 5, 6, 7), pb0, o[d]); }
        { const s16x4 lo = vtr(tb + 2 * KSTEP_B * d + 512), hi = vtr(tb + 2 * KSTEP_B * d + 512 + 128); o[d] = ATT_MFMA(__builtin_shufflevector(lo, hi, 0, 1, 2, 3, 4, 5, 6, 7), pb1, o[d]); }
    }
}
DI void tile64(const LAS unsigned char* img, const bf16x8 (&qf)[10], float& mrun, float& lrun, f32x16 (&o)[4], int lane) {
    __builtin_amdgcn_sched_barrier(0);
    const LAS unsigned char* rb = img + row_base(lane); const LAS unsigned char* tb = img + tr_base(lane);
    f32x16 p0, p1;
#pragma unroll
    for (int i = 0; i < 16; ++i) { p0[i] = 0.f; p1[i] = 0.f; }
#pragma unroll
    for (int s = 0; s < 10; ++s) {
        const bf16x8 a0 = *(const LAS bf16x8*)(rb + KSTEP_B * s), a1 = *(const LAS bf16x8*)(rb + SUB_BYTES + KSTEP_B * s);
        p0 = ATT_MFMA(a0, qf[s], p0); p1 = ATT_MFMA(a1, qf[s], p1);
    }
    float mx = fmaxf(p0[0], p1[0]);
#pragma unroll
    for (int i = 1; i < 16; ++i) mx = fmaxf(mx, fmaxf(p0[i], p1[i]));
    mx = xhalf_max(mx);
    if (!__all(mx - mrun <= DEFER_THR)) {
        const float mn = fmaxf(mrun, mx), corr = __builtin_amdgcn_exp2f(mrun - mn); mrun = mn; lrun *= corr;
#pragma unroll
        for (int d = 0; d < 4; ++d)
#pragma unroll
            for (int i = 0; i < 16; ++i) o[d][i] *= corr;
    }
    float ls = 0.f;
#pragma unroll
    for (int i = 0; i < 16; ++i) { p0[i] = __builtin_amdgcn_exp2f(p0[i] - mrun); ls += p0[i]; }
    const bf16x8 pa = pack8(p0, 0), pb = pack8(p0, 1);
#pragma unroll
    for (int d = 0; d < 4; ++d) {
        { const s16x4 lo = vtr(tb + 2 * KSTEP_B * d), hi = vtr(tb + 2 * KSTEP_B * d + 128); o[d] = ATT_MFMA(__builtin_shufflevector(lo, hi, 0, 1, 2, 3, 4, 5, 6, 7), pa, o[d]); }
        { const s16x4 lo = vtr(tb + 2 * KSTEP_B * d + 512), hi = vtr(tb + 2 * KSTEP_B * d + 512 + 128); o[d] = ATT_MFMA(__builtin_shufflevector(lo, hi, 0, 1, 2, 3, 4, 5, 6, 7), pb, o[d]); }
    }
#pragma unroll
    for (int i = 0; i < 16; ++i) { p1[i] = __builtin_amdgcn_exp2f(p1[i] - mrun); ls += p1[i]; }
    lrun += ls;
    const bf16x8 pc = pack8(p1, 0), pd = pack8(p1, 1);
#pragma unroll
    for (int d = 0; d < 4; ++d) {
        { const s16x4 lo = vtr(tb + SUB_BYTES + 2 * KSTEP_B * d), hi = vtr(tb + SUB_BYTES + 2 * KSTEP_B * d + 128); o[d] = ATT_MFMA(__builtin_shufflevector(lo, hi, 0, 1, 2, 3, 4, 5, 6, 7), pc, o[d]); }
        { const s16x4 lo = vtr(tb + SUB_BYTES + 2 * KSTEP_B * d + 512), hi = vtr(tb + SUB_BYTES + 2 * KSTEP_B * d + 512 + 128); o[d] = ATT_MFMA(__builtin_shufflevector(lo, hi, 0, 1, 2, 3, 4, 5, 6, 7), pd, o[d]); }
    }
}

DI void prompt_unit(LAS unsigned char* lds, const bf16* QB, const bf16* CKVB, const bf16* KRB, bf16* OM, int b, int qblk, int tid, int wave, int lane) {
    const int r = lane & 31, h = lane >> 5;
    const int row0 = b * SEQ + qblk * 32, kb = b * SEQ;
    bf16x8 qf[10];
    { const bf16* qp = QB + (size_t)(row0 + r) * 1280 + wave * 160 + 8 * h;
#pragma unroll
      for (int s = 0; s < 10; ++s) qf[s] = *(const GAS bf16x8*)(qp + 16 * s); }
    f32x16 o[4];
#pragma unroll
    for (int d = 0; d < 4; ++d)
#pragma unroll
        for (int i = 0; i < 16; ++i) o[d][i] = 0.f;
    float mrun = -1e30f, lrun = 0.f;
    const int nsub = qblk + 1, ntile = (nsub + 1) >> 1;
    const int lrow0 = tid >> 4, lch = tid & 15, lrow1 = lrow0 + 32;
    const unsigned ld0 = (unsigned)(lrow0 >> 5) * SUB_BYTES + img_off(lrow0 & 31, lch), ld1 = (unsigned)(lrow1 >> 5) * SUB_BYTES + img_off(lrow1 & 31, lch);
    const int rrow = tid >> 2, rc = tid & 3; const unsigned rd = (unsigned)(rrow >> 5) * SUB_BYTES + img_off(rrow & 31, 16 + rc);
    const bf16* g0 = CKVB + (size_t)(kb + lrow0) * KVR + lch * 8; const bf16* g1 = CKVB + (size_t)(kb + lrow1) * KVR + lch * 8; const bf16* g2 = KRB + (size_t)(kb + rrow) * RD + rc * 8;
    v4u s0 = *(const GAS v4u*)g0, s1 = *(const GAS v4u*)g1, s2 = (tid < 256) ? *(const GAS v4u*)g2 : (v4u){0u, 0u, 0u, 0u};
    *(LAS v4u*)(lds + ld0) = s0; *(LAS v4u*)(lds + ld1) = s1; if (tid < 256) *(LAS v4u*)(lds + rd) = s2;
    __syncthreads();
    const int nfull = qblk >> 1;
#define PU_LOAD(tn) do { const size_t adv = (size_t)(tn) * 64; s0 = *(const GAS v4u*)(g0 + adv * KVR); s1 = *(const GAS v4u*)(g1 + adv * KVR); if (tid < 256) s2 = *(const GAS v4u*)(g2 + adv * RD); } while (0)
#define PU_WRITE(par) do { LAS unsigned char* nb = lds + (par) * (2 * SUB_BYTES); *(LAS v4u*)(nb + ld0) = s0; *(LAS v4u*)(nb + ld1) = s1; if (tid < 256) *(LAS v4u*)(nb + rd) = s2; } while (0)
    for (int t = 0; t < nfull; ++t) {
        PU_LOAD(t + 1);
        const LAS unsigned char* img = lds + (t & 1) * (2 * SUB_BYTES);
        tile64(img, qf, mrun, lrun, o, lane);
        PU_WRITE((t + 1) & 1); __syncthreads();
    }
    { const LAS unsigned char* img = lds + (nfull & 1) * (2 * SUB_BYTES);
      if (qblk & 1) { subtile<false>(img, qf, mrun, lrun, o, lane, 0); img += SUB_BYTES; }
      subtile<true>(img, qf, mrun, lrun, o, lane, r);
      __syncthreads(); }
#undef PU_LOAD
#undef PU_WRITE
    const float inv = 1.f / xhalf_sum(lrun);
    bf16* op = OM + (size_t)(row0 + r) * 1536 + wave * 128 + 4 * h;
#pragma unroll
    for (int d = 0; d < 4; ++d)
#pragma unroll
        for (int g = 0; g < 4; ++g)
            *(GAS v2u*)(op + 32 * d + 8 * g) = (v2u){pk2(o[d][4 * g] * inv, o[d][4 * g + 1] * inv), pk2(o[d][4 * g + 2] * inv, o[d][4 * g + 3] * inv)};
}

DI void sample_unit(LAS unsigned char* lds, const bf16* QB, const bf16* CKVB, const bf16* KRB, const float* cckv, const float* ckr, const int* ptab, float* PO, float* PML,
                    int b, int sp, int tid, int wave, int lane) {
    const int r = lane & 31, h = lane >> 5, qt = wave & 1, ks = wave >> 1;
    const int qr = 32 * qt + r, tq = qr >> 3, hd = qr & 7;
    bf16x8 qf[10];
    { const bf16* qp = QB + (size_t)(MP + b * DS + tq) * 1280 + hd * 160 + 8 * h;
#pragma unroll
      for (int s = 0; s < 10; ++s) qf[s] = *(const GAS bf16x8*)(qp + 16 * s); }
    f32x16 o[4];
#pragma unroll
    for (int d = 0; d < 4; ++d)
#pragma unroll
        for (int i = 0; i < 16; ++i) o[d][i] = 0.f;
    float mrun = -1e30f, lrun = 0.f;
    constexpr int PBUF = 4 * SUB_BYTES;
    unsigned ldl[4];
#pragma unroll
    for (int i = 0; i < 4; ++i) { const int row = (tid >> 4) + 32 * i; ldl[i] = (unsigned)(row >> 5) * SUB_BYTES + img_off(row & 31, tid & 15); }
    const int rrow = tid >> 2; const unsigned ldr = (unsigned)(rrow >> 5) * SUB_BYTES + img_off(rrow & 31, 16 + (tid & 3));
    const int* pt = ptab + b * NPAGE + sp * 64;
    f32x4 sl[8], sr[2];
    { const int pg = pt[0]; const float* pl = cckv + (size_t)pg * (PAGE * KVR) + (size_t)(tid >> 4) * KVR + (tid & 15) * 8; const float* prp = ckr + (size_t)pg * (PAGE * RD) + (size_t)rrow * RD + (tid & 3) * 4;
#pragma unroll
      for (int i = 0; i < 4; ++i) { sl[2 * i] = *(const GAS f32x4*)(pl + (size_t)i * 32 * KVR); sl[2 * i + 1] = *(const GAS f32x4*)(pl + (size_t)i * 32 * KVR + 4); }
      sr[0] = *(const GAS f32x4*)prp; sr[1] = *(const GAS f32x4*)(prp + 16); }
#define SAMP_WRITE(buf) do { _Pragma("unroll") for (int i = 0; i < 4; ++i) *(LAS v4u*)((buf) + ldl[i]) = (v4u){cvtpk(sl[2*i].x, sl[2*i].y), cvtpk(sl[2*i].z, sl[2*i].w), cvtpk(sl[2*i+1].x, sl[2*i+1].y), cvtpk(sl[2*i+1].z, sl[2*i+1].w)}; \
        *(LAS v4u*)((buf) + ldr) = (v4u){cvtpk(sr[0].x, sr[1].x), cvtpk(sr[0].y, sr[1].y), cvtpk(sr[0].z, sr[1].z), cvtpk(sr[0].w, sr[1].w)}; } while (0)
    SAMP_WRITE(lds);
    __syncthreads();
    for (int p = 0; p < 64; ++p) {
        const bool more = p + 1 < 64;
        if (more) { const int pg = pt[p + 1]; const float* pl = cckv + (size_t)pg * (PAGE * KVR) + (size_t)(tid >> 4) * KVR + (tid & 15) * 8; const float* prp = ckr + (size_t)pg * (PAGE * RD) + (size_t)rrow * RD + (tid & 3) * 4;
#pragma unroll
            for (int i = 0; i < 4; ++i) { sl[2 * i] = *(const GAS f32x4*)(pl + (size_t)i * 32 * KVR); sl[2 * i + 1] = *(const GAS f32x4*)(pl + (size_t)i * 32 * KVR + 4); }
            sr[0] = *(const GAS f32x4*)prp; sr[1] = *(const GAS f32x4*)(prp + 16); }
        subtile<false>(lds + (p & 1) * PBUF + ks * SUB_BYTES, qf, mrun, lrun, o, lane, 0);
        if (more) { LAS unsigned char* nb = lds + ((p + 1) & 1) * PBUF; SAMP_WRITE(nb); }
        __syncthreads();
    }
#undef SAMP_WRITE
    if (sp == 0) {
        LAS unsigned char* nb = lds;
        { const int row = tid >> 4, ch = tid & 15; v4u v = {0u, 0u, 0u, 0u}; if (row < DS) v = *(const GAS v4u*)(CKVB + (size_t)(MP + b * DS + row) * KVR + ch * 8); *(LAS v4u*)(nb + img_off(row, ch)) = v; }
        if (tid < 128) { const int row = tid >> 2, c = tid & 3; v4u v = {0u, 0u, 0u, 0u}; if (row < DS) v = *(const GAS v4u*)(KRB + (size_t)(MP + b * DS + row) * RD + c * 8); *(LAS v4u*)(nb + img_off(row, 16 + c)) = v; }
        __syncthreads();
        if (ks == 0) subtile<true>(nb, qf, mrun, lrun, o, lane, tq);
        __syncthreads();
    }
    const float lt = xhalf_sum(lrun);
    const int idx = b * 8 + sp * 4 + ks;
    if (h == 0) ((GAS f32x2*)PML)[(size_t)idx * 64 + qr] = (f32x2){mrun, lt};
    float* op = PO + ((size_t)idx * 64 + qr) * 128 + 4 * h;
#pragma unroll
    for (int d = 0; d < 4; ++d)
#pragma unroll
        for (int g = 0; g < 4; ++g) *(GAS f32x4*)(op + 32 * d + 8 * g) = (f32x4){o[d][4 * g], o[d][4 * g + 1], o[d][4 * g + 2], o[d][4 * g + 3]};
}
}

DI float rowsum16(float v) {
    v += __builtin_bit_cast(float, __builtin_amdgcn_update_dpp(0, __builtin_bit_cast(int, v), 0x128, 0xf, 0xf, false));
    v += __builtin_bit_cast(float, __builtin_amdgcn_update_dpp(0, __builtin_bit_cast(int, v), 0x124, 0xf, 0xf, false));
    v += __builtin_bit_cast(float, __builtin_amdgcn_update_dpp(0, __builtin_bit_cast(int, v), 0x122, 0xf, 0xf, false));
    v += __builtin_bit_cast(float, __builtin_amdgcn_update_dpp(0, __builtin_bit_cast(int, v), 0x121, 0xf, 0xf, false));
    return v;
}
constexpr int SCAN_STRIDE = 340, SCAN_CHUNK = 32, SCAN_PIECES = 85;
constexpr int SCAN_BUF = SCAN_CHUNK * SCAN_STRIDE * 4, SCAN_YOFF = 2 * SCAN_BUF, SCAN_YBUF = SCAN_CHUNK * 16 * 4;
DI void scan_item(LAS unsigned char* lds, const float* SC5, const float* RKV, const float* SCAL, float* Y, const float* init, float* fin, int m0, int T, int hd, int quarter, int tid, int wave, int lane) {
    constexpr size_t ASZ = (size_t)M * RWD;
    const int j = lane & 15, rowl = (wave & 3) * 4 + (lane >> 4), row = quarter * 16 + rowl;
    const bool comp = wave < 4;
    f32x4 s = (f32x4){0.f, 0.f, 0.f, 0.f};
    if (comp && init) s = *(const GAS f32x4*)(init + (size_t)row * 64 + 4 * j);
    const int nchunk = (T + SCAN_CHUNK - 1) / SCAN_CHUNK;
    f32x4 stg[6];
#define SCAN_LOAD(c) do { const int nst_ = min(SCAN_CHUNK, T - (c) * SCAN_CHUNK); _Pragma("unroll") for (int i = 0; i < 6; ++i) { const int q = tid + 512 * i; if (q < nst_ * SCAN_PIECES) { \
        const int st = q / SCAN_PIECES, pc = q - st * SCAN_PIECES; const size_t mm = (size_t)(m0 + (c) * SCAN_CHUNK + st); const float* src; \
        if (pc < 80) src = SC5 + (size_t)(pc >> 4) * ASZ + mm * RWD + hd * 64 + (pc & 15) * 4; else if (pc < 84) src = RKV + mm * 1536 + 1024 + hd * 64 + quarter * 16 + (pc - 80) * 4; else src = SCAL + (mm * 8 + hd) * 4; \
        stg[i] = *(const GAS f32x4*)src; } } } while (0)
#define SCAN_WRITE(buf, c) do { const int nst_ = min(SCAN_CHUNK, T - (c) * SCAN_CHUNK); _Pragma("unroll") for (int i = 0; i < 6; ++i) { const int q = tid + 512 * i; if (q < nst_ * SCAN_PIECES) { \
        const int st = q / SCAN_PIECES, pc = q - st * SCAN_PIECES; const int dst = st * SCAN_STRIDE + (pc < 80 ? (pc >> 4) * 64 + (pc & 15) * 4 : pc < 84 ? 320 + (pc - 80) * 4 : 336); \
        *(LAS f32x4*)((LAS float*)(buf) + dst) = stg[i]; } } } while (0)
#define SCAN_FLUSH(c) do { const int nst_ = min(SCAN_CHUNK, T - (c) * SCAN_CHUNK); const int t_ = tid - 256, st = t_ >> 3, c2 = t_ & 7; if (st < nst_) { \
        const f32x2 yv = *(const LAS f32x2*)(lds + SCAN_YOFF + ((c) & 1) * SCAN_YBUF + (st * 16 + c2 * 2) * 4); \
        *(GAS f32x2*)(Y + (size_t)(m0 + (c) * SCAN_CHUNK + st) * RWD + hd * 64 + quarter * 16 + c2 * 2) = yv; } } while (0)
    SCAN_LOAD(0); SCAN_WRITE(lds, 0);
    __syncthreads();
    for (int c = 0; c < nchunk; ++c) {
        const bool more = c + 1 < nchunk;
        if (more) SCAN_LOAD(c + 1);
        if (comp) {
            const LAS float* cb = (const LAS float*)(lds + (c & 1) * SCAN_BUF) + 4 * j;
            LAS float* yb = (LAS float*)(lds + SCAN_YOFF + (c & 1) * SCAN_YBUF) + rowl;
            const int nst = min(SCAN_CHUNK, T - c * SCAN_CHUNK);
            f32x4 a4 = *(const LAS f32x4*)(cb), wr4 = *(const LAS f32x4*)(cb + 64), w4 = *(const LAS f32x4*)(cb + 128), b4 = *(const LAS f32x4*)(cb + 192), k4 = *(const LAS f32x4*)(cb + 256);
            float vv = cb[320 - 4 * j + rowl]; f32x2 sc = *(const LAS f32x2*)(cb + 336 - 4 * j);
#pragma unroll 2
            for (int st = 0; st < nst; ++st) {
                const LAS float* nb = cb + min(st + 1, nst - 1) * SCAN_STRIDE;
                const f32x4 na4 = *(const LAS f32x4*)(nb), nwr4 = *(const LAS f32x4*)(nb + 64), nw4 = *(const LAS f32x4*)(nb + 128), nb4 = *(const LAS f32x4*)(nb + 192), nk4 = *(const LAS f32x4*)(nb + 256);
                const float nvv = nb[320 - 4 * j + rowl]; const f32x2 nsc = *(const LAS f32x2*)(nb + 336 - 4 * j);
                float sa = (s.x * a4.x + s.y * a4.y) + (s.z * a4.z + s.w * a4.w);
                float y1 = (s.x * wr4.x + s.y * wr4.y) + (s.z * wr4.z + s.w * wr4.w);
                sa = rowsum16(sa); y1 = rowsum16(y1);
                s = s * w4 + b4 * sa + k4 * vv;
                const float y = y1 + sa * sc.x + vv * sc.y;
                if (j == 0) yb[st * 16] = y;
                a4 = na4; wr4 = nwr4; w4 = nw4; b4 = nb4; k4 = nk4; vv = nvv; sc = nsc;
            }
        } else if (c > 0) SCAN_FLUSH(c - 1);
        if (more) { LAS unsigned char* nbuf = lds + ((c + 1) & 1) * SCAN_BUF; SCAN_WRITE(nbuf, c + 1); }
        __syncthreads();
    }
    if (!comp) SCAN_FLUSH(nchunk - 1);
#undef SCAN_LOAD
#undef SCAN_WRITE
#undef SCAN_FLUSH
    if (comp) *(GAS f32x4*)(fin + (size_t)row * 64 + 4 * j) = s;
    __syncthreads();
}

constexpr int Q_PSCAN = 128, Q_SATT = 256, Q_PATT = 1024, Q_SSCAN = 4096, Q_TOTAL = Q_PSCAN + Q_SATT + Q_PATT + Q_SSCAN;
DI void mixer_phase(const Ptrs& P, LAS unsigned char* lds, volatile LAS unsigned* MISC, gu32* ctl, int tid, int wave, int lane) {
    unsigned char* ws = P.ws;
    const bf16* QB = (const bf16*)(ws + WS_QB); const bf16* CKVB = (const bf16*)(ws + WS_CKVB); const bf16* KRB = (const bf16*)(ws + WS_KRB); bf16* OM = (bf16*)(ws + WS_OM);
    const float* SC5 = (const float*)(ws + WS_SC5); const float* RKV = (const float*)(ws + WS_RKV); const float* SCAL = (const float*)(ws + WS_SCAL); float* Y = (float*)(ws + WS_Y);
#define Q_POP() do { if (tid == 0) MISC[0] = __hip_atomic_fetch_add(ctl + CW_QHEAD, 1u, RLX_AGENT); __syncthreads(); it = (int)MISC[0]; __syncthreads(); it = __builtin_amdgcn_readfirstlane(it); } while (0)
    int it; Q_POP();
#ifndef MK_SKIP_PSCAN
    while (it < Q_PSCAN) {
        const int ch = it >> 2, qtr = it & 3, b = ch >> 3, hd = ch & 7;
        scan_item(lds, SC5, RKV, SCAL, Y, nullptr, P.out + O_WKVP + (size_t)ch * 4096, b * SEQ, SEQ, hd, qtr, tid, wave, lane);
        Q_POP(); }
#endif
#ifndef MK_SKIP_SATT
    while (it < Q_PSCAN + Q_SATT) {
        const int u = it - Q_PSCAN; att::sample_unit(lds, QB, CKVB, KRB, P.in[2], P.in[3], (const int*)P.in[6], (float*)(ws + WS_PO), (float*)(ws + WS_PML), u >> 1, u & 1, tid, wave, lane);
        Q_POP(); }
#endif
#ifndef MK_SKIP_PATT
    while (it < Q_PSCAN + Q_SATT + Q_PATT) {
        const int u = it - Q_PSCAN - Q_SATT; att::prompt_unit(lds, QB, CKVB, KRB, OM, u & 3, 255 - (u >> 2), tid, wave, lane);
        Q_POP(); }
#endif
#ifndef MK_SKIP_SSCAN
    while (it < Q_TOTAL) {
        const int u = it - Q_PSCAN - Q_SATT - Q_PATT, ch = u >> 2, qtr = u & 3, b = ch >> 3, hd = ch & 7;
        scan_item(lds, SC5, RKV, SCAL, Y, P.in[4] + (size_t)ch * 4096, P.out + O_WKVS + (size_t)ch * 4096, MP + b * DS, DS, hd, qtr, tid, wave, lane);
        Q_POP(); }
#endif
#undef Q_POP
}
constexpr int N_PHASES = 15;
#ifndef MK_REP_MIX
#define MK_REP_MIX 1
#endif
#ifndef MK_REP_EW
#define MK_REP_EW 1
#endif
#ifndef MK_REP_GEMM
#define MK_REP_GEMM 1
#endif
#define DUP_1(x)
#define DUP_2(x) xcd_barrier(bar); x
#define DUP_CAT(a, b) a##b
#define DUP_SEL(n) DUP_CAT(DUP_, n)

__global__ void __launch_bounds__(NWAVES * 64, 2) mk_fwd(Args args) {
    extern __shared__ __attribute__((aligned(16))) unsigned char lds_raw[];
    LAS unsigned char* lds = (LAS unsigned char*)lds_raw;
    volatile LAS unsigned* MISC = (volatile LAS unsigned*)(lds + MISC_OFF);
    const int tid = threadIdx.x, lane = tid & 63, wave = __builtin_amdgcn_readfirstlane(tid >> 6);
    const int G = gridDim.x, bx = blockIdx.x;
    const int gw = bx * NWAVES + wave, NGW = G * NWAVES;
    unsigned char* ws = args.ws;
#define P (*args_here())
    gu32* ctl = (gu32*)(ws + WS_CTL);
    for (int u = tid; u < (LDS_BYTES - LDSCTL_OFF) / 4; u += NWAVES * 64) ((LAS unsigned*)(lds + LDSCTL_OFF))[u] = 0u;
    __syncthreads();
    const int lo = args.ph_lo, hi = args.ph_hi;
    const bool one_launch = (hi - lo) > 1;
    XcdBarrier bar; bar.bar = (unsigned*)(ctl + CW_BAR); bar.x = 0; bar.st = nullptr;
    if (one_launch) bar = xcd_barrier_post((unsigned*)(ctl + CW_BAR), MISC + 8);
#ifndef MK_ONLY
#define MK_ONLY -1
#endif
#define IN(k) ((MK_ONLY < 0 || (k) == MK_ONLY) && lo <= (k) && (k) < hi)
#define SEAM(k) do { if (IN(k) && IN((k) + 1)) xcd_barrier(bar); } while (0)
    bf16* XNB = (bf16*)(ws + WS_XNB); bf16* HB = (bf16*)(ws + WS_HB); float* Z = (float*)(ws + WS_Z); float* X1 = (float*)(ws + WS_X1); float* X2 = (float*)(ws + WS_X2);
    const float* cosT = (const float*)(ws + WS_ROPE); const float* sinT = cosT + ROPE_N * 16;

    if (IN(0)) { p0_prologue(P, lds, gw, NGW, wave, lane); SEAM(0); }
#define PH1_BODY do {    \
        pg8::Gemm g{XNB, (const bf16*)(ws + WS_WGUA), M, 2 * FF, DM}; pg8::StaticOrder S; S.init(M, 2 * FF, G, bx); \
        pg8::EpiSwiGLU E{HB, FF}; \
        pg8::gemm_phase<pg8::EpiSwiGLU, pg8::StaticOrder, true, true>(lds + RING_OFF, g, S, E); } while (0)
    if (IN(1)) { PH1_BODY; DUP_SEL(MK_REP_GEMM)(PH1_BODY;) SEAM(1); }
#define PH2_BODY do {    \
        pg8::Gemm g{HB, (const bf16*)(ws + WS_WDA), M, DM, FF}; pg8::StaticOrder S; S.init(M, DM, G, bx); \
        pg8::EpiResid E{P.in[0], P.in[1], MP, Z, DM, ALPHA, 0.5f}; \
        pg8::gemm_phase<pg8::EpiResid, pg8::StaticOrder, true, true>(lds + RING_OFF, g, S, E); } while (0)
    if (IN(2)) { PH2_BODY; DUP_SEL(MK_REP_GEMM)(PH2_BODY;) SEAM(2); }
#define PH3_BODY do { ln_phase(Z, P.in[7], P.in[8], X1, XNB, gw, NGW, lane); } while (0)
    if (IN(3)) { PH3_BODY; DUP_SEL(MK_REP_EW)(PH3_BODY;) SEAM(3); }
#define PH4_BODY do {    \
        pg8::Gemm g{XNB, (const bf16*)(ws + WS_WIN), M, INP, DM}; pg8::StaticOrder S; S.init(M, INP, G, bx); \
        pg8::EpiF32 E{(float*)(ws + WS_PROJ), INP}; \
        pg8::gemm_phase<pg8::EpiF32, pg8::StaticOrder, true, true>(lds + RING_OFF, g, S, E); } while (0)
    if (IN(4)) { PH4_BODY; DUP_SEL(MK_REP_GEMM)(PH4_BODY;) SEAM(4); }
#define PH5_BODY do { prep_a(P, gw, NGW, lane); } while (0)
    if (IN(5)) { PH5_BODY; DUP_SEL(MK_REP_EW)(PH5_BODY;) SEAM(5); }
#define PH6_BODY do {    \
        int k256 = 256; asm volatile("" : "+s"(k256));           \
        { pg8::Gemm g{(const bf16*)(ws + WS_CQN), (const bf16*)(ws + WS_WQ), M, 1280, k256}; pg8::StaticOrder S; S.init(M, 1280, G, bx); \
          pg8::EpiQ E{(bf16*)(ws + WS_QB), cosT, sinT, QSCALE}; \
          pg8::gemm_phase<pg8::EpiQ, pg8::StaticOrder, true, true>(lds + RING_OFF, g, S, E); } \
        { pg8::Gemm g{(const bf16*)(ws + WS_LA), (const bf16*)(ws + WS_WL), M, 1536, k256}; pg8::StaticOrder S; S.init(M, 1536, G, bx); \
          pg8::EpiF32 E{(float*)(ws + WS_LO), 1536}; \
          pg8::gemm_phase<pg8::EpiF32, pg8::StaticOrder, true, true>(lds + RING_OFF, g, S, E); } \
        } while (0)
    if (IN(6)) { PH6_BODY; DUP_SEL(MK_REP_GEMM)(PH6_BODY;) SEAM(6); }
#define PH7_BODY do { prep_c(P, gw, NGW, lane); } while (0)
    if (IN(7)) { PH7_BODY; DUP_SEL(MK_REP_EW)(PH7_BODY;) SEAM(7); }
    if (IN(8)) { mixer_phase(P, lds, MISC, ctl, tid, wave, lane); DUP_SEL(MK_REP_MIX)(mixer_phase(P, lds, MISC, ctl + 64, tid, wave, lane);) SEAM(8); }
#define PH9_BODY do { post_phase(P, gw, NGW, lane); } while (0)
    if (IN(9)) { PH9_BODY; DUP_SEL(MK_REP_EW)(PH9_BODY;) SEAM(9); }
#define PH10_BODY do {   \
        pg8::Gemm g{(const bf16*)(ws + WS_OM), (const bf16*)(ws + WS_WO), M, DM, 1536}; pg8::StaticOrder S; S.init(M, DM, G, bx); \
        pg8::EpiResid E{X1, X1, M, Z, DM, ALPHA, 1.0f}; \
        pg8::gemm_phase<pg8::EpiResid, pg8::StaticOrder, true, true>(lds + RING_OFF, g, S, E); } while (0)
    if (IN(10)) { PH10_BODY; DUP_SEL(MK_REP_GEMM)(PH10_BODY;) SEAM(10); }
#define PH11_BODY do { ln_phase(Z, P.in[30], P.in[31], X2, XNB, gw, NGW, lane); } while (0)
    if (IN(11)) { PH11_BODY; DUP_SEL(MK_REP_EW)(PH11_BODY;) SEAM(11); }
#define PH12_BODY do {   \
        pg8::Gemm g{XNB, (const bf16*)(ws + WS_WGUB), M, 2 * FF, DM}; pg8::StaticOrder S; S.init(M, 2 * FF, G, bx); \
        pg8::EpiSwiGLU E{HB, FF}; \
        pg8::gemm_phase<pg8::EpiSwiGLU, pg8::StaticOrder, true, true>(lds + RING_OFF, g, S, E); } while (0)
    if (IN(12)) { PH12_BODY; DUP_SEL(MK_REP_GEMM)(PH12_BODY;) SEAM(12); }
#define PH13_BODY do {   \
        pg8::Gemm g{HB, (const bf16*)(ws + WS_WDB), M, DM, FF}; pg8::StaticOrder S; S.init(M, DM, G, bx); \
        pg8::EpiResid E{X2, X2, M, Z, DM, ALPHA, 0.5f}; \
        pg8::gemm_phase<pg8::EpiResid, pg8::StaticOrder, true, true>(lds + RING_OFF, g, S, E); } while (0)
    if (IN(13)) { PH13_BODY; DUP_SEL(MK_REP_GEMM)(PH13_BODY;) SEAM(13); }
#define PH14_BODY do { ln_phase(Z, P.in[35], P.in[36], P.out + O_YP, nullptr, gw, NGW, lane); } while (0)
    if (IN(14)) { PH14_BODY; DUP_SEL(MK_REP_EW)(PH14_BODY;) }
#undef IN
#undef SEAM
#undef P
}

#ifndef MK_PER_PHASE
#define MK_PER_PHASE 0
#endif
extern "C" void kernel_launch(void* const* d_in, const int* in_sizes, int n_in, void* d_out, int out_size, void* d_ws, size_t ws_size, hipStream_t stream) {
    static int grid = 0;
    if (grid == 0) {
        if (n_in != 37 || (size_t)out_size != O_END || ws_size < WS_END) { fprintf(stderr, "kernel_launch: unexpected shapes: n_in %d out %d ws %zu\n", n_in, out_size, ws_size); grid = -1; return; }
        int dev = 0, cus = 0, per_cu = 0;
        if (hipGetDevice(&dev) != hipSuccess || hipDeviceGetAttribute(&cus, hipDeviceAttributeMultiprocessorCount, dev) != hipSuccess) { grid = -1; return; }
        if (hipFuncSetAttribute((const void*)mk_fwd, hipFuncAttributeMaxDynamicSharedMemorySize, LDS_BYTES) != hipSuccess) { fprintf(stderr, "kernel_launch: hipFuncSetAttribute failed\n"); grid = -1; return; }
        if (hipOccupancyMaxActiveBlocksPerMultiprocessor(&per_cu, (const void*)mk_fwd, NWAVES * 64, LDS_BYTES) != hipSuccess || per_cu < 1) { fprintf(stderr, "kernel_launch: occupancy query says %d\n", per_cu); }
        (void)hipGetLastError();
        grid = cus;
    }
    if (grid < 0) return;
    if (hipMemsetAsync((char*)d_ws + WS_CTL, 0, CTL_ZERO_BYTES, stream) != hipSuccess) return;
    Args a{};
    for (int i = 0; i < 37; ++i) a.in[i] = (const float*)d_in[i];
    a.out = (float*)d_out; a.ws = (unsigned char*)d_ws;
#if MK_PER_PHASE
    for (int p = 0; p < N_PHASES; ++p) { a.ph_lo = p; a.ph_hi = p + 1; hipLaunchKernelGGL(mk_fwd, dim3(grid), dim3(NWAVES * 64), LDS_BYTES, stream, a); }
#else
    a.ph_lo = 0; a.ph_hi = N_PHASES;
    hipLaunchKernelGGL(mk_fwd, dim3(grid), dim3(NWAVES * 64), LDS_BYTES, stream, a);
#endif
    const hipError_t le = hipPeekAtLastError();
    if (le != hipSuccess) fprintf(stderr, "kernel_launch: launch failed: %s\n", hipGetErrorName(le));
}
```

```cpp
#include <hip/hip_runtime.h>
#include <cstdio>
#include <cstdint>
namespace pg8 {
#define PG8_LAS __attribute__((address_space(3)))
typedef unsigned short bf16_t;
typedef short bf16x8 __attribute__((ext_vector_type(8)));
typedef float f32x4 __attribute__((ext_vector_type(4)));
typedef unsigned u32x4 __attribute__((ext_vector_type(4)));
constexpr int BM = 256, BK = 64, HALF = 128, HTB = HALF * BK * 2  , STAGE_BYTES = 8 * HTB, NXCD = 8, WGM = 8;

__host__ __device__ __forceinline__ int lds_byte(int r, int c) { const int st = (r >> 4) * 2 + (c >> 5), rr = r & 15, cc = c & 31, ob = rr * 64 + cc * 2; return st * 1024 + (ob ^ (((ob >> 9) & 1) << 5)); }
__host__ __device__ __forceinline__ void stage_rc(int b, int& R, int& C) { const int st = b / 1024, sb = b % 1024, swz = sb ^ (((sb >> 9) & 1) << 5); R = (st >> 1) * 16 + swz / 64; C = (st & 1) * 32 + (swz % 64) / 2; }
__host__ __device__ __forceinline__ int perm32(int rho) { const int n = rho >> 4, i = rho & 15; return 8 * (i >> 2) + 4 * n + (i & 3); }

struct Unit { int pm, pn; };
struct Gemm { const bf16_t* A; const bf16_t* Bt; int M, N, K; };

struct StaticOrder {
    int nM, nN, nwg, G, c;
    __host__ __device__ void init(int M, int N, int G_, int c_) { nM = M / BM; nN = N / BM; nwg = nM * nN; G = G_; c = c_; }
    __host__ __device__ bool next(int i, Unit& u) const {
        const long L = (long)i * G + c; if (L >= nwg) return false;
        int wgid = (int)L; { const int q = nwg / NXCD, r = nwg % NXCD, xcd = wgid % NXCD, off = wgid / NXCD; wgid = (xcd < r ? xcd * (q + 1) : r * (q + 1) + (xcd - r) * q) + off; }
        const int nig = WGM * nN, gid = wgid / nig, fm = gid * WGM, gsz = (nM - fm) < WGM ? (nM - fm) : WGM;
        u.pm = fm + ((wgid % nig) % gsz); u.pn = (wgid % nig) / gsz; return true;
    }
    __device__ __forceinline__ void a_ready(const Unit&) const {}
    __device__ __forceinline__ void done(const Unit&) const {}
};
__device__ __forceinline__ unsigned cvt_pk_bf16(float lo, float hi) { unsigned r; asm volatile("v_cvt_pk_bf16_f32 %0, %1, %2" : "=v"(r) : "v"(lo), "v"(hi)); return r; }
__device__ __forceinline__ float silu_mul(float g, float u) { const float e = __builtin_amdgcn_exp2f(-1.4426950408889634f * g); return g * __builtin_amdgcn_rcpf(1.0f + e) * u; }

struct EpiSwiGLU {
    static constexpr bool PERM = true, AFTER_DRAIN = false;
    bf16_t* O; int ldo;
    __device__ __forceinline__ void operator()(const f32x4 (&acc)[2][2][4][2], const Unit& u, int wr, int wc, int fr, int fq) const {
        const int row0 = u.pm * BM + wr * 64 + fr, col0 = u.pn * HALF + wc * 32 + 8 * fq;
#pragma unroll
        for (int ai = 0; ai < 2; ++ai)
#pragma unroll
            for (int m = 0; m < 4; ++m) {
                bf16_t* rowp = O + (size_t)(row0 + ai * HALF + m * 16) * ldo + col0;
                const f32x4 g0 = acc[ai][0][m][0], g1 = acc[ai][0][m][1], u0 = acc[ai][1][m][0], u1 = acc[ai][1][m][1];
                u32x4 w;
                w.x = cvt_pk_bf16(silu_mul(g0[0], u0[0]), silu_mul(g0[1], u0[1])); w.y = cvt_pk_bf16(silu_mul(g0[2], u0[2]), silu_mul(g0[3], u0[3]));
                w.z = cvt_pk_bf16(silu_mul(g1[0], u1[0]), silu_mul(g1[1], u1[1])); w.w = cvt_pk_bf16(silu_mul(g1[2], u1[2]), silu_mul(g1[3], u1[3]));
                *(u32x4*)rowp = w;
            }
    }
};
struct EpiResid {
    static constexpr bool PERM = false, AFTER_DRAIN = false;
    const float* base0; const float* base1; int split; float* Z; int ldc; float alpha, sc;
    __device__ __forceinline__ void operator()(const f32x4 (&acc)[2][2][4][2], const Unit& u, int wr, int wc, int fr, int fq) const {
        const int row0 = u.pm * BM + wr * 64 + fr, col0 = u.pn * BM + wc * 32 + 4 * fq;
        const float* bp = (u.pm * BM < split) ? base0 : base1 - (size_t)split * ldc;
#pragma unroll
        for (int ai = 0; ai < 2; ++ai)
#pragma unroll
            for (int m = 0; m < 4; ++m) {
                const size_t off = (size_t)(row0 + ai * HALF + m * 16) * ldc + col0;
#pragma unroll
                for (int bj = 0; bj < 2; ++bj)
#pragma unroll
                    for (int n = 0; n < 2; ++n) { const size_t o = off + bj * HALF + n * 16; const f32x4 b = *(const f32x4*)(bp + o); *(f32x4*)(Z + o) = b * alpha + acc[ai][bj][m][n] * sc; }
            }
    }
};
struct EpiF32 {
    static constexpr bool PERM = false, AFTER_DRAIN = false;
    float* O; int ldc;
    __device__ __forceinline__ void operator()(const f32x4 (&acc)[2][2][4][2], const Unit& u, int wr, int wc, int fr, int fq) const {
        const int row0 = u.pm * BM + wr * 64 + fr, col0 = u.pn * BM + wc * 32 + 4 * fq;
#pragma unroll
        for (int ai = 0; ai < 2; ++ai)
#pragma unroll
            for (int m = 0; m < 4; ++m) {
                const size_t off = (size_t)(row0 + ai * HALF + m * 16) * ldc + col0;
#pragma unroll
                for (int bj = 0; bj < 2; ++bj)
#pragma unroll
                    for (int n = 0; n < 2; ++n) *(f32x4*)(O + off + bj * HALF + n * 16) = acc[ai][bj][m][n];
            }
    }
};
struct EpiQ {
    static constexpr bool PERM = true, AFTER_DRAIN = false;
    bf16_t* Q; const float* cosT; const float* sinT; float qscale;
    __device__ __forceinline__ void operator()(const f32x4 (&acc)[2][2][4][2], const Unit& u, int wr, int wc, int fr, int fq) const {
        const int row0 = u.pm * BM + wr * 64 + fr;
        if (u.pn < 4) {
#pragma unroll
            for (int ai = 0; ai < 2; ++ai)
#pragma unroll
                for (int m = 0; m < 4; ++m) {
                    const int row = row0 + ai * HALF + m * 16;
#pragma unroll
                    for (int bj = 0; bj < 2; ++bj) {
                        bf16_t* p = Q + (size_t)row * 1280 + (2 * u.pn + bj) * 160 + wc * 32 + 8 * fq;
                        const f32x4 v0 = acc[ai][bj][m][0] * qscale, v1 = acc[ai][bj][m][1] * qscale;
                        u32x4 w; w.x = cvt_pk_bf16(v0[0], v0[1]); w.y = cvt_pk_bf16(v0[2], v0[3]); w.z = cvt_pk_bf16(v1[0], v1[1]); w.w = cvt_pk_bf16(v1[2], v1[3]);
                        *(u32x4*)p = w;
                    }
                }
        } else {
#pragma unroll
            for (int ai = 0; ai < 2; ++ai)
#pragma unroll
                for (int m = 0; m < 4; ++m) {
                    const int row = row0 + ai * HALF + m * 16;
                    const int tix = row < 32768 ? (row & 8191) : 8192 + ((row - 32768) & 7);
                    const f32x4 c = *(const f32x4*)(cosT + tix * 16 + 4 * fq), s = *(const f32x4*)(sinT + tix * 16 + 4 * fq);
#pragma unroll
                    for (int bj = 0; bj < 2; ++bj) {
                        bf16_t* p = Q + (size_t)row * 1280 + (4 * bj + wc) * 160 + 128 + 8 * fq;
                        const f32x4 v0 = acc[ai][bj][m][0], v1 = acc[ai][bj][m][1];
                        u32x4 w;
                        w.x = cvt_pk_bf16((v0[0] * c[0] - v0[1] * s[0]) * qscale, (v0[0] * s[0] + v0[1] * c[0]) * qscale);
                        w.y = cvt_pk_bf16((v0[2] * c[1] - v0[3] * s[1]) * qscale, (v0[2] * s[1] + v0[3] * c[1]) * qscale);
                        w.z = cvt_pk_bf16((v1[0] * c[2] - v1[1] * s[2]) * qscale, (v1[0] * s[2] + v1[1] * c[2]) * qscale);
                        w.w = cvt_pk_bf16((v1[2] * c[3] - v1[3] * s[3]) * qscale, (v1[2] * s[3] + v1[3] * c[3]) * qscale);
                        *(u32x4*)p = w;
                    }
                }
        }
    }
};
template <class Epi, class Sched, bool ALIGN_EPI = false, bool SP2 = false>
__device__ __forceinline__ void gemm_phase(PG8_LAS unsigned char* lds, const Gemm g, const Sched& S, const Epi& E) {
    const int tid = threadIdx.x, wid = __builtin_amdgcn_readfirstlane(tid >> 6), lane = tid & 63, wr = wid >> 2, wc = wid & 3, fr = lane & 15, fq = lane >> 4;
    const int K = g.K, nt = K / BK;
    unsigned voffA[2], voffB[2];
#pragma unroll
    for (int i = 0; i < 2; ++i) { int R, C; stage_rc(tid * 16 + i * 8192, R, C); const int Rb = Epi::PERM ? ((R & ~31) + perm32(R & 31)) : R;
        voffA[i] = (unsigned)(R * K + C) * 2u; voffB[i] = (unsigned)(Rb * K + C) * 2u; }
    const size_t kstep = (size_t)(BK * 2);
    const size_t hstep = (size_t)HALF * K * 2;
    const size_t tstep = 2 * hstep;
    const unsigned ldsw = (unsigned)wid * 1024u;
    const int aoff = lds_byte(wr * 64 + fr, fq * 8), boff = lds_byte(wc * 32 + fr, fq * 8);
#define PG8_SA(b, h) (((b) * 2 + (h)) * HTB)
#define PG8_SB(b, h) ((4 + (b) * 2 + (h)) * HTB)
#define PG8_STAGE(bufoff, gbase, voff) do { _Pragma("unroll") for (int _i = 0; _i < 2; ++_i) \
        __builtin_amdgcn_global_load_lds((const unsigned*)((const char*)(gbase) + (voff)[_i]), (PG8_LAS unsigned*)(lds + (bufoff) + ldsw + _i * 8192), 16, 0, 0); } while (0)
#define PG8_LDA(dst, b, h) do { _Pragma("unroll") for (int m = 0; m < 4; ++m) _Pragma("unroll") for (int k = 0; k < 2; ++k) dst[m][k] = *(const PG8_LAS bf16x8*)(lds + PG8_SA(b, h) + aoff + m * 2048 + k * 1024); } while (0)
#define PG8_LDB(dst, b, h) do { _Pragma("unroll") for (int n = 0; n < 2; ++n) _Pragma("unroll") for (int k = 0; k < 2; ++k) dst[n][k] = *(const PG8_LAS bf16x8*)(lds + PG8_SB(b, h) + boff + n * 2048 + k * 1024); } while (0)
#define PG8_MMA(ai, bj, At, Bt) do { __builtin_amdgcn_s_setprio(1); _Pragma("unroll") for (int m = 0; m < 4; ++m) _Pragma("unroll") for (int n = 0; n < 2; ++n) _Pragma("unroll") for (int k = 0; k < 2; ++k) \
        acc[ai][bj][m][n] = __builtin_amdgcn_mfma_f32_16x16x32_bf16(Bt[n][k], At[m][k], acc[ai][bj][m][n], 0, 0, 0); __builtin_amdgcn_s_setprio(0); } while (0)
#define PG8_WAIT_V(n) asm volatile("s_waitcnt vmcnt(" #n ")" ::: "memory")
#define PG8_WAIT_L(n) asm volatile("s_waitcnt lgkmcnt(" #n ")" ::: "memory")
#define PG8_BAR __builtin_amdgcn_s_barrier()
#define PG8_SCHED __builtin_amdgcn_sched_barrier(0)
    Unit cur, nxt; int ui = 0;
    if (!S.next(0, cur)) return;
    f32x4 acc[2][2][4][2];
#pragma unroll
    for (int a = 0; a < 2; ++a)
#pragma unroll
        for (int b = 0; b < 2; ++b)
#pragma unroll
            for (int m = 0; m < 4; ++m)
#pragma unroll
                for (int n = 0; n < 2; ++n) acc[a][b][m][n] = (f32x4){0.f, 0.f, 0.f, 0.f};
    bf16x8 At[4][2], B0[2][2], B1[2][2];
    const char* cA = (const char*)g.A + (size_t)cur.pm * tstep; const char* cB = (const char*)g.Bt + (size_t)cur.pn * tstep;
    S.a_ready(cur);
    if constexpr (SP2) {
        PG8_STAGE(PG8_SB(0, 0), cB, voffB); PG8_STAGE(PG8_SB(0, 1), cB + hstep, voffB); PG8_STAGE(PG8_SA(0, 0), cA, voffA); PG8_STAGE(PG8_SA(0, 1), cA + hstep, voffA);
        if (wr == 1) PG8_BAR;
        PG8_WAIT_V(2); PG8_BAR;
        PG8_STAGE(PG8_SB(1, 0), cB + kstep, voffB); PG8_STAGE(PG8_SA(1, 0), cA + kstep, voffA); PG8_STAGE(PG8_SB(1, 1), cB + hstep + kstep, voffB);
        PG8_WAIT_V(6); PG8_BAR;
    } else {
        PG8_STAGE(PG8_SB(0, 0), cB, voffB); PG8_STAGE(PG8_SA(0, 0), cA, voffA); PG8_STAGE(PG8_SB(0, 1), cB + hstep, voffB); PG8_STAGE(PG8_SA(0, 1), cA + hstep, voffA);
        if (wr == 1) PG8_BAR;
        PG8_WAIT_V(4); PG8_BAR;
        PG8_STAGE(PG8_SB(1, 0), cB + kstep, voffB); PG8_STAGE(PG8_SA(1, 0), cA + kstep, voffA); PG8_STAGE(PG8_SB(1, 1), cB + hstep + kstep, voffB);
        PG8_WAIT_V(6); PG8_BAR;
    }
    for (;;) {
        const bool has_next = S.next(ui + 1, nxt);
        const char* nA = has_next ? (const char*)g.A + (size_t)nxt.pm * tstep : cA; const char* nB = has_next ? (const char*)g.Bt + (size_t)nxt.pn * tstep : cB;
        for (int t = 0; t < nt; t += 2) {
            const bool last = (t == nt - 2);
            const char* a1 = cA + (size_t)(t + 1) * kstep;
            const char* a2 = last ? nA : cA + (size_t)(t + 2) * kstep; const char* b2 = last ? nB : cB + (size_t)(t + 2) * kstep;
            const char* a3 = a2 + kstep; const char* b3 = b2 + kstep;
            if (last && has_next) S.a_ready(nxt);
            if constexpr (SP2) {
            PG8_LDB(B0, 0, 0); PG8_LDB(B1, 0, 1); PG8_SCHED; PG8_LDA(At, 0, 0); PG8_STAGE(PG8_SA(1, 1), a1 + hstep, voffA);
            PG8_WAIT_V(8); PG8_WAIT_L(0); PG8_BAR; PG8_MMA(0, 0, At, B0); PG8_MMA(0, 1, At, B1); PG8_BAR; PG8_SCHED;
            PG8_LDA(At, 0, 1); PG8_STAGE(PG8_SB(0, 0), b2, voffB); PG8_STAGE(PG8_SB(0, 1), b2 + hstep, voffB); PG8_STAGE(PG8_SA(0, 0), a2, voffA);
            PG8_WAIT_V(8); PG8_WAIT_L(0); PG8_BAR; PG8_MMA(1, 0, At, B0); PG8_MMA(1, 1, At, B1); PG8_BAR; PG8_SCHED;
            PG8_LDB(B0, 1, 0); PG8_LDB(B1, 1, 1); PG8_SCHED; PG8_LDA(At, 1, 0); PG8_STAGE(PG8_SA(0, 1), a2 + hstep, voffA);
            PG8_WAIT_V(8); PG8_WAIT_L(0); PG8_BAR; PG8_MMA(0, 0, At, B0); PG8_MMA(0, 1, At, B1); PG8_BAR; PG8_SCHED;
            PG8_LDA(At, 1, 1); PG8_STAGE(PG8_SB(1, 0), b3, voffB); PG8_STAGE(PG8_SB(1, 1), b3 + hstep, voffB); PG8_STAGE(PG8_SA(1, 0), a3, voffA);
            PG8_WAIT_V(8); PG8_WAIT_L(0); PG8_BAR; PG8_MMA(1, 0, At, B0); PG8_MMA(1, 1, At, B1); PG8_BAR; PG8_SCHED;
            } else {
            PG8_LDB(B0, 0, 0); PG8_SCHED; PG8_LDA(At, 0, 0); PG8_STAGE(PG8_SA(1, 1), a1 + hstep, voffA);
            PG8_WAIT_L(8); PG8_BAR; PG8_WAIT_L(0); PG8_MMA(0, 0, At, B0); PG8_BAR; PG8_SCHED;
            PG8_LDB(B1, 0, 1); PG8_STAGE(PG8_SB(0, 0), b2, voffB);
            PG8_BAR; PG8_WAIT_L(0); PG8_MMA(0, 1, At, B1); PG8_BAR;
            PG8_LDA(At, 0, 1); PG8_STAGE(PG8_SA(0, 0), a2, voffA);
            PG8_BAR; PG8_WAIT_L(0); PG8_MMA(1, 0, At, B0); PG8_BAR; PG8_SCHED;
            PG8_STAGE(PG8_SB(0, 1), b2 + hstep, voffB);
            PG8_WAIT_V(6); PG8_BAR; PG8_MMA(1, 1, At, B1); PG8_BAR;
            PG8_LDB(B0, 1, 0); PG8_SCHED; PG8_LDA(At, 1, 0); PG8_STAGE(PG8_SA(0, 1), a2 + hstep, voffA);
            PG8_WAIT_L(8); PG8_BAR; PG8_WAIT_L(0); PG8_MMA(0, 0, At, B0); PG8_BAR; PG8_SCHED;
            PG8_LDB(B1, 1, 1); PG8_STAGE(PG8_SB(1, 0), b3, voffB);
            PG8_BAR; PG8_WAIT_L(0); PG8_MMA(0, 1, At, B1); PG8_BAR;
            PG8_LDA(At, 1, 1); PG8_STAGE(PG8_SA(1, 0), a3, voffA);
            PG8_BAR; PG8_WAIT_L(0); PG8_MMA(1, 0, At, B0); PG8_BAR; PG8_SCHED;
            PG8_STAGE(PG8_SB(1, 1), b3 + hstep, voffB);
            PG8_WAIT_V(6); PG8_BAR; PG8_MMA(1, 1, At, B1); PG8_BAR;
            }
        }
        if constexpr (ALIGN_EPI) { if (wr == 0) PG8_BAR; }
        if constexpr (!Epi::AFTER_DRAIN) { E(acc, cur, wr, wc, fr, fq); S.done(cur); }
        if (!has_next) break;
#pragma unroll
        for (int a = 0; a < 2; ++a)
#pragma unroll
            for (int b = 0; b < 2; ++b)
#pragma unroll
                for (int m = 0; m < 4; ++m)
#pragma unroll
                    for (int n = 0; n < 2; ++n) acc[a][b][m][n] = (f32x4){0.f, 0.f, 0.f, 0.f};
        cur = nxt; cA = nA; cB = nB; ++ui;
        if constexpr (ALIGN_EPI) { if (wr == 1) PG8_BAR; }
    }
    PG8_WAIT_V(0);
    if constexpr (!ALIGN_EPI) { if (wr == 0) PG8_BAR; }
    PG8_BAR;
    if constexpr (Epi::AFTER_DRAIN) { E.fused(acc, cur, wr, wc, fr, fq, lds, wid, lane); S.done(cur); }
#undef PG8_SA
#undef PG8_SB
#undef PG8_STAGE
#undef PG8_LDA
#undef PG8_LDB
#undef PG8_MMA
#undef PG8_WAIT_V
#undef PG8_WAIT_L
#undef PG8_BAR
#undef PG8_SCHED
}
}
constexpr int NWAVES = 8;
constexpr int DM = 1024, SEQ = 8192, NB = 4, DB = 128, DS = 8, FF = 2816;
constexpr int MP = NB * SEQ, MS = DB * DS, M = MP + MS;
constexpr int QR = 256, KVR = 128, RD = 32, RWC = 1792, INC = 2208, INP = 2304, RWD = 512;
constexpr int NPAGE = 128, PAGE = 128;
constexpr float ALPHA = 1.189207115002721f;
constexpr float QSCALE = 0.10206207261596577f * 1.4426950408889634f;
constexpr float LN_EPS = 1e-5f, RMS_EPS = 1e-6f, GN_EPS = 64e-5f;
constexpr size_t O_YP = 0, O_YS = 33554432, O_CKVP = 34603008, O_KRP = 38797312, O_WKVP = 39845888, O_SHP = 39976960,
                 O_CKVS = 39984128, O_KRS = 40115200, O_WKVS = 40147968, O_SHS = 44342272, O_END = 44571648;
constexpr size_t MiB = 1u << 20;
constexpr size_t WS_CTL = 0, CTL_ZERO_BYTES = 1 * MiB;
constexpr size_t WS_WGUA = 2 * MiB, WS_WDA = 13 * MiB, WS_WGUB = 19 * MiB, WS_WDB = 30 * MiB, WS_WIN = 36 * MiB, WS_WQ = 41 * MiB, WS_WO = 42 * MiB, WS_WL = 45 * MiB, WS_ROPE = 46 * MiB;
constexpr size_t WS_XNB = 48 * MiB, WS_HB = 114 * MiB, WS_Z = 296 * MiB, WS_X1 = 428 * MiB, WS_X2 = 560 * MiB, WS_PROJ = 692 * MiB, WS_CQN = 989 * MiB, WS_QB = 1006 * MiB;
constexpr size_t WS_CKVB = 1089 * MiB, WS_KRB = 1098 * MiB, WS_RKV = 1101 * MiB, WS_LA = 1299 * MiB, WS_LO = 1316 * MiB, WS_SC5 = 1514 * MiB, WS_G = 1844 * MiB, WS_SCAL = 1910 * MiB;
constexpr size_t WS_Y = 1915 * MiB, WS_OM = 1981 * MiB, WS_PO = 2080 * MiB, WS_PML = 2112 * MiB, WS_END = 2113 * MiB;
constexpr int ROPE_N = 8200;
constexpr int CW_TMO = 0, CW_QHEAD = 64, CW_BAR = 4096;
constexpr int RING_OFF = 0, RING_BYTES = 131072, LDSCTL_OFF = RING_BYTES, MISC_OFF = LDSCTL_OFF + 320, LDS_BYTES = 147456;

#define GAS __attribute__((address_space(1)))
#define LAS __attribute__((address_space(3)))
typedef unsigned short bf16;
typedef unsigned v4u __attribute__((ext_vector_type(4)));
typedef unsigned v2u __attribute__((ext_vector_type(2)));
typedef float f32x4 __attribute__((ext_vector_type(4)));
typedef float f32x2 __attribute__((ext_vector_type(2)));
typedef short bf16x8 __attribute__((ext_vector_type(8)));
typedef short s16x4 __attribute__((ext_vector_type(4)));
typedef float f32x16 __attribute__((ext_vector_type(16)));
typedef GAS unsigned gu32;
#define RLX_AGENT __ATOMIC_RELAXED, __HIP_MEMORY_SCOPE_AGENT
#define DI __device__ __forceinline__
DI unsigned f2bf(float f) { unsigned u = __builtin_bit_cast(unsigned, f); return (u + 0x7fffu + ((u >> 16) & 1u)) >> 16; }
DI unsigned pk2(float lo, float hi) { return f2bf(lo) | (f2bf(hi) << 16); }
DI float wave_sum(float v) {
#pragma unroll
    for (int o = 1; o < 64; o <<= 1) v += __shfl_xor(v, o);
    return v;
}
#define XB_TMO      128
#define XB_XCNT(j)  (256  + 64 * (j))
#define XB_XSUB(j)  (1280 + 64 * (j))
#define XB_XGEN(j)  (2304 + 64 * (j))
#define XB_TOP      3328
#define XB_TOPGEN   3392
#define XCD_BAR_WORDS 3456
#define XB_SPIN_CAP (1u << 18)

__device__ __forceinline__ unsigned xb_ld(unsigned* p)              { return __hip_atomic_load(p, __ATOMIC_RELAXED, __HIP_MEMORY_SCOPE_AGENT); }
__device__ __forceinline__ unsigned xb_add(unsigned* p, unsigned v) { return __hip_atomic_fetch_add(p, v, __ATOMIC_RELAXED, __HIP_MEMORY_SCOPE_AGENT); }
__device__ __forceinline__ unsigned xb_xcc_id() { return (unsigned)__builtin_amdgcn_s_getreg((3 << 11) | 20) & 0xFu; }
#define XB_SPIN(cond, bar) do { unsigned _sp = 0; while (cond) { __builtin_amdgcn_s_sleep(1); \
    if ((++_sp & 255u) == 0u) { if (xb_ld(&(bar)[XB_TMO])) break; if (_sp > XB_SPIN_CAP) { atomicAdd(&(bar)[XB_TMO], 1u); break; } } } } while (0)

struct XcdBarrier {
    unsigned* bar; unsigned x;
    volatile LAS unsigned* st;
};

__device__ __forceinline__ XcdBarrier xcd_barrier_post(unsigned* bar, volatile LAS unsigned* st) {
    XcdBarrier b; b.bar = bar; b.x = xb_xcc_id(); b.st = st;
    if (threadIdx.x == 0) (void)xb_add(&bar[XB_XCNT(b.x)], 1u);
    return b;
}
__device__ __forceinline__ void xcd_barrier_complete(unsigned* bar, unsigned x, unsigned& nloc, unsigned& nx) {
    const unsigned G = gridDim.x * gridDim.y * gridDim.z;
    unsigned sum, cnt, mine, sp = 0u;
    for (;;) {
        sum = 0u; cnt = 0u; mine = 0u;
#pragma unroll
        for (unsigned j = 0; j < 16; ++j) { const unsigned c = xb_ld(&bar[XB_XCNT(j)]); sum += c; cnt += (c > 0u) ? 1u : 0u; mine = (j == x) ? c : mine; }
        if (sum == G) break;
        __builtin_amdgcn_s_sleep(1);
        if ((++sp & 255u) == 0u) { if (xb_ld(&bar[XB_TMO])) break; if (sp > XB_SPIN_CAP) { atomicAdd(&bar[XB_TMO], 1u); break; } }
    }
    nloc = mine > 0u ? mine : 1u; nx = cnt > 0u ? cnt : 1u;
}

__device__ __forceinline__ void xcd_barrier(const XcdBarrier& b) {
    asm volatile("s_waitcnt vmcnt(0)" ::: "memory");
    __syncthreads();
    if (threadIdx.x == 0) {
        unsigned* bar = b.bar;
        __builtin_amdgcn_s_waitcnt(0);
        unsigned nloc = b.st[0], nx = b.st[1];
        if (nloc == 0u) { xcd_barrier_complete(bar, b.x, nloc, nx); b.st[0] = nloc; b.st[1] = nx; }
        const unsigned old = xb_add(&bar[XB_XSUB(b.x)], 1u);
        const unsigned gen = old / nloc;
        if (old + 1u == (gen + 1u) * nloc) {
            __builtin_amdgcn_fence(__ATOMIC_RELEASE, "agent");
            asm volatile("s_waitcnt vmcnt(0)" ::: "memory");
            const unsigned og = xb_add(&bar[XB_TOP], 1u);
            const unsigned tg = og / nx;
            if (og + 1u == (tg + 1u) * nx) xb_add(&bar[XB_TOPGEN], 1u);
            else XB_SPIN(xb_ld(&bar[XB_TOPGEN]) == tg, bar);
            __builtin_amdgcn_fence(__ATOMIC_ACQUIRE, "agent");
            xb_add(&bar[XB_XGEN(b.x)], 1u);
            asm volatile("s_waitcnt vmcnt(0)" ::: "memory");
        } else {
            XB_SPIN(xb_ld(&bar[XB_XGEN(b.x)]) == gen, bar);
            __builtin_amdgcn_fence(__ATOMIC_ACQUIRE, "agent");
            asm volatile("s_waitcnt vmcnt(0)" ::: "memory");
        }
    }
    __syncthreads();
}
DI void p0_transpose_item(const float* W, int K, int N, bf16* WT, int kb, int nb, int drow0, LAS float* scr, int lane) {
    const int k0 = 64 * kb, n0 = 32 * nb;
#pragma unroll 8
    for (int i = 0; i < 32; ++i) { const int kk = 2 * i + (lane >> 5); scr[kk * 33 + (lane & 31)] = W[(size_t)(k0 + kk) * N + n0 + (lane & 31)]; }
    asm volatile("s_waitcnt lgkmcnt(0)" ::: "memory");
    const int c = lane & 7;
#pragma unroll
    for (int j = 0; j < 4; ++j) { const int n = (lane >> 3) + 8 * j; const LAS float* s = scr + (8 * c) * 33 + n;
        v4u o; o.x = pk2(s[0 * 33], s[1 * 33]); o.y = pk2(s[2 * 33], s[3 * 33]); o.z = pk2(s[4 * 33], s[5 * 33]); o.w = pk2(s[6 * 33], s[7 * 33]);
        *(GAS v4u*)(WT + (size_t)(drow0 + n) * K + k0 + 8 * c) = o; }
    asm volatile("s_waitcnt lgkmcnt(0)" ::: "memory");
}
DI int gu_row(int n, int up) { return 256 * (n >> 7) + (n & 127) + (up ? 128 : 0); }

DI void sincos_d(double r, double& s, double& c) {
    const double z = r * r;
    double ps = -9.18368986379554601e-29; ps = ps * z + 6.44695028438447359e-26; ps = ps * z - 3.86817017063068413e-23; ps = ps * z + 1.95729410633912626e-20; ps = ps * z - 8.22063524662432950e-18;
    ps = ps * z + 2.81145725434552060e-15; ps = ps * z - 7.64716373181981641e-13; ps = ps * z + 1.60590438368216133e-10; ps = ps * z - 2.50521083854417202e-08; ps = ps * z + 2.75573192239858925e-06;
    ps = ps * z - 1.98412698412698413e-04; ps = ps * z + 8.33333333333333322e-03; ps = ps * z - 1.66666666666666657e-01; ps = ps * z + 1.0; s = ps * r;
    double pc = 3.27988923706983776e-30; pc = pc * z - 2.47959626322479759e-27; pc = pc * z + 1.61173757109611839e-24; pc = pc * z - 8.89679139245057408e-22; pc = pc * z + 4.11031762331216484e-19;
    pc = pc * z - 1.56192069685862253e-16; pc = pc * z + 4.77947733238738525e-14; pc = pc * z - 1.14707455977297245e-11; pc = pc * z + 2.08767569878681002e-09; pc = pc * z - 2.75573192239858883e-07;
    pc = pc * z + 2.48015873015873016e-05; pc = pc * z - 1.38888888888888894e-03; pc = pc * z + 4.16666666666666644e-02; pc = pc * z - 0.5; pc = pc * z + 1.0; c = pc;
}

struct Args { const float* in[37]; float* out; unsigned char* ws; int ph_lo, ph_hi; };
static_assert(sizeof(Args) == 37 * 8 + 8 + 8 + 8, "Args has no padding");
typedef const __attribute__((address_space(4))) Args Ptrs;
DI Ptrs* args_here() { Ptrs* p = (Ptrs*)__builtin_amdgcn_kernarg_segment_ptr(); asm volatile("" : "+s"(p)); return p; }

DI void p0_prologue(const Ptrs& P, LAS unsigned char* lds, int gw, int NGW, int wave, int lane) {
    unsigned char* ws = P.ws;
    LAS float* scr = (LAS float*)(lds + RING_OFF + wave * 16384);
    constexpr int I_GU = (DM / 64) * (FF / 32), I_D = (FF / 64) * (DM / 32), I_IN = (DM / 64) * (INC / 32);
    constexpr int NITEMS = 6 * I_GU + I_IN;
    for (int it = gw; it < NITEMS; it += NGW) {
        int r = it;
        if (r < 4 * I_GU) {
            const int which = r / I_GU; r -= which * I_GU; const int nblk = FF / 32, kb = r / nblk, nb = r % nblk;
            const float* W = which == 0 ? P.in[9] : which == 1 ? P.in[10] : which == 2 ? P.in[32] : P.in[33];
            bf16* WT = (bf16*)(ws + (which < 2 ? WS_WGUA : WS_WGUB));
            p0_transpose_item(W, DM, FF, WT, kb, nb, gu_row(32 * nb, which & 1), scr, lane); continue; }
        r -= 4 * I_GU;
        if (r < 2 * I_D) { const int which = r / I_D; r -= which * I_D; const int nblk = DM / 32, kb = r / nblk, nb = r % nblk;
            p0_transpose_item(which ? P.in[34] : P.in[11], FF, DM, (bf16*)(ws + (which ? WS_WDB : WS_WDA)), kb, nb, 32 * nb, scr, lane); continue; }
        r -= 2 * I_D;
        { const int nblk = INC / 32, kb = r / nblk, nb = r % nblk; p0_transpose_item(P.in[12], DM, INC, (bf16*)(ws + WS_WIN), kb, nb, 32 * nb, scr, lane); }
    }
    const int gt = gw * 64 + lane, NGT = NGW * 64;
    { GAS v4u* z = (GAS v4u*)(ws + WS_WIN + (size_t)INC * DM * 2); for (int i = gt; i < (INP - INC) * DM * 2 / 16; i += NGT) z[i] = (v4u){0u, 0u, 0u, 0u}; }
    { bf16* WL = (bf16*)(ws + WS_WL); const float* wl = P.in[20]; const float* al = P.in[22]; const float* gl = P.in[23];
      for (int i = gt; i < 1536 * 256; i += NGT) { const int n = i >> 8, k = i & 255; float v = 0.f;
          if (n < 512) { if (k < 64) v = wl[k * 512 + n]; }
          else if (n < 1024) { if (k >= 64 && k < 128) v = al[(k - 64) * 512 + (n - 512)]; }
          else { if (k >= 128) v = gl[(k - 128) * 512 + (n - 1024)]; }
          WL[i] = (bf16)f2bf(v); } }
    { bf16* WQ = (bf16*)(ws + WS_WQ); const float* uq = P.in[14]; const float* uk = P.in[16];
      for (int i = gt; i < 1280 * 256; i += NGT) { const int n = i >> 8, c = i & 255; float v;
          if (n < 1024) { const int hd = n >> 7, r = n & 127; const float* a = uq + c * 768 + hd * 96; const float* b = uk + r * 512 + hd * 64; float s = 0.f;
              for (int j = 0; j < 64; ++j) s += a[j] * b[j]; v = s; }
          else { const int hd = (n - 1024) >> 5, cp = (n - 1024) & 31, p = (cp >> 1) + 16 * (cp & 1); v = uq[c * 768 + hd * 96 + 64 + p]; }
          WQ[i] = (bf16)f2bf(v); } }
    { bf16* WO = (bf16*)(ws + WS_WO); const float* uv = P.in[17]; const float* wo = P.in[29];
      for (int i = gt; i < 1536 * 1024; i += NGT) { const int k = i >> 10, n = i & 1023; float v;
          if (k < 1024) { const int hd = k >> 7, r = k & 127; const float* a = uv + r * 512 + hd * 64; const float* b = wo + (size_t)(hd * 64) * 1024 + n; float s = 0.f;
              for (int j = 0; j < 64; ++j) s += a[j] * b[(size_t)j * 1024]; v = s; }
          else v = wo[(size_t)(512 + k - 1024) * 1024 + n];
          WO[(size_t)n * 1536 + k] = (bf16)f2bf(v); } }
    { float* ct = (float*)(ws + WS_ROPE); float* st = ct + ROPE_N * 16;
      for (int i = gt; i < ROPE_N * 16; i += NGT) { const int tix = i >> 4, f = i & 15; const double pos = (double)(tix < 8192 ? tix : 16384 + (tix - 8192));
          double inv = 1.0; for (int q = 0; q < f; ++q) inv *= 0.5623413251903491;
          const double ang = pos * inv; const double kq = __builtin_rint(ang * 0.15915494309189535); const double r = __builtin_fma(-kq, 6.283185307179586, ang) - kq * 2.4492935982947064e-16;
          double s, c; sincos_d(r, s, c); ct[i] = (float)c; st[i] = (float)s; } }
    { bf16* XNB = (bf16*)(ws + WS_XNB);
      for (int m = gw; m < M; m += NGW) { const float* xr = m < MP ? P.in[0] + (size_t)m * DM : P.in[1] + (size_t)(m - MP) * DM;
          const GAS f32x4* x4 = (const GAS f32x4*)xr + lane; GAS v2u* o = (GAS v2u*)(XNB + (size_t)m * DM) + lane;
#pragma unroll
          for (int j = 0; j < 4; ++j) { const f32x4 v = x4[64 * j]; o[64 * j] = (v2u){pk2(v.x, v.y), pk2(v.z, v.w)}; } } }
}

DI void ln_phase(const float* Z, const float* g, const float* b, float* Xf, bf16* Xb, int gw, int NGW, int lane) {
    f32x4 gv[4], bv[4];
#pragma unroll
    for (int j = 0; j < 4; ++j) { gv[j] = ((const GAS f32x4*)g)[lane + 64 * j]; bv[j] = ((const GAS f32x4*)b)[lane + 64 * j]; }
    for (int m = gw; m < M; m += NGW) {
        const GAS f32x4* zr = (const GAS f32x4*)(Z + (size_t)m * DM) + lane;
        f32x4 v[4]; float s = 0.f;
#pragma unroll
        for (int j = 0; j < 4; ++j) { v[j] = zr[64 * j]; s += (v[j].x + v[j].y) + (v[j].z + v[j].w); }
        const float mean = wave_sum(s) * (1.f / DM); float s2 = 0.f;
#pragma unroll
        for (int j = 0; j < 4; ++j) { v[j] = v[j] - mean; s2 += (v[j].x * v[j].x + v[j].y * v[j].y) + (v[j].z * v[j].z + v[j].w * v[j].w); }
        const float rstd = 1.f / sqrtf(wave_sum(s2) * (1.f / DM) + LN_EPS);
#pragma unroll
        for (int j = 0; j < 4; ++j) { v[j] = v[j] * rstd * gv[j] + bv[j]; }
        if (Xf) { GAS f32x4* o = (GAS f32x4*)(Xf + (size_t)m * DM) + lane;
#pragma unroll
            for (int j = 0; j < 4; ++j) o[64 * j] = v[j]; }
        if (Xb) { GAS v2u* o = (GAS v2u*)(Xb + (size_t)m * DM) + lane;
#pragma unroll
            for (int j = 0; j < 4; ++j) o[64 * j] = (v2u){pk2(v[j].x, v[j].y), pk2(v[j].z, v[j].w)}; }
    }
}

DI void prep_a(const Ptrs& P, int gw, int NGW, int lane) {
    unsigned char* ws = P.ws;
    const float* PROJ = (const float*)(ws + WS_PROJ);
    bf16* CQN = (bf16*)(ws + WS_CQN); bf16* CKVB = (bf16*)(ws + WS_CKVB); bf16* KRB = (bf16*)(ws + WS_KRB);
    float* RKV = (float*)(ws + WS_RKV); bf16* LA = (bf16*)(ws + WS_LA);
    const float* ct = (const float*)(ws + WS_ROPE); const float* st = ct + ROPE_N * 16;
    const float* qg = P.in[13]; const float* kg = P.in[15]; const float* mu = P.in[18]; const float* sshift = P.in[5];
    const f32x4 qg4 = ((const GAS f32x4*)qg)[lane]; const f32x2 kg2 = ((const GAS f32x2*)kg)[lane];
    f32x4 mu4[7];
#pragma unroll
    for (int i = 0; i < 7; ++i) mu4[i] = ((const GAS f32x4*)mu)[lane + 64 * i];
    for (int m = gw; m < M; m += NGW) {
        const bool samp = m >= MP; const int ms = m - MP;
        const int bb = samp ? (ms >> 3) : (m >> 13), t = samp ? (ms & 7) : (m & 8191), tix = samp ? 8192 + t : t;
        const float* pr = PROJ + (size_t)m * INP;
        { const f32x4 v = ((const GAS f32x4*)pr)[lane]; const float ss = wave_sum((v.x * v.x + v.y * v.y) + (v.z * v.z + v.w * v.w));
          const float rs = 1.f / sqrtf(ss * (1.f / QR) + RMS_EPS);
          ((GAS v2u*)(CQN + (size_t)m * QR))[lane] = (v2u){pk2(v.x * rs * qg4.x, v.y * rs * qg4.y), pk2(v.z * rs * qg4.z, v.w * rs * qg4.w)}; }
        { const f32x2 v = ((const GAS f32x2*)(pr + QR))[lane]; const float ss = wave_sum(v.x * v.x + v.y * v.y);
          const float rs = 1.f / sqrtf(ss * (1.f / KVR) + RMS_EPS); const float a = v.x * rs * kg2.x, b = v.y * rs * kg2.y;
          float* o = samp ? P.out + O_CKVS + (size_t)ms * KVR : P.out + O_CKVP + (size_t)m * KVR;
          ((GAS f32x2*)o)[lane] = (f32x2){a, b}; ((GAS unsigned*)(CKVB + (size_t)m * KVR))[lane] = pk2(a, b); }
        { const int l31 = lane & 31; const float v = pr[QR + KVR + l31]; const float pv = __shfl_xor(v, 16); const int p = lane & 15;
          const float c = ct[tix * 16 + p], s = st[tix * 16 + p];
          const float o = (l31 < 16) ? v * c - pv * s : pv * s + v * c;
          if (lane < 32) { float* op = samp ? P.out + O_KRS + (size_t)ms * RD : P.out + O_KRP + (size_t)m * RD; op[lane] = o; }
          const float ohi = __shfl_down(o, 16);
          if (lane < 16) ((GAS unsigned*)(KRB + (size_t)m * RD))[lane] = pk2(o, ohi); }
        { const GAS f32x4* rw4 = (const GAS f32x4*)(pr + (INC - RWC));
          const GAS f32x4* pv4 = (t == 0) ? (samp ? (const GAS f32x4*)(sshift + (size_t)bb * RWC) : (const GAS f32x4*)nullptr) : (const GAS f32x4*)(pr - INP + (INC - RWC));
          const bool last = samp ? (t == DS - 1) : (t == SEQ - 1);
          float* sh = samp ? P.out + O_SHS + (size_t)bb * RWC : P.out + O_SHP + (size_t)bb * RWC;
#pragma unroll
          for (int i = 0; i < 7; ++i) {
              const f32x4 r = rw4[lane + 64 * i]; const f32x4 pv = pv4 ? pv4[lane + 64 * i] : (f32x4){0.f, 0.f, 0.f, 0.f};
              const f32x4 x = r + (pv - r) * mu4[i];
              if (last) ((GAS f32x4*)sh)[lane + 64 * i] = r;
              if (i < 6) ((GAS f32x4*)(RKV + (size_t)m * 1536))[lane + 64 * i] = x;
              else { f32x4 y;
                  if (lane < 16) { for (int j = 0; j < 4; ++j) { const float e = __expf(2.f * x[j]); y[j] = 1.f - 2.f / (e + 1.f); } }
                  else if (lane < 32) y = x;
                  else { for (int j = 0; j < 4; ++j) y[j] = 1.f / (1.f + __expf(-x[j])); }
                  ((GAS v2u*)(LA + (size_t)m * 256))[lane] = (v2u){pk2(y.x, y.y), pk2(y.z, y.w)}; }
          } }
    }
}

DI float red8(float v) { v += __shfl_xor(v, 1); v += __shfl_xor(v, 2); v += __shfl_xor(v, 4); return v; }
DI void prep_c(const Ptrs& P, int gw, int NGW, int lane) {
    unsigned char* ws = P.ws;
    const float* RKV = (const float*)(ws + WS_RKV); const float* LO = (const float*)(ws + WS_LO);
    float* SC5 = (float*)(ws + WS_SC5); float* G = (float*)(ws + WS_G); float* SCAL = (float*)(ws + WS_SCAL);
    constexpr size_t ASZ = (size_t)M * RWD;
    const int c0 = lane * 8;
    float w0v[8], a0v[8], kkv[8], kav[8], rkv[8];
#pragma unroll
    for (int j = 0; j < 8; ++j) { w0v[j] = P.in[19][c0 + j]; a0v[j] = P.in[21][c0 + j]; kkv[j] = P.in[24][c0 + j]; kav[j] = P.in[25][c0 + j]; rkv[j] = P.in[26][c0 + j]; }
    for (int m = gw; m < M; m += NGW) {
        const float* rk = RKV + (size_t)m * 1536 + c0; const float* lo = LO + (size_t)m * 1536 + c0;
        float r[8], k[8], wl[8], al[8], gl[8];
        { const f32x4 a = ((const GAS f32x4*)rk)[0], b = ((const GAS f32x4*)rk)[1]; r[0]=a.x; r[1]=a.y; r[2]=a.z; r[3]=a.w; r[4]=b.x; r[5]=b.y; r[6]=b.z; r[7]=b.w; }
        { const f32x4 a = ((const GAS f32x4*)(rk + 512))[0], b = ((const GAS f32x4*)(rk + 512))[1]; k[0]=a.x; k[1]=a.y; k[2]=a.z; k[3]=a.w; k[4]=b.x; k[5]=b.y; k[6]=b.z; k[7]=b.w; }
        { const f32x4 a = ((const GAS f32x4*)lo)[0], b = ((const GAS f32x4*)lo)[1]; wl[0]=a.x; wl[1]=a.y; wl[2]=a.z; wl[3]=a.w; wl[4]=b.x; wl[5]=b.y; wl[6]=b.z; wl[7]=b.w; }
        { const f32x4 a = ((const GAS f32x4*)(lo + 512))[0], b = ((const GAS f32x4*)(lo + 512))[1]; al[0]=a.x; al[1]=a.y; al[2]=a.z; al[3]=a.w; al[4]=b.x; al[5]=b.y; al[6]=b.z; al[7]=b.w; }
        { const f32x4 a = ((const GAS f32x4*)(lo + 1024))[0], b = ((const GAS f32x4*)(lo + 1024))[1]; gl[0]=a.x; gl[1]=a.y; gl[2]=a.z; gl[3]=a.w; gl[4]=b.x; gl[5]=b.y; gl[6]=b.z; gl[7]=b.w; }
        float dec[8], av[8], kk[8], kp[8]; float nn = 0.f;
#pragma unroll
        for (int j = 0; j < 8; ++j) {
            const float z = -(w0v[j] + wl[j]);
            const float sp = fmaxf(z, 0.f) + log1pf(__expf(-fabsf(z)));
            const float w = -sp - 0.5f; dec[j] = __expf(-__expf(w));
            av[j] = 1.f / (1.f + __expf(-(a0v[j] + al[j])));
            kk[j] = k[j] * kkv[j]; nn += kk[j] * kk[j];
            kp[j] = k[j] * (1.f + (av[j] - 1.f) * kav[j]);
        }
        nn = red8(nn); const float inv = 1.f / fmaxf(sqrtf(nn), 1e-12f);
        float as[8], bs[8], wr[8]; float br = 0.f, kr = 0.f, bon = 0.f;
#pragma unroll
        for (int j = 0; j < 8; ++j) { const float kn = kk[j] * inv; as[j] = -kn; bs[j] = kn * av[j]; wr[j] = dec[j] * r[j]; br += bs[j] * r[j]; kr += kp[j] * r[j]; bon += r[j] * kp[j] * rkv[j]; }
        br = red8(br); kr = red8(kr); bon = red8(bon);
        float* o = SC5 + (size_t)m * RWD + c0;
        ((GAS f32x4*)o)[0] = (f32x4){as[0], as[1], as[2], as[3]}; ((GAS f32x4*)o)[1] = (f32x4){as[4], as[5], as[6], as[7]}; o += ASZ;
        ((GAS f32x4*)o)[0] = (f32x4){wr[0], wr[1], wr[2], wr[3]}; ((GAS f32x4*)o)[1] = (f32x4){wr[4], wr[5], wr[6], wr[7]}; o += ASZ;
        ((GAS f32x4*)o)[0] = (f32x4){dec[0], dec[1], dec[2], dec[3]}; ((GAS f32x4*)o)[1] = (f32x4){dec[4], dec[5], dec[6], dec[7]}; o += ASZ;
        ((GAS f32x4*)o)[0] = (f32x4){bs[0], bs[1], bs[2], bs[3]}; ((GAS f32x4*)o)[1] = (f32x4){bs[4], bs[5], bs[6], bs[7]}; o += ASZ;
        ((GAS f32x4*)o)[0] = (f32x4){kp[0], kp[1], kp[2], kp[3]}; ((GAS f32x4*)o)[1] = (f32x4){kp[4], kp[5], kp[6], kp[7]};
        float* go = G + (size_t)m * RWD + c0;
        ((GAS f32x4*)go)[0] = (f32x4){gl[0], gl[1], gl[2], gl[3]}; ((GAS f32x4*)go)[1] = (f32x4){gl[4], gl[5], gl[6], gl[7]};
        if ((lane & 7) == 0) ((GAS f32x4*)(SCAL + ((size_t)m * 8 + (lane >> 3)) * 4))[0] = (f32x4){br * 0.0625f, kr * 0.0625f, bon, 0.f};
    }
}

DI void post_phase(const Ptrs& P, int gw, int NGW, int lane) {
    unsigned char* ws = P.ws;
    bf16* OM = (bf16*)(ws + WS_OM);
    { const float* PO = (const float*)(ws + WS_PO); const float* PML = (const float*)(ws + WS_PML);
      for (int it = gw; it < DB * 64; it += NGW) { const int b = it >> 6, qr = it & 63;
          float mi[8], li[8]; float mx = -3.0e38f;
#pragma unroll
          for (int s = 0; s < 8; ++s) { const f32x2 ml = ((const GAS f32x2*)PML)[(size_t)(b * 8 + s) * 64 + qr]; mi[s] = ml.x; li[s] = ml.y; mx = fmaxf(mx, ml.x); }
          float L = 0.f; f32x2 acc = {0.f, 0.f};
#pragma unroll
          for (int s = 0; s < 8; ++s) { const float w = __builtin_amdgcn_exp2f(mi[s] - mx); L += li[s] * w;
              const f32x2 o = ((const GAS f32x2*)(PO + ((size_t)(b * 8 + s) * 64 + qr) * 128))[lane]; acc += o * w; }
          const float inv = 1.f / L; const int tq = qr >> 3, hd = qr & 7;
          ((GAS unsigned*)(OM + (size_t)(MP + b * 8 + tq) * 1536 + hd * 128))[lane] = pk2(acc.x * inv, acc.y * inv); } }
    { const float* Y = (const float*)(ws + WS_Y); const float* RKV = (const float*)(ws + WS_RKV); const float* G = (const float*)(ws + WS_G); const float* SCAL = (const float*)(ws + WS_SCAL);
      const int c0 = lane * 8; float lg[8], lb[8];
#pragma unroll
      for (int j = 0; j < 8; ++j) { lg[j] = P.in[27][c0 + j]; lb[j] = P.in[28][c0 + j]; }
      for (int m = gw; m < M; m += NGW) {
          float y[8], v[8], g[8];
          { const GAS f32x4* p = (const GAS f32x4*)(Y + (size_t)m * RWD + c0); const f32x4 a = p[0], b = p[1]; y[0]=a.x; y[1]=a.y; y[2]=a.z; y[3]=a.w; y[4]=b.x; y[5]=b.y; y[6]=b.z; y[7]=b.w; }
          { const GAS f32x4* p = (const GAS f32x4*)(RKV + (size_t)m * 1536 + 1024 + c0); const f32x4 a = p[0], b = p[1]; v[0]=a.x; v[1]=a.y; v[2]=a.z; v[3]=a.w; v[4]=b.x; v[5]=b.y; v[6]=b.z; v[7]=b.w; }
          { const GAS f32x4* p = (const GAS f32x4*)(G + (size_t)m * RWD + c0); const f32x4 a = p[0], b = p[1]; g[0]=a.x; g[1]=a.y; g[2]=a.z; g[3]=a.w; g[4]=b.x; g[5]=b.y; g[6]=b.z; g[7]=b.w; }
          const float bon = SCAL[((size_t)m * 8 + (lane >> 3)) * 4 + 2];
          float s = 0.f;
#pragma unroll
          for (int j = 0; j < 8; ++j) s += y[j];
          const float mean = red8(s) * (1.f / 64.f); float q = 0.f;
#pragma unroll
          for (int j = 0; j < 8; ++j) { y[j] -= mean; q += y[j] * y[j]; }
          const float rstd = 1.f / sqrtf(red8(q) * (1.f / 64.f) + GN_EPS);
          float o[8];
#pragma unroll
          for (int j = 0; j < 8; ++j) o[j] = (y[j] * rstd * lg[j] + lb[j] + bon * v[j]) * g[j];
          *(GAS v4u*)(OM + (size_t)m * 1536 + 1024 + c0) = (v4u){pk2(o[0], o[1]), pk2(o[2], o[3]), pk2(o[4], o[5]), pk2(o[6], o[7])};
      } }
}
namespace att {
constexpr int KSTEP_B = 1152, SUB_BYTES = 10 * KSTEP_B;
DI unsigned img_off(unsigned row, unsigned ch) { return (unsigned)KSTEP_B * (ch >> 1) + 32u * row + 16u * ((ch & 1u) ^ ((row >> 3) & 1u)); }
DI unsigned kvmap(unsigned r) { return (r & ~12u) | ((r & 4u) << 1) | ((r & 8u) >> 1); }
DI unsigned row_base(unsigned lane) { const unsigned kr = kvmap(lane & 31u), h = lane >> 5; return 32u * kr + 16u * (h ^ ((kr >> 3) & 1u)); }
DI unsigned tr_base(unsigned lane) { const unsigned h = lane >> 5, blk = (lane >> 4) & 1u, q = (lane & 15u) >> 2, p = lane & 3u;
    return (unsigned)KSTEP_B * blk + 32u * (8u * h + q) + 16u * ((p >> 1) ^ h) + 8u * (p & 1u); }
DI unsigned cvtpk(float lo, float hi) { typedef float f2 __attribute__((ext_vector_type(2))); typedef __bf16 b2 __attribute__((ext_vector_type(2))); f2 v = {lo, hi}; b2 b = __builtin_convertvector(v, b2); return __builtin_bit_cast(unsigned, b); }
DI s16x4 vtr(const LAS unsigned char* p) { typedef short v4i16_t __attribute__((ext_vector_type(4))); return __builtin_bit_cast(s16x4, __builtin_amdgcn_ds_read_tr16_b64_v4i16((LAS v4i16_t*)p)); }
#define ATT_MFMA(a, b, c) __builtin_amdgcn_mfma_f32_32x32x16_bf16((a), (b), (c), 0, 0, 0)

constexpr float DEFER_THR = 8.0f;
DI float xhalf_max(float v) { auto rr = __builtin_amdgcn_permlane32_swap(__float_as_uint(v), __float_as_uint(v), false, false); return fmaxf(__uint_as_float(rr[0]), __uint_as_float(rr[1])); }
DI float xhalf_sum(float v) { auto rr = __builtin_amdgcn_permlane32_swap(__float_as_uint(v), __float_as_uint(v), false, false); return __uint_as_float(rr[0]) + __uint_as_float(rr[1]); }
DI bf16x8 pack8(const f32x16& x, int s) { v4u w; w.x = cvtpk(x[8 * s], x[8 * s + 1]); w.y = cvtpk(x[8 * s + 2], x[8 * s + 3]); w.z = cvtpk(x[8 * s + 4], x[8 * s + 5]); w.w = cvtpk(x[8 * s + 6], x[8 * s + 7]); return __builtin_bit_cast(bf16x8, w); }

template <bool MASK>
DI void subtile(const LAS unsigned char* img, const bf16x8 (&qf)[10], float& mrun, float& lrun, f32x16 (&o)[4], int lane, int qlim) {
    __builtin_amdgcn_sched_barrier(0);
    const unsigned h = lane >> 5;
    const LAS unsigned char* rb = img + row_base(lane); const LAS unsigned char* tb = img + tr_base(lane);
    f32x16 x;
#pragma unroll
    for (int i = 0; i < 16; ++i) x[i] = 0.f;
#pragma unroll
    for (int s = 0; s < 10; ++s) { const bf16x8 a = *(const LAS bf16x8*)(rb + KSTEP_B * s); x = ATT_MFMA(a, qf[s], x); }
    if (MASK) {
#pragma unroll
        for (int i = 0; i < 16; ++i) { const int kv = 16 * (i >> 3) + 8 * (int)h + (i & 7); if (kv > qlim) x[i] = -1e30f; }
    }
    float mx = x[0];
#pragma unroll
    for (int i = 1; i < 16; ++i) mx = fmaxf(mx, x[i]);
    mx = xhalf_max(mx);
    if (!__all(mx - mrun <= DEFER_THR)) {
        const float mn = fmaxf(mrun, mx), corr = __builtin_amdgcn_exp2f(mrun - mn); mrun = mn; lrun *= corr;
#pragma unroll
        for (int d = 0; d < 4; ++d)
#pragma unroll
            for (int i = 0; i < 16; ++i) o[d][i] *= corr;
    }
    float ls = 0.f;
#pragma unroll
    for (int i = 0; i < 16; ++i) { x[i] = __builtin_amdgcn_exp2f(x[i] - mrun); ls += x[i]; }
    lrun += ls;
    const bf16x8 pb0 = pack8(x, 0), pb1 = pack8(x, 1);
#pragma unroll
    for (int d = 0; d < 4; ++d) {
        { const s16x4 lo = vtr(tb + 2 * KSTEP_B * d), hi = vtr(tb + 2 * KSTEP_B * d + 128); o[d] = ATT_MFMA(__builtin_shufflevector(lo, hi, 0, 1, 2, 3, 4, 5, 6, 7), pb0, o[d]); }
        { const s16x4 lo = vtr(tb + 2 * KSTEP_B * d + 512), hi = vtr(tb + 2 * KSTEP_B * d + 512 + 128); o[d] = ATT_MFMA(__builtin_shufflevector(lo, hi, 0, 1, 2, 3, 4, 5, 6, 7), pb1, o[d]); }
    }
}
DI void tile64(const LAS unsigned char* img, const bf16x8 (&qf)[10], float& mrun, float& lrun, f32x16 (&o)[4], int lane) {
    __builtin_amdgcn_sched_barrier(0);
    const LAS unsigned char* rb = img + row_base(lane); const LAS unsigned char* tb = img + tr_base(lane);
    f32x16 p0, p1;
#pragma unroll
    for (int i = 0; i < 16; ++i) { p0[i] = 0.f; p1[i] = 0.f; }
#pragma unroll
    for (int s = 0; s < 10; ++s) {
        const bf16x8 a0 = *(const LAS bf16x8*)(rb + KSTEP_B * s), a1 = *(const LAS bf16x8*)(rb + SUB_BYTES + KSTEP_B * s);
        p0 = ATT_MFMA(a0, qf[s], p0); p1 = ATT_MFMA(a1, qf[s], p1);
    }
    float mx = fmaxf(p0[0], p1[0]);
#pragma unroll
    for (int i = 1; i < 16; ++i) mx = fmaxf(mx, fmaxf(p0[i], p1[i]));
    mx = xhalf_max(mx);
    if (!__all(mx - mrun <= DEFER_THR)) {
        const float mn = fmaxf(mrun, mx), corr = __builtin_amdgcn_exp2f(mrun - mn); mrun = mn; lrun *= corr;
#pragma unroll
        for (int d = 0; d < 4; ++d)
#pragma unroll
            for (int i = 0; i < 16; ++i) o[d][i] *= corr;
    }
    float ls = 0.f;
#pragma unroll
    for (int i = 0; i < 16; ++i) { p0[i] = __builtin_amdgcn_exp2f(p0[i] - mrun); ls += p0[i]; }
    const bf16x8 pa = pack8(p0, 0), pb = pack8(p0, 1);
#pragma unroll
    for (int d = 0; d < 4; ++d) {
        { const s16x4 lo = vtr(tb + 2 * KSTEP_B * d), hi = vtr(tb + 2 * KSTEP_B * d + 128); o[d] = ATT_MFMA(__builtin_shufflevector(lo, hi, 0, 1, 2, 3, 4, 5, 6, 7), pa, o[d]); }
        { const s16x4 lo = vtr(tb + 2 * KSTEP_B * d + 512), hi = vtr(tb + 2 * KSTEP_B * d + 512 + 128); o[d] = ATT_MFMA(__builtin_shufflevector(lo, hi, 0, 1, 2, 3, 4, 5, 6, 7), pb, o[d]); }
    }
#pragma unroll
    for (int i = 0; i < 16; ++i) { p1[i] = __builtin_amdgcn_exp2f(p1[i] - mrun); ls += p1[i]; }
    lrun += ls;
    const bf16x8 pc = pack8(p1, 0), pd = pack8(p1, 1);
#pragma unroll
    for (int d = 0; d < 4; ++d) {
        { const s16x4 lo = vtr(tb + SUB_BYTES + 2 * KSTEP_B * d), hi = vtr(tb + SUB_BYTES + 2 * KSTEP_B * d + 128); o[d] = ATT_MFMA(__builtin_shufflevector(lo, hi, 0, 1, 2, 3, 4, 5, 6, 7), pc, o[d]); }
        { const s16x4 lo = vtr(tb + SUB_BYTES + 2 * KSTEP_B * d + 512), hi = vtr(tb + SUB_BYTES + 2 * KSTEP_B * d + 512 + 128); o[d] = ATT_MFMA(__builtin_shufflevector(lo, hi, 0, 1, 2, 3, 4, 5, 6, 7), pd, o[d]); }
    }
}

DI void prompt_unit(LAS unsigned char* lds, const bf16* QB, const bf16* CKVB, const bf16* KRB, bf16* OM, int b, int qblk, int tid, int wave, int lane) {
    const int r = lane & 31, h = lane >> 5;
    const int row0 = b * SEQ + qblk * 32, kb = b * SEQ;
    bf16x8 qf[10];
    { const bf16* qp = QB + (size_t)(row0 + r) * 1280 + wave * 160 + 8 * h;
#pragma unroll
      for (int s = 0; s < 10; ++s) qf[s] = *(const GAS bf16x8*)(qp + 16 * s); }
    f32x16 o[4];
#pragma unroll
    for (int d = 0; d < 4; ++d)
#pragma unroll
        for (int i = 0; i < 16; ++i) o[d][i] = 0.f;
    float mrun = -1e30f, lrun = 0.f;
    const int nsub = qblk + 1, ntile = (nsub + 1) >> 1;
    const int lrow0 = tid >> 4, lch = tid & 15, lrow1 = lrow0 + 32;
    const unsigned ld0 = (unsigned)(lrow0 >> 5) * SUB_BYTES + img_off(lrow0 & 31, lch), ld1 = (unsigned)(lrow1 >> 5) * SUB_BYTES + img_off(lrow1 & 31, lch);
    const int rrow = tid >> 2, rc = tid & 3; const unsigned rd = (unsigned)(rrow >> 5) * SUB_BYTES + img_off(rrow & 31, 16 + rc);
    const bf16* g0 = CKVB + (size_t)(kb + lrow0) * KVR + lch * 8; const bf16* g1 = CKVB + (size_t)(kb + lrow1) * KVR + lch * 8; const bf16* g2 = KRB + (size_t)(kb + rrow) * RD + rc * 8;
    v4u s0 = *(const GAS v4u*)g0, s1 = *(const GAS v4u*)g1, s2 = (tid < 256) ? *(const GAS v4u*)g2 : (v4u){0u, 0u, 0u, 0u};
    *(LAS v4u*)(lds + ld0) = s0; *(LAS v4u*)(lds + ld1) = s1; if (tid < 256) *(LAS v4u*)(lds + rd) = s2;
    __syncthreads();
    const int nfull = qblk >> 1;
#define PU_LOAD(tn) do { const size_t adv = (size_t)(tn) * 64; s0 = *(const GAS v4u*)(g0 + adv * KVR); s1 = *(const GAS v4u*)(g1 + adv * KVR); if (tid < 256) s2 = *(const GAS v4u*)(g2 + adv * RD); } while (0)
#define PU_WRITE(par) do { LAS unsigned char* nb = lds + (par) * (2 * SUB_BYTES); *(LAS v4u*)(nb + ld0) = s0; *(LAS v4u*)(nb + ld1) = s1; if (tid < 256) *(LAS v4u*)(nb + rd) = s2; } while (0)
    for (int t = 0; t < nfull; ++t) {
        PU_LOAD(t + 1);
        const LAS unsigned char* img = lds + (t & 1) * (2 * SUB_BYTES);
        tile64(img, qf, mrun, lrun, o, lane);
        PU_WRITE((t + 1) & 1); __syncthreads();
    }
    { const LAS unsigned char* img = lds + (nfull & 1) * (2 * SUB_BYTES);
      if (qblk & 1) { subtile<false>(img, qf, mrun, lrun, o, lane, 0); img += SUB_BYTES; }
      subtile<true>(img, qf, mrun, lrun, o, lane, r);
      __syncthreads(); }
#undef PU_LOAD
#undef PU_WRITE
    const float inv = 1.f / xhalf_sum(lrun);
    bf16* op = OM + (size_t)(row0 + r) * 1536 + wave * 128 + 4 * h;
#pragma unroll
    for (int d = 0; d < 4; ++d)
#pragma unroll
        for (int g = 0; g < 4; ++g)
            *(GAS v2u*)(op + 32 * d + 8 * g) = (v2u){pk2(o[d][4 * g] * inv, o[d][4 * g + 1] * inv), pk2(o[d][4 * g + 2] * inv, o[d][4 * g + 3] * inv)};
}

DI void sample_unit(LAS unsigned char* lds, const bf16* QB, const bf16* CKVB, const bf16* KRB, const float* cckv, const float* ckr, const int* ptab, float* PO, float* PML,
                    int b, int sp, int tid, int wave, int lane) {
    const int r = lane & 31, h = lane >> 5, qt = wave & 1, ks = wave >> 1;
    const int qr = 32 * qt + r, tq = qr >> 3, hd = qr & 7;
    bf16x8 qf[10];
    { const bf16* qp = QB + (size_t)(MP + b * DS + tq) * 1280 + hd * 160 + 8 * h;
#pragma unroll
      for (int s = 0; s < 10; ++s) qf[s] = *(const GAS bf16x8*)(qp + 16 * s); }
    f32x16 o[4];
#pragma unroll
    for (int d = 0; d < 4; ++d)
#pragma unroll
        for (int i = 0; i < 16; ++i) o[d][i] = 0.f;
    float mrun = -1e30f, lrun = 0.f;
    constexpr int PBUF = 4 * SUB_BYTES;
    unsigned ldl[4];
#pragma unroll
    for (int i = 0; i < 4; ++i) { const int row = (tid >> 4) + 32 * i; ldl[i] = (unsigned)(row >> 5) * SUB_BYTES + img_off(row & 31, tid & 15); }
    const int rrow = tid >> 2; const unsigned ldr = (unsigned)(rrow >> 5) * SUB_BYTES + img_off(rrow & 31, 16 + (tid & 3));
    const int* pt = ptab + b * NPAGE + sp * 64;
    f32x4 sl[8], sr[2];
    { const int pg = pt[0]; const float* pl = cckv + (size_t)pg * (PAGE * KVR) + (size_t)(tid >> 4) * KVR + (tid & 15) * 8; const float* prp = ckr + (size_t)pg * (PAGE * RD) + (size_t)rrow * RD + (tid & 3) * 4;
#pragma unroll
      for (int i = 0; i < 4; ++i) { sl[2 * i] = *(const GAS f32x4*)(pl + (size_t)i * 32 * KVR); sl[2 * i + 1] = *(const GAS f32x4*)(pl + (size_t)i * 32 * KVR + 4); }
      sr[0] = *(const GAS f32x4*)prp; sr[1] = *(const GAS f32x4*)(prp + 16); }
#define SAMP_WRITE(buf) do { _Pragma("unroll") for (int i = 0; i < 4; ++i) *(LAS v4u*)((buf) + ldl[i]) = (v4u){cvtpk(sl[2*i].x, sl[2*i].y), cvtpk(sl[2*i].z, sl[2*i].w), cvtpk(sl[2*i+1].x, sl[2*i+1].y), cvtpk(sl[2*i+1].z, sl[2*i+1].w)}; \
        *(LAS v4u*)((buf) + ldr) = (v4u){cvtpk(sr[0].x, sr[1].x), cvtpk(sr[0].y, sr[1].y), cvtpk(sr[0].z, sr[1].z), cvtpk(sr[0].w, sr[1].w)}; } while (0)
    SAMP_WRITE(lds);
    __syncthreads();
    for (int p = 0; p < 64; ++p) {
        const bool more = p + 1 < 64;
        if (more) { const int pg = pt[p + 1]; const float* pl = cckv + (size_t)pg * (PAGE * KVR) + (size_t)(tid >> 4) * KVR + (tid & 15) * 8; const float* prp = ckr + (size_t)pg * (PAGE * RD) + (size_t)rrow * RD + (tid & 3) * 4;
#pragma unroll
            for (int i = 0; i < 4; ++i) { sl[2 * i] = *(const GAS f32x4*)(pl + (size_t)i * 32 * KVR); sl[2 * i + 1] = *(const GAS f32x4*)(pl + (size_t)i * 32 * KVR + 4); }
            sr[0] = *(const GAS f32x4*)prp; sr[1] = *(const GAS f32x4*)(prp + 16); }
        subtile<false>(lds + (p & 1) * PBUF + ks * SUB_BYTES, qf, mrun, lrun, o, lane, 0);
        if (more) { LAS unsigned char* nb = lds + ((p + 1) & 1) * PBUF; SAMP_WRITE(nb); }
        __syncthreads();
    }
#undef SAMP_WRITE
    if (sp == 0) {
        LAS unsigned char* nb = lds;
        { const int row = tid >> 4, ch = tid & 15; v4u v = {0u, 0u, 0u, 0u}; if (row < DS) v = *(const GAS v4u*)(CKVB + (size_t)(MP + b * DS + row) * KVR + ch * 8); *(LAS v4u*)(nb + img_off(row, ch)) = v; }
        if (tid < 128) { const int row = tid >> 2, c = tid & 3; v4u v = {0u, 0u, 0u, 0u}; if (row < DS) v = *(const GAS v4u*)(KRB + (size_t)(MP + b * DS + row) * RD + c * 8); *(LAS v4u*)(nb + img_off(row, 16 + c)) = v; }
        __syncthreads();
        if (ks == 0) subtile<true>(nb, qf, mrun, lrun, o, lane, tq);
        __syncthreads();
    }
    const float lt = xhalf_sum(lrun);
    const int idx = b * 8 + sp * 4 + ks;
    if (h == 0) ((GAS f32x2*)PML)[(size_t)idx * 64 + qr] = (f32x2){mrun, lt};
    float* op = PO + ((size_t)idx * 64 + qr) * 128 + 4 * h;
#pragma unroll
    for (int d = 0; d < 4; ++d)
#pragma unroll
        for (int g = 0; g < 4; ++g) *(GAS f32x4*)(op + 32 * d + 8 * g) = (f32x4){o[d][4 * g], o[d][4 * g + 1], o[d][4 * g + 2], o[d][4 * g + 3]};
}
}

DI float rowsum16(float v) {
    v += __builtin_bit_cast(float, __builtin_amdgcn_update_dpp(0, __builtin_bit_cast(int, v), 0x128, 0xf, 0xf, false));
    v += __builtin_bit_cast(float, __builtin_amdgcn_update_dpp(0, __builtin_bit_cast(int, v), 0x124, 0xf, 0xf, false));
    v += __builtin_bit_cast(float, __builtin_amdgcn_update_dpp(0, __builtin_bit_cast(int, v), 0x122, 0xf, 0xf, false));
    v += __builtin_bit_cast(float, __builtin_amdgcn_update_dpp(0, __builtin_bit_cast(int, v), 0x121, 0xf, 0xf, false));
    return v;
}
constexpr int SCAN_STRIDE = 340, SCAN_CHUNK = 16, SCAN_PIECES = 85, SCAN_NBUF = 5, SCAN_AHEAD = 3;
constexpr int SCAN_BUF = 1536 * 16, SCAN_YOFF = SCAN_NBUF * SCAN_BUF, SCAN_YBUF = SCAN_CHUNK * 16 * 4;
static_assert(SCAN_YOFF + 2 * SCAN_YBUF <= RING_BYTES && SCAN_CHUNK * SCAN_PIECES <= 1536, "scan LDS map");
DI float dot4(const f32x4& x, const f32x4& y) { return fmaf(x.y, y.y, x.x * y.x) + fmaf(x.w, y.w, x.z * y.z); }
template <int VAR> DI void scan_item(LAS unsigned char* lds, const float* SC5, const float* RKV, const float* SCAL, float* Y, const float* init, float* fin, int m0, int T, int hd, int quarter, int tid, int wave, int lane) {
    constexpr size_t ASZ = (size_t)M * RWD;
    const int j = lane & 15, rowl = (wave & 3) * 4 + (lane >> 4), row = quarter * 16 + rowl;
    const bool isA = wave < 4;
    const int nchunk = (T + SCAN_CHUNK - 1) / SCAN_CHUNK, nst0 = min(SCAN_CHUNK, T);
    const char* sp[3]; unsigned sstr[3];
#pragma unroll
    for (int i = 0; i < 3; ++i) { int q = tid + 512 * i; if (q >= nst0 * SCAN_PIECES) q = 0;
        const int st = q / SCAN_PIECES, pc = q - st * SCAN_PIECES; const size_t mm = (size_t)(m0 + st); const float* src;
        if (pc < 80) { src = SC5 + (size_t)(pc >> 4) * ASZ + mm * RWD + hd * 64 + (pc & 15) * 4; sstr[i] = SCAN_CHUNK * RWD * 4; }
        else if (pc < 84) { src = RKV + mm * 1536 + 1024 + hd * 64 + quarter * 16 + (pc - 80) * 4; sstr[i] = SCAN_CHUNK * 1536 * 4; }
        else { src = SCAL + (mm * 8 + hd) * 4; sstr[i] = SCAN_CHUNK * 32 * 4; }
        sp[i] = (const char*)src; }
#define SCAN_DMA(c) do { const int cn_ = min((c), nchunk - 1); LAS unsigned char* db_ = lds + ((c) % SCAN_NBUF) * SCAN_BUF + wave * 1024; _Pragma("unroll") for (int i = 0; i < 3; ++i) \
        __builtin_amdgcn_global_load_lds((const GAS unsigned*)(sp[i] + (size_t)cn_ * sstr[i]), (LAS unsigned*)(db_ + i * 8192), 16, 0, 0); } while (0)
#define SCAN_WAIT_BAR() do { asm volatile("s_waitcnt vmcnt(3) lgkmcnt(0)" ::: "memory"); __builtin_amdgcn_s_barrier(); asm volatile("" ::: "memory"); } while (0)
    SCAN_DMA(0); SCAN_DMA(1); SCAN_DMA(2);
    asm volatile("s_waitcnt vmcnt(3) lgkmcnt(0)" ::: "memory"); __builtin_amdgcn_s_barrier(); asm volatile("" ::: "memory");
    f32x4 s = (f32x4){0.f, 0.f, 0.f, 0.f}, t, bq; float sa = 0.f, P1 = 0.f, P2 = 0.f, ypv = 0.f, br16 = 0.f;
    f32x4 cw, ck, cwr, cb4, ca; float cvv = 0.f; f32x2 csc;
#define SCAN_OP(g, off) (*(const LAS f32x4*)(lds + (((g) >> 4) % SCAN_NBUF) * SCAN_BUF + ((g) & 15) * (SCAN_STRIDE * 4) + (off) * 4 + 16 * j))
    if (isA) {
        if (init) s = *(const GAS f32x4*)(init + (size_t)row * 64 + 4 * j);
        const f32x4 a0 = SCAN_OP(0, 0), wr0 = SCAN_OP(0, 64), w0 = SCAN_OP(0, 128), b0 = SCAN_OP(0, 192), k0 = SCAN_OP(0, 256), a1 = SCAN_OP(1, 0);
        const LAS float* m0p = (const LAS float*)lds; const float vv0 = m0p[320 + rowl]; const f32x2 sc0 = *(const LAS f32x2*)(m0p + 336);
        sa = rowsum16(dot4(s, a0));
        t = s * w0 + k0 * vv0; bq = b0;
        P2 = dot4(t, a1); P1 = dot4(b0, a1);
        ypv = fmaf(vv0, sc0.y, dot4(s, wr0)); br16 = sc0.x;
        cw = SCAN_OP(1, 128); ck = SCAN_OP(1, 256); cwr = SCAN_OP(1, 64); cb4 = SCAN_OP(1, 192); ca = SCAN_OP(2, 0);
        { const LAS float* p1 = (const LAS float*)(lds + SCAN_STRIDE * 4); cvv = p1[320 + rowl]; csc = *(const LAS f32x2*)(p1 + 336); }
    }
    for (int c = 0; c < nchunk; ++c) {
        SCAN_DMA(c + SCAN_AHEAD);
        if (!isA && c >= 1) {
            const int cc = c - 1, t_ = tid - 256, st = t_ >> 4, r16 = t_ & 15;
            if (st < min(SCAN_CHUNK, T - cc * SCAN_CHUNK))
                Y[(size_t)(m0 + cc * SCAN_CHUNK + st) * RWD + hd * 64 + quarter * 16 + r16] = *(const LAS float*)(lds + SCAN_YOFF + (cc & 1) * SCAN_YBUF + (st * 16 + r16) * 4);
        }
        if (isA) {
            const int nst = min(SCAN_CHUNK, T - c * SCAN_CHUNK);
            const LAS unsigned char* b0p = lds + (c % SCAN_NBUF) * SCAN_BUF + 16 * j; const LAS unsigned char* b1p = lds + ((c + 1) % SCAN_NBUF) * SCAN_BUF + 16 * j;
            LAS float* yb = (LAS float*)(lds + SCAN_YOFF + (c & 1) * SCAN_YBUF) + rowl;
#pragma unroll
            for (int st = 0; st < SCAN_CHUNK; ++st) {
                if (st >= nst) break;
                const LAS unsigned char* q2 = (st + 2 < SCAN_CHUNK ? b0p + (st + 2) * (SCAN_STRIDE * 4) : b1p + (st + 2 - SCAN_CHUNK) * (SCAN_STRIDE * 4));
                const LAS unsigned char* q3 = (st + 3 < SCAN_CHUNK ? b0p + (st + 3) * (SCAN_STRIDE * 4) : b1p + (st + 3 - SCAN_CHUNK) * (SCAN_STRIDE * 4));
                const f32x4 nw = *(const LAS f32x4*)(q2 + 512), nk = *(const LAS f32x4*)(q2 + 1024), nwr = *(const LAS f32x4*)(q2 + 256), nb4 = *(const LAS f32x4*)(q2 + 768), na = *(const LAS f32x4*)(q3);
                const float nvv = *(const LAS float*)(q2 - 16 * j + (320 + rowl) * 4); const f32x2 nsc = *(const LAS f32x2*)(q2 - 16 * j + 336 * 4);
                float part = fmaf(sa, P1, P2);
                float yp = fmaf(sa, br16, ypv);
                s = bq * sa + t;
                if (VAR == 3) { part *= 0.99f; yp *= 0.99f; } else if (VAR == 2) { part = rowsum16(part); yp *= 0.99f; } else { part = rowsum16(part); yp = rowsum16(yp); }
                yb[st * 16] = yp;
                t = s * cw + ck * cvv; bq = cb4;
                P2 = dot4(t, ca); P1 = dot4(cb4, ca);
                ypv = fmaf(cvv, csc.y, dot4(s, cwr)); br16 = csc.x;
                sa = part;
                cw = nw; ck = nk; cwr = nwr; cb4 = nb4; ca = na; cvv = nvv; csc = nsc;
            }
        }
        if (isA || c == 0) asm volatile("s_waitcnt vmcnt(3) lgkmcnt(0)" ::: "memory"); else if (c == 1) asm volatile("s_waitcnt vmcnt(4) lgkmcnt(0)" ::: "memory"); else asm volatile("s_waitcnt vmcnt(5) lgkmcnt(0)" ::: "memory");
        __builtin_amdgcn_s_barrier(); asm volatile("" ::: "memory");
    }
    if (!isA) { const int cc = nchunk - 1, t_ = tid - 256, st = t_ >> 4, r16 = t_ & 15;
        if (st < min(SCAN_CHUNK, T - cc * SCAN_CHUNK))
            Y[(size_t)(m0 + cc * SCAN_CHUNK + st) * RWD + hd * 64 + quarter * 16 + r16] = *(const LAS float*)(lds + SCAN_YOFF + (cc & 1) * SCAN_YBUF + (st * 16 + r16) * 4); }
#undef SCAN_DMA
#undef SCAN_WAIT_BAR
#undef SCAN_OP
    if (isA) *(GAS f32x4*)(fin + (size_t)row * 64 + 4 * j) = s;
    asm volatile("s_waitcnt vmcnt(0) lgkmcnt(0)" ::: "memory"); __builtin_amdgcn_s_barrier(); asm volatile("" ::: "memory");
}

constexpr int Q_PSCAN = 128, Q_SATT = 256, Q_PATT = 1024, Q_SSCAN = 4096, Q_TOTAL = Q_PSCAN + Q_SATT + Q_PATT + Q_SSCAN;
template <int MODE, int VAR> DI void mixer_phase(const Ptrs& P, LAS unsigned char* lds, volatile LAS unsigned* MISC, gu32* ctl, int tid, int wave, int lane) {
    unsigned char* ws = P.ws;
    const bf16* QB = (const bf16*)(ws + WS_QB); const bf16* CKVB = (const bf16*)(ws + WS_CKVB); const bf16* KRB = (const bf16*)(ws + WS_KRB); bf16* OM = (bf16*)(ws + WS_OM);
    const float* SC5 = (const float*)(ws + WS_SC5); const float* RKV = (const float*)(ws + WS_RKV); const float* SCAL = (const float*)(ws + WS_SCAL); float* Y = (float*)(ws + WS_Y);
#define Q_POP() do { if (tid == 0) MISC[0] = __hip_atomic_fetch_add(ctl + CW_QHEAD, 1u, RLX_AGENT); __syncthreads(); it = (int)MISC[0]; __syncthreads(); it = __builtin_amdgcn_readfirstlane(it); } while (0)
    int it; Q_POP();
#ifndef MK_SKIP_PSCAN
    if (MODE == 0 || MODE == 1)
    while (it < Q_PSCAN) {
        const int ch = it >> 2, qtr = it & 3, b = ch >> 3, hd = ch & 7;
        if (VAR == 0) scan_item<0>(lds, SC5, RKV, SCAL, Y, nullptr, P.out + O_WKVP + (size_t)ch * 4096, b * SEQ, SEQ, hd, qtr, tid, wave, lane);
        else scan_item<VAR>(lds, SC5, RKV, SCAL, (float*)(ws + WS_END), nullptr, (float*)(ws + WS_END + 80 * MiB) + (size_t)ch * 4096, b * SEQ, SEQ, hd, qtr, tid, wave, lane);
        Q_POP(); }
#endif
    if (MODE == 2 || MODE == 3) { while (it < Q_PSCAN) Q_POP(); }
    if (MODE == 3) { while (it < Q_PSCAN + Q_SATT) Q_POP(); }
#ifndef MK_SKIP_SATT
    if (MODE == 0 || MODE == 2)
    while (it < Q_PSCAN + Q_SATT) {
        const int u = it - Q_PSCAN; att::sample_unit(lds, QB, CKVB, KRB, P.in[2], P.in[3], (const int*)P.in[6], (float*)(ws + WS_PO), (float*)(ws + WS_PML), u >> 1, u & 1, tid, wave, lane);
        Q_POP(); }
#endif
#ifndef MK_SKIP_PATT
    if (MODE == 0 || MODE == 3)
    while (it < Q_PSCAN + Q_SATT + Q_PATT) {
        const int u = it - Q_PSCAN - Q_SATT; att::prompt_unit(lds, QB, CKVB, KRB, OM, u & 3, 255 - (u >> 2), tid, wave, lane);
        Q_POP(); }
#endif
#ifndef MK_SKIP_SSCAN
    if (MODE == 0)
    while (it < Q_TOTAL) {
        const int u = it - Q_PSCAN - Q_SATT - Q_PATT, ch = u >> 2, qtr = u & 3, b = ch >> 3, hd = ch & 7;
        scan_item<0>(lds, SC5, RKV, SCAL, Y, P.in[4] + (size_t)ch * 4096, P.out + O_WKVS + (size_t)ch * 4096, MP + b * DS, DS, hd, qtr, tid, wave, lane);
        Q_POP(); }
#endif
#undef Q_POP
}
constexpr int N_PHASES = 15;
#ifndef MK_REP_MIX
#define MK_REP_MIX 1
#endif
#ifndef MK_DUP_VAR
#define MK_DUP_VAR 0
#endif
#ifndef MK_DUP_MODE
#define MK_DUP_MODE 0
#endif
#ifndef MK_REP_EW
#define MK_REP_EW 1
#endif
#ifndef MK_REP_GEMM
#define MK_REP_GEMM 1
#endif
#define DUP_1(...)
#define DUP_2(...) xcd_barrier(bar); __VA_ARGS__
#define DUP_CAT(a, b) a##b
#define DUP_SEL(n) DUP_CAT(DUP_, n)

__global__ void __launch_bounds__(NWAVES * 64, 2) mk_fwd(Args args) {
    extern __shared__ __attribute__((aligned(16))) unsigned char lds_raw[];
    LAS unsigned char* lds = (LAS unsigned char*)lds_raw;
    volatile LAS unsigned* MISC = (volatile LAS unsigned*)(lds + MISC_OFF);
    const int tid = threadIdx.x, lane = tid & 63, wave = __builtin_amdgcn_readfirstlane(tid >> 6);
    const int G = gridDim.x, bx = blockIdx.x;
    const int gw = bx * NWAVES + wave, NGW = G * NWAVES;
    unsigned char* ws = args.ws;
#define P (*args_here())
    gu32* ctl = (gu32*)(ws + WS_CTL);
    for (int u = tid; u < (LDS_BYTES - LDSCTL_OFF) / 4; u += NWAVES * 64) ((LAS unsigned*)(lds + LDSCTL_OFF))[u] = 0u;
    __syncthreads();
    const int lo = args.ph_lo, hi = args.ph_hi;
    const bool one_launch = (hi - lo) > 1;
    XcdBarrier bar; bar.bar = (unsigned*)(ctl + CW_BAR); bar.x = 0; bar.st = nullptr;
    if (one_launch) bar = xcd_barrier_post((unsigned*)(ctl + CW_BAR), MISC + 8);
#ifndef MK_ONLY
#define MK_ONLY -1
#endif
#define IN(k) ((MK_ONLY < 0 || (k) == MK_ONLY) && lo <= (k) && (k) < hi)
#define SEAM(k) do { if (IN(k) && IN((k) + 1)) xcd_barrier(bar); } while (0)
    bf16* XNB = (bf16*)(ws + WS_XNB); bf16* HB = (bf16*)(ws + WS_HB); float* Z = (float*)(ws + WS_Z); float* X1 = (float*)(ws + WS_X1); float* X2 = (float*)(ws + WS_X2);
    const float* cosT = (const float*)(ws + WS_ROPE); const float* sinT = cosT + ROPE_N * 16;

    if (IN(0)) { p0_prologue(P, lds, gw, NGW, wave, lane); SEAM(0); }
#define PH1_BODY do {    \
        pg8::Gemm g{XNB, (const bf16*)(ws + WS_WGUA), M, 2 * FF, DM}; pg8::StaticOrder S; S.init(M, 2 * FF, G, bx); \
        pg8::EpiSwiGLU E{HB, FF}; \
        pg8::gemm_phase<pg8::EpiSwiGLU, pg8::StaticOrder, true, true>(lds + RING_OFF, g, S, E); } while (0)
    if (IN(1)) { PH1_BODY; DUP_SEL(MK_REP_GEMM)(PH1_BODY;) SEAM(1); }
#define PH2_BODY do {    \
        pg8::Gemm g{HB, (const bf16*)(ws + WS_WDA), M, DM, FF}; pg8::StaticOrder S; S.init(M, DM, G, bx); \
        pg8::EpiResid E{P.in[0], P.in[1], MP, Z, DM, ALPHA, 0.5f}; \
        pg8::gemm_phase<pg8::EpiResid, pg8::StaticOrder, true, true>(lds + RING_OFF, g, S, E); } while (0)
    if (IN(2)) { PH2_BODY; DUP_SEL(MK_REP_GEMM)(PH2_BODY;) SEAM(2); }
#define PH3_BODY do { ln_phase(Z, P.in[7], P.in[8], X1, XNB, gw, NGW, lane); } while (0)
    if (IN(3)) { PH3_BODY; DUP_SEL(MK_REP_EW)(PH3_BODY;) SEAM(3); }
#define PH4_BODY do {    \
        pg8::Gemm g{XNB, (const bf16*)(ws + WS_WIN), M, INP, DM}; pg8::StaticOrder S; S.init(M, INP, G, bx); \
        pg8::EpiF32 E{(float*)(ws + WS_PROJ), INP}; \
        pg8::gemm_phase<pg8::EpiF32, pg8::StaticOrder, true, true>(lds + RING_OFF, g, S, E); } while (0)
    if (IN(4)) { PH4_BODY; DUP_SEL(MK_REP_GEMM)(PH4_BODY;) SEAM(4); }
#define PH5_BODY do { prep_a(P, gw, NGW, lane); } while (0)
    if (IN(5)) { PH5_BODY; DUP_SEL(MK_REP_EW)(PH5_BODY;) SEAM(5); }
#define PH6_BODY do {    \
        int k256 = 256; asm volatile("" : "+s"(k256));           \
        { pg8::Gemm g{(const bf16*)(ws + WS_CQN), (const bf16*)(ws + WS_WQ), M, 1280, k256}; pg8::StaticOrder S; S.init(M, 1280, G, bx); \
          pg8::EpiQ E{(bf16*)(ws + WS_QB), cosT, sinT, QSCALE}; \
          pg8::gemm_phase<pg8::EpiQ, pg8::StaticOrder, true, true>(lds + RING_OFF, g, S, E); } \
        { pg8::Gemm g{(const bf16*)(ws + WS_LA), (const bf16*)(ws + WS_WL), M, 1536, k256}; pg8::StaticOrder S; S.init(M, 1536, G, bx); \
          pg8::EpiF32 E{(float*)(ws + WS_LO), 1536}; \
          pg8::gemm_phase<pg8::EpiF32, pg8::StaticOrder, true, true>(lds + RING_OFF, g, S, E); } \
        } while (0)
    if (IN(6)) { PH6_BODY; DUP_SEL(MK_REP_GEMM)(PH6_BODY;) SEAM(6); }
#define PH7_BODY do { prep_c(P, gw, NGW, lane); } while (0)
    if (IN(7)) { PH7_BODY; DUP_SEL(MK_REP_EW)(PH7_BODY;) SEAM(7); }
    if (IN(8)) { mixer_phase<0, 0>(P, lds, MISC, ctl, tid, wave, lane); DUP_SEL(MK_REP_MIX)(mixer_phase<MK_DUP_MODE, MK_DUP_VAR>(P, lds, MISC, ctl + 64, tid, wave, lane);) SEAM(8); }
#define PH9_BODY do { post_phase(P, gw, NGW, lane); } while (0)
    if (IN(9)) { PH9_BODY; DUP_SEL(MK_REP_EW)(PH9_BODY;) SEAM(9); }
#define PH10_BODY do {   \
        pg8::Gemm g{(const bf16*)(ws + WS_OM), (const bf16*)(ws + WS_WO), M, DM, 1536}; pg8::StaticOrder S; S.init(M, DM, G, bx); \
        pg8::EpiResid E{X1, X1, M, Z, DM, ALPHA, 1.0f}; \
        pg8::gemm_phase<pg8::EpiResid, pg8::StaticOrder, true, true>(lds + RING_OFF, g, S, E); } while (0)
    if (IN(10)) { PH10_BODY; DUP_SEL(MK_REP_GEMM)(PH10_BODY;) SEAM(10); }
#define PH11_BODY do { ln_phase(Z, P.in[30], P.in[31], X2, XNB, gw, NGW, lane); } while (0)
    if (IN(11)) { PH11_BODY; DUP_SEL(MK_REP_EW)(PH11_BODY;) SEAM(11); }
#define PH12_BODY do {   \
        pg8::Gemm g{XNB, (const bf16*)(ws + WS_WGUB), M, 2 * FF, DM}; pg8::StaticOrder S; S.init(M, 2 * FF, G, bx); \
        pg8::EpiSwiGLU E{HB, FF}; \
        pg8::gemm_phase<pg8::EpiSwiGLU, pg8::StaticOrder, true, true>(lds + RING_OFF, g, S, E); } while (0)
    if (IN(12)) { PH12_BODY; DUP_SEL(MK_REP_GEMM)(PH12_BODY;) SEAM(12); }
#define PH13_BODY do {   \
        pg8::Gemm g{HB, (const bf16*)(ws + WS_WDB), M, DM, FF}; pg8::StaticOrder S; S.init(M, DM, G, bx); \
        pg8::EpiResid E{X2, X2, M, Z, DM, ALPHA, 0.5f}; \
        pg8::gemm_phase<pg8::EpiResid, pg8::StaticOrder, true, true>(lds + RING_OFF, g, S, E); } while (0)
    if (IN(13)) { PH13_BODY; DUP_SEL(MK_REP_GEMM)(PH13_BODY;) SEAM(13); }
#define PH14_BODY do { ln_phase(Z, P.in[35], P.in[36], P.out + O_YP, nullptr, gw, NGW, lane); } while (0)
    if (IN(14)) { PH14_BODY; DUP_SEL(MK_REP_EW)(PH14_BODY;) }
#undef IN
#undef SEAM
#undef P
}

#ifndef MK_PER_PHASE
#define MK_PER_PHASE 0
#endif
extern "C" void kernel_launch(void* const* d_in, const int* in_sizes, int n_in, void* d_out, int out_size, void* d_ws, size_t ws_size, hipStream_t stream) {
    static int grid = 0;
    if (grid == 0) {
        if (n_in != 37 || (size_t)out_size != O_END || ws_size < WS_END) { fprintf(stderr, "kernel_launch: unexpected shapes: n_in %d out %d ws %zu\n", n_in, out_size, ws_size); grid = -1; return; }
        int dev = 0, cus = 0, per_cu = 0;
        if (hipGetDevice(&dev) != hipSuccess || hipDeviceGetAttribute(&cus, hipDeviceAttributeMultiprocessorCount, dev) != hipSuccess) { grid = -1; return; }
        if (hipFuncSetAttribute((const void*)mk_fwd, hipFuncAttributeMaxDynamicSharedMemorySize, LDS_BYTES) != hipSuccess) { fprintf(stderr, "kernel_launch: hipFuncSetAttribute failed\n"); grid = -1; return; }
        if (hipOccupancyMaxActiveBlocksPerMultiprocessor(&per_cu, (const void*)mk_fwd, NWAVES * 64, LDS_BYTES) != hipSuccess || per_cu < 1) { fprintf(stderr, "kernel_launch: occupancy query says %d\n", per_cu); }
        (void)hipGetLastError();
        grid = cus;
    }
    if (grid < 0) return;
    if (hipMemsetAsync((char*)d_ws + WS_CTL, 0, CTL_ZERO_BYTES, stream) != hipSuccess) return;
    Args a{};
    for (int i = 0; i < 37; ++i) a.in[i] = (const float*)d_in[i];
    a.out = (float*)d_out; a.ws = (unsigned char*)d_ws;
#if MK_PER_PHASE
    for (int p = 0; p < N_PHASES; ++p) { a.ph_lo = p; a.ph_hi = p + 1; hipLaunchKernelGGL(mk_fwd, dim3(grid), dim3(NWAVES * 64), LDS_BYTES, stream, a); }
#else
    a.ph_lo = 0; a.ph_hi = N_PHASES;
    hipLaunchKernelGGL(mk_fwd, dim3(grid), dim3(NWAVES * 64), LDS_BYTES, stream, a);
#endif
    const hipError_t le = hipPeekAtLastError();
    if (le != hipSuccess) fprintf(stderr, "kernel_launch: launch failed: %s\n", hipGetErrorName(le));
}
```

```cpp
#include <hip/hip_runtime.h>
#include <cstdio>
#include <cstdint>
namespace pg8 {
#define PG8_LAS __attribute__((address_space(3)))
typedef unsigned short bf16_t;
typedef short bf16x8 __attribute__((ext_vector_type(8)));
typedef float f32x4 __attribute__((ext_vector_type(4)));
typedef unsigned u32x4 __attribute__((ext_vector_type(4)));
constexpr int BM = 256, BK = 64, HALF = 128, HTB = HALF * BK * 2  , STAGE_BYTES = 8 * HTB, NXCD = 8, WGM = 8;

__host__ __device__ __forceinline__ int lds_byte(int r, int c) { const int st = (r >> 4) * 2 + (c >> 5), rr = r & 15, cc = c & 31, ob = rr * 64 + cc * 2; return st * 1024 + (ob ^ (((ob >> 9) & 1) << 5)); }
__host__ __device__ __forceinline__ void stage_rc(int b, int& R, int& C) { const int st = b / 1024, sb = b % 1024, swz = sb ^ (((sb >> 9) & 1) << 5); R = (st >> 1) * 16 + swz / 64; C = (st & 1) * 32 + (swz % 64) / 2; }
__host__ __device__ __forceinline__ int perm32(int rho) { const int n = rho >> 4, i = rho & 15; return 8 * (i >> 2) + 4 * n + (i & 3); }

struct Unit { int pm, pn, pk; };
struct Gemm { const bf16_t* A; const bf16_t* Bt; int M, N, K, ld; };

struct StaticOrder {
    int nM, nN, nwg, G, c;
    __host__ __device__ void init(int M, int N, int G_, int c_) { nM = M / BM; nN = N / BM; nwg = nM * nN; G = G_; c = c_; }
    __host__ __device__ bool next(int i, Unit& u) const {
        const long L = (long)i * G + c; if (L >= nwg) return false;
        int wgid = (int)L; { const int q = nwg / NXCD, r = nwg % NXCD, xcd = wgid % NXCD, off = wgid / NXCD; wgid = (xcd < r ? xcd * (q + 1) : r * (q + 1) + (xcd - r) * q) + off; }
        const int nig = WGM * nN, gid = wgid / nig, fm = gid * WGM, gsz = (nM - fm) < WGM ? (nM - fm) : WGM;
        u.pm = fm + ((wgid % nig) % gsz); u.pn = (wgid % nig) / gsz; u.pk = 0; return true;
    }
    __device__ __forceinline__ void a_ready(const Unit&) const {}
    __device__ __forceinline__ void done(const Unit&) const {}
};
struct SplitOrder {
    int nM, nN, nK, pm0, G, c;
    __host__ __device__ void init(int nM_, int nN_, int nK_, int pm0_, int G_, int c_) { nM = nM_; nN = nN_; nK = nK_; pm0 = pm0_; G = G_; c = c_; }
    __host__ __device__ bool next(int i, Unit& u) const {
        const int L = i * G + c; if (L >= nM * nN * nK) return false;
        const int per = nM * nN, r = L % per; u.pk = L / per; u.pm = pm0 + r / nN; u.pn = r % nN; return true;
    }
    __device__ __forceinline__ void a_ready(const Unit&) const {}
    __device__ __forceinline__ void done(const Unit&) const {}
};
__device__ __forceinline__ unsigned cvt_pk_bf16(float lo, float hi) { unsigned r; asm volatile("v_cvt_pk_bf16_f32 %0, %1, %2" : "=v"(r) : "v"(lo), "v"(hi)); return r; }
__device__ __forceinline__ float silu_mul(float g, float u) { const float e = __builtin_amdgcn_exp2f(-1.4426950408889634f * g); return g * __builtin_amdgcn_rcpf(1.0f + e) * u; }

struct EpiSwiGLU {
    static constexpr bool PERM = true, AFTER_DRAIN = false;
    bf16_t* O; int ldo;
    __device__ __forceinline__ void operator()(const f32x4 (&acc)[2][2][4][2], const Unit& u, int wr, int wc, int fr, int fq) const {
        const int row0 = u.pm * BM + wr * 64 + fr, col0 = u.pn * HALF + wc * 32 + 8 * fq;
#pragma unroll
        for (int ai = 0; ai < 2; ++ai)
#pragma unroll
            for (int m = 0; m < 4; ++m) {
                bf16_t* rowp = O + (size_t)(row0 + ai * HALF + m * 16) * ldo + col0;
                const f32x4 g0 = acc[ai][0][m][0], g1 = acc[ai][0][m][1], u0 = acc[ai][1][m][0], u1 = acc[ai][1][m][1];
                u32x4 w;
                w.x = cvt_pk_bf16(silu_mul(g0[0], u0[0]), silu_mul(g0[1], u0[1])); w.y = cvt_pk_bf16(silu_mul(g0[2], u0[2]), silu_mul(g0[3], u0[3]));
                w.z = cvt_pk_bf16(silu_mul(g1[0], u1[0]), silu_mul(g1[1], u1[1])); w.w = cvt_pk_bf16(silu_mul(g1[2], u1[2]), silu_mul(g1[3], u1[3]));
                *(u32x4*)rowp = w;
            }
    }
};
struct EpiResid {
    static constexpr bool PERM = false, AFTER_DRAIN = false;
    const float* base0; const float* base1; int split; float* Z; int ldc; float alpha, sc;
    __device__ __forceinline__ void operator()(const f32x4 (&acc)[2][2][4][2], const Unit& u, int wr, int wc, int fr, int fq) const {
        const int row0 = u.pm * BM + wr * 64 + fr, col0 = u.pn * BM + wc * 32 + 4 * fq;
        const float* bp = (u.pm * BM < split) ? base0 : base1 - (size_t)split * ldc;
#pragma unroll
        for (int ai = 0; ai < 2; ++ai)
#pragma unroll
            for (int m = 0; m < 4; ++m) {
                const size_t off = (size_t)(row0 + ai * HALF + m * 16) * ldc + col0;
#pragma unroll
                for (int bj = 0; bj < 2; ++bj)
#pragma unroll
                    for (int n = 0; n < 2; ++n) { const size_t o = off + bj * HALF + n * 16; const f32x4 b = *(const f32x4*)(bp + o); *(f32x4*)(Z + o) = b * alpha + acc[ai][bj][m][n] * sc; }
            }
    }
};
struct EpiF32 {
    static constexpr bool PERM = false, AFTER_DRAIN = false;
    float* O; int ldc;
    __device__ __forceinline__ void operator()(const f32x4 (&acc)[2][2][4][2], const Unit& u, int wr, int wc, int fr, int fq) const {
        const int row0 = u.pm * BM + wr * 64 + fr, col0 = u.pn * BM + wc * 32 + 4 * fq;
#pragma unroll
        for (int ai = 0; ai < 2; ++ai)
#pragma unroll
            for (int m = 0; m < 4; ++m) {
                const size_t off = (size_t)(row0 + ai * HALF + m * 16) * ldc + col0;
#pragma unroll
                for (int bj = 0; bj < 2; ++bj)
#pragma unroll
                    for (int n = 0; n < 2; ++n) *(f32x4*)(O + off + bj * HALF + n * 16) = acc[ai][bj][m][n];
            }
    }
};
struct EpiPart {
    static constexpr bool PERM = false, AFTER_DRAIN = false;
    float* O; int ldc; int row0; size_t pstride;
    __device__ __forceinline__ void operator()(const f32x4 (&acc)[2][2][4][2], const Unit& u, int wr, int wc, int fr, int fq) const {
        const int rowb = u.pm * BM - row0 + wr * 64 + fr, col0 = u.pn * BM + wc * 32 + 4 * fq; float* Ob = O + (size_t)u.pk * pstride;
#pragma unroll
        for (int ai = 0; ai < 2; ++ai)
#pragma unroll
            for (int m = 0; m < 4; ++m) {
                const size_t off = (size_t)(rowb + ai * HALF + m * 16) * ldc + col0;
#pragma unroll
                for (int bj = 0; bj < 2; ++bj)
#pragma unroll
                    for (int n = 0; n < 2; ++n) *(f32x4*)(Ob + off + bj * HALF + n * 16) = acc[ai][bj][m][n];
            }
    }
};
struct EpiQ {
    static constexpr bool PERM = true, AFTER_DRAIN = false;
    bf16_t* Q; const float* cosT; const float* sinT; float qscale;
    __device__ __forceinline__ void operator()(const f32x4 (&acc)[2][2][4][2], const Unit& u, int wr, int wc, int fr, int fq) const {
        const int row0 = u.pm * BM + wr * 64 + fr;
        if (u.pn < 4) {
#pragma unroll
            for (int ai = 0; ai < 2; ++ai)
#pragma unroll
                for (int m = 0; m < 4; ++m) {
                    const int row = row0 + ai * HALF + m * 16;
#pragma unroll
                    for (int bj = 0; bj < 2; ++bj) {
                        bf16_t* p = Q + (size_t)row * 1280 + (2 * u.pn + bj) * 160 + wc * 32 + 8 * fq;
                        const f32x4 v0 = acc[ai][bj][m][0] * qscale, v1 = acc[ai][bj][m][1] * qscale;
                        u32x4 w; w.x = cvt_pk_bf16(v0[0], v0[1]); w.y = cvt_pk_bf16(v0[2], v0[3]); w.z = cvt_pk_bf16(v1[0], v1[1]); w.w = cvt_pk_bf16(v1[2], v1[3]);
                        *(u32x4*)p = w;
                    }
                }
        } else {
#pragma unroll
            for (int ai = 0; ai < 2; ++ai)
#pragma unroll
                for (int m = 0; m < 4; ++m) {
                    const int row = row0 + ai * HALF + m * 16;
                    const int tix = row < 32768 ? (row & 8191) : 8192 + ((row - 32768) & 7);
                    const f32x4 c = *(const f32x4*)(cosT + tix * 16 + 4 * fq), s = *(const f32x4*)(sinT + tix * 16 + 4 * fq);
#pragma unroll
                    for (int bj = 0; bj < 2; ++bj) {
                        bf16_t* p = Q + (size_t)row * 1280 + (4 * bj + wc) * 160 + 128 + 8 * fq;
                        const f32x4 v0 = acc[ai][bj][m][0], v1 = acc[ai][bj][m][1];
                        u32x4 w;
                        w.x = cvt_pk_bf16((v0[0] * c[0] - v0[1] * s[0]) * qscale, (v0[0] * s[0] + v0[1] * c[0]) * qscale);
                        w.y = cvt_pk_bf16((v0[2] * c[1] - v0[3] * s[1]) * qscale, (v0[2] * s[1] + v0[3] * c[1]) * qscale);
                        w.z = cvt_pk_bf16((v1[0] * c[2] - v1[1] * s[2]) * qscale, (v1[0] * s[2] + v1[1] * c[2]) * qscale);
                        w.w = cvt_pk_bf16((v1[2] * c[3] - v1[3] * s[3]) * qscale, (v1[2] * s[3] + v1[3] * c[3]) * qscale);
                        *(u32x4*)p = w;
                    }
                }
        }
    }
};
template <class Epi, class Sched, bool ALIGN_EPI = false, bool SP2 = false>
__device__ __forceinline__ void gemm_phase(PG8_LAS unsigned char* lds, const Gemm g, const Sched& S, const Epi& E) {
    const int tid = threadIdx.x, wid = __builtin_amdgcn_readfirstlane(tid >> 6), lane = tid & 63, wr = wid >> 2, wc = wid & 3, fr = lane & 15, fq = lane >> 4;
    const int K = g.K, LD = g.ld ? g.ld : g.K, nt = K / BK;
    unsigned voffA[2], voffB[2];
#pragma unroll
    for (int i = 0; i < 2; ++i) { int R, C; stage_rc(tid * 16 + i * 8192, R, C); const int Rb = Epi::PERM ? ((R & ~31) + perm32(R & 31)) : R;
        voffA[i] = (unsigned)(R * LD + C) * 2u; voffB[i] = (unsigned)(Rb * LD + C) * 2u; }
    const size_t kstep = (size_t)(BK * 2);
    const size_t hstep = (size_t)HALF * LD * 2;
    const size_t tstep = 2 * hstep;
    const unsigned ldsw = (unsigned)wid * 1024u;
    const int aoff = lds_byte(wr * 64 + fr, fq * 8), boff = lds_byte(wc * 32 + fr, fq * 8);
#define PG8_SA(b, h) (((b) * 2 + (h)) * HTB)
#define PG8_SB(b, h) ((4 + (b) * 2 + (h)) * HTB)
#define PG8_STAGE(bufoff, gbase, voff) do { _Pragma("unroll") for (int _i = 0; _i < 2; ++_i) \
        __builtin_amdgcn_global_load_lds((const unsigned*)((const char*)(gbase) + (voff)[_i]), (PG8_LAS unsigned*)(lds + (bufoff) + ldsw + _i * 8192), 16, 0, 0); } while (0)
#define PG8_LDA(dst, b, h) do { _Pragma("unroll") for (int m = 0; m < 4; ++m) _Pragma("unroll") for (int k = 0; k < 2; ++k) dst[m][k] = *(const PG8_LAS bf16x8*)(lds + PG8_SA(b, h) + aoff + m * 2048 + k * 1024); } while (0)
#define PG8_LDB(dst, b, h) do { _Pragma("unroll") for (int n = 0; n < 2; ++n) _Pragma("unroll") for (int k = 0; k < 2; ++k) dst[n][k] = *(const PG8_LAS bf16x8*)(lds + PG8_SB(b, h) + boff + n * 2048 + k * 1024); } while (0)
#define PG8_MMA(ai, bj, At, Bt) do { __builtin_amdgcn_s_setprio(1); _Pragma("unroll") for (int m = 0; m < 4; ++m) _Pragma("unroll") for (int n = 0; n < 2; ++n) _Pragma("unroll") for (int k = 0; k < 2; ++k) \
        acc[ai][bj][m][n] = __builtin_amdgcn_mfma_f32_16x16x32_bf16(Bt[n][k], At[m][k], acc[ai][bj][m][n], 0, 0, 0); __builtin_amdgcn_s_setprio(0); } while (0)
#define PG8_WAIT_V(n) asm volatile("s_waitcnt vmcnt(" #n ")" ::: "memory")
#define PG8_WAIT_L(n) asm volatile("s_waitcnt lgkmcnt(" #n ")" ::: "memory")
#define PG8_BAR __builtin_amdgcn_s_barrier()
#define PG8_SCHED __builtin_amdgcn_sched_barrier(0)
    Unit cur, nxt; int ui = 0;
    if (!S.next(0, cur)) return;
    f32x4 acc[2][2][4][2];
#pragma unroll
    for (int a = 0; a < 2; ++a)
#pragma unroll
        for (int b = 0; b < 2; ++b)
#pragma unroll
            for (int m = 0; m < 4; ++m)
#pragma unroll
                for (int n = 0; n < 2; ++n) acc[a][b][m][n] = (f32x4){0.f, 0.f, 0.f, 0.f};
    bf16x8 At[4][2], B0[2][2], B1[2][2];
    const size_t sstep = (size_t)K * 2;
    const char* cA = (const char*)g.A + (size_t)cur.pm * tstep + (size_t)cur.pk * sstep; const char* cB = (const char*)g.Bt + (size_t)cur.pn * tstep + (size_t)cur.pk * sstep;
    S.a_ready(cur);
    if constexpr (SP2) {
        PG8_STAGE(PG8_SB(0, 0), cB, voffB); PG8_STAGE(PG8_SB(0, 1), cB + hstep, voffB); PG8_STAGE(PG8_SA(0, 0), cA, voffA); PG8_STAGE(PG8_SA(0, 1), cA + hstep, voffA);
        if (wr == 1) PG8_BAR;
        PG8_WAIT_V(2); PG8_BAR;
        PG8_STAGE(PG8_SB(1, 0), cB + kstep, voffB); PG8_STAGE(PG8_SA(1, 0), cA + kstep, voffA); PG8_STAGE(PG8_SB(1, 1), cB + hstep + kstep, voffB);
        PG8_WAIT_V(6); PG8_BAR;
    } else {
        PG8_STAGE(PG8_SB(0, 0), cB, voffB); PG8_STAGE(PG8_SA(0, 0), cA, voffA); PG8_STAGE(PG8_SB(0, 1), cB + hstep, voffB); PG8_STAGE(PG8_SA(0, 1), cA + hstep, voffA);
        if (wr == 1) PG8_BAR;
        PG8_WAIT_V(4); PG8_BAR;
        PG8_STAGE(PG8_SB(1, 0), cB + kstep, voffB); PG8_STAGE(PG8_SA(1, 0), cA + kstep, voffA); PG8_STAGE(PG8_SB(1, 1), cB + hstep + kstep, voffB);
        PG8_WAIT_V(6); PG8_BAR;
    }
    for (;;) {
        const bool has_next = S.next(ui + 1, nxt);
        const char* nA = has_next ? (const char*)g.A + (size_t)nxt.pm * tstep + (size_t)nxt.pk * sstep : cA; const char* nB = has_next ? (const char*)g.Bt + (size_t)nxt.pn * tstep + (size_t)nxt.pk * sstep : cB;
        for (int t = 0; t < nt; t += 2) {
            const bool last = (t == nt - 2);
            const char* a1 = cA + (size_t)(t + 1) * kstep;
            const char* a2 = last ? nA : cA + (size_t)(t + 2) * kstep; const char* b2 = last ? nB : cB + (size_t)(t + 2) * kstep;
            const char* a3 = a2 + kstep; const char* b3 = b2 + kstep;
            if (last && has_next) S.a_ready(nxt);
            if constexpr (SP2) {
            PG8_LDB(B0, 0, 0); PG8_LDB(B1, 0, 1); PG8_SCHED; PG8_LDA(At, 0, 0); PG8_STAGE(PG8_SA(1, 1), a1 + hstep, voffA);
            PG8_WAIT_V(8); PG8_WAIT_L(0); PG8_BAR; PG8_MMA(0, 0, At, B0); PG8_MMA(0, 1, At, B1); PG8_BAR; PG8_SCHED;
            PG8_LDA(At, 0, 1); PG8_STAGE(PG8_SB(0, 0), b2, voffB); PG8_STAGE(PG8_SB(0, 1), b2 + hstep, voffB); PG8_STAGE(PG8_SA(0, 0), a2, voffA);
            PG8_WAIT_V(8); PG8_WAIT_L(0); PG8_BAR; PG8_MMA(1, 0, At, B0); PG8_MMA(1, 1, At, B1); PG8_BAR; PG8_SCHED;
            PG8_LDB(B0, 1, 0); PG8_LDB(B1, 1, 1); PG8_SCHED; PG8_LDA(At, 1, 0); PG8_STAGE(PG8_SA(0, 1), a2 + hstep, voffA);
            PG8_WAIT_V(8); PG8_WAIT_L(0); PG8_BAR; PG8_MMA(0, 0, At, B0); PG8_MMA(0, 1, At, B1); PG8_BAR; PG8_SCHED;
            PG8_LDA(At, 1, 1); PG8_STAGE(PG8_SB(1, 0), b3, voffB); PG8_STAGE(PG8_SB(1, 1), b3 + hstep, voffB); PG8_STAGE(PG8_SA(1, 0), a3, voffA);
            PG8_WAIT_V(8); PG8_WAIT_L(0); PG8_BAR; PG8_MMA(1, 0, At, B0); PG8_MMA(1, 1, At, B1); PG8_BAR; PG8_SCHED;
            } else {
            PG8_LDB(B0, 0, 0); PG8_SCHED; PG8_LDA(At, 0, 0); PG8_STAGE(PG8_SA(1, 1), a1 + hstep, voffA);
            PG8_WAIT_L(8); PG8_BAR; PG8_WAIT_L(0); PG8_MMA(0, 0, At, B0); PG8_BAR; PG8_SCHED;
            PG8_LDB(B1, 0, 1); PG8_STAGE(PG8_SB(0, 0), b2, voffB);
            PG8_BAR; PG8_WAIT_L(0); PG8_MMA(0, 1, At, B1); PG8_BAR;
            PG8_LDA(At, 0, 1); PG8_STAGE(PG8_SA(0, 0), a2, voffA);
            PG8_BAR; PG8_WAIT_L(0); PG8_MMA(1, 0, At, B0); PG8_BAR; PG8_SCHED;
            PG8_STAGE(PG8_SB(0, 1), b2 + hstep, voffB);
            PG8_WAIT_V(6); PG8_BAR; PG8_MMA(1, 1, At, B1); PG8_BAR;
            PG8_LDB(B0, 1, 0); PG8_SCHED; PG8_LDA(At, 1, 0); PG8_STAGE(PG8_SA(0, 1), a2 + hstep, voffA);
            PG8_WAIT_L(8); PG8_BAR; PG8_WAIT_L(0); PG8_MMA(0, 0, At, B0); PG8_BAR; PG8_SCHED;
            PG8_LDB(B1, 1, 1); PG8_STAGE(PG8_SB(1, 0), b3, voffB);
            PG8_BAR; PG8_WAIT_L(0); PG8_MMA(0, 1, At, B1); PG8_BAR;
            PG8_LDA(At, 1, 1); PG8_STAGE(PG8_SA(1, 0), a3, voffA);
            PG8_BAR; PG8_WAIT_L(0); PG8_MMA(1, 0, At, B0); PG8_BAR; PG8_SCHED;
            PG8_STAGE(PG8_SB(1, 1), b3 + hstep, voffB);
            PG8_WAIT_V(6); PG8_BAR; PG8_MMA(1, 1, At, B1); PG8_BAR;
            }
        }
        if constexpr (ALIGN_EPI) { if (wr == 0) PG8_BAR; }
        if constexpr (!Epi::AFTER_DRAIN) { E(acc, cur, wr, wc, fr, fq); S.done(cur); }
        if (!has_next) break;
#pragma unroll
        for (int a = 0; a < 2; ++a)
#pragma unroll
            for (int b = 0; b < 2; ++b)
#pragma unroll
                for (int m = 0; m < 4; ++m)
#pragma unroll
                    for (int n = 0; n < 2; ++n) acc[a][b][m][n] = (f32x4){0.f, 0.f, 0.f, 0.f};
        cur = nxt; cA = nA; cB = nB; ++ui;
        if constexpr (ALIGN_EPI) { if (wr == 1) PG8_BAR; }
    }
    PG8_WAIT_V(0);
    if constexpr (!ALIGN_EPI) { if (wr == 0) PG8_BAR; }
    PG8_BAR;
    if constexpr (Epi::AFTER_DRAIN) { E.fused(acc, cur, wr, wc, fr, fq, lds, wid, lane); S.done(cur); }
#undef PG8_SA
#undef PG8_SB
#undef PG8_STAGE
#undef PG8_LDA
#undef PG8_LDB
#undef PG8_MMA
#undef PG8_WAIT_V
#undef PG8_WAIT_L
#undef PG8_BAR
#undef PG8_SCHED
}
}
constexpr int NWAVES = 8;
constexpr int DM = 1024, SEQ = 8192, NB = 4, DB = 128, DS = 8, FF = 2816;
constexpr int MP = NB * SEQ, MS = DB * DS, M = MP + MS;
constexpr int QR = 256, KVR = 128, RD = 32, RWC = 1792, INC = 2208, INP = 2304, RWD = 512;
constexpr int NPAGE = 128, PAGE = 128;
constexpr float ALPHA = 1.189207115002721f;
constexpr float QSCALE = 0.10206207261596577f * 1.4426950408889634f;
constexpr float LN_EPS = 1e-5f, RMS_EPS = 1e-6f, GN_EPS = 64e-5f;
constexpr size_t O_YP = 0, O_YS = 33554432, O_CKVP = 34603008, O_KRP = 38797312, O_WKVP = 39845888, O_SHP = 39976960,
                 O_CKVS = 39984128, O_KRS = 40115200, O_WKVS = 40147968, O_SHS = 44342272, O_END = 44571648;
constexpr size_t MiB = 1u << 20;
constexpr size_t WS_CTL = 0, CTL_ZERO_BYTES = 1 * MiB;
constexpr size_t WS_WGUA = 2 * MiB, WS_WDA = 13 * MiB, WS_WGUB = 19 * MiB, WS_WDB = 30 * MiB, WS_WIN = 36 * MiB, WS_WQ = 41 * MiB, WS_WO = 42 * MiB, WS_WL = 45 * MiB, WS_ROPE = 46 * MiB;
constexpr size_t WS_XNB = 48 * MiB, WS_HB = 114 * MiB, WS_Z = 296 * MiB, WS_X1 = 428 * MiB, WS_X2 = 560 * MiB, WS_PROJ = 692 * MiB, WS_CQN = 989 * MiB, WS_QB = 1006 * MiB;
constexpr size_t WS_CKVB = 1089 * MiB, WS_KRB = 1098 * MiB, WS_RKV = 1101 * MiB, WS_LA = 1299 * MiB, WS_LO = 1316 * MiB, WS_SC5 = 1514 * MiB, WS_G = 1844 * MiB, WS_SCAL = 1910 * MiB;
constexpr size_t WS_Y = 1915 * MiB, WS_OM = 1981 * MiB, WS_PO = 2080 * MiB, WS_PML = 2112 * MiB, WS_PART = 2113 * MiB, WS_OPS = 2161 * MiB, WS_G15 = 2321 * MiB, WS_END = 2325 * MiB;
constexpr int ROPE_N = 8200;
constexpr int CW_TMO = 0, CW_QHEAD = 64, CW_BAR = 4096;
constexpr int RING_OFF = 0, RING_BYTES = 131072, LDSCTL_OFF = RING_BYTES, MISC_OFF = LDSCTL_OFF + 320, LDS_BYTES = 147456;

#define GAS __attribute__((address_space(1)))
#define LAS __attribute__((address_space(3)))
typedef unsigned short bf16;
typedef unsigned v4u __attribute__((ext_vector_type(4)));
typedef unsigned v2u __attribute__((ext_vector_type(2)));
typedef float f32x4 __attribute__((ext_vector_type(4)));
typedef float f32x2 __attribute__((ext_vector_type(2)));
typedef short bf16x8 __attribute__((ext_vector_type(8)));
typedef short s16x4 __attribute__((ext_vector_type(4)));
typedef float f32x16 __attribute__((ext_vector_type(16)));
typedef GAS unsigned gu32;
#define RLX_AGENT __ATOMIC_RELAXED, __HIP_MEMORY_SCOPE_AGENT
#define DI __device__ __forceinline__
DI unsigned f2bf(float f) { unsigned u = __builtin_bit_cast(unsigned, f); return (u + 0x7fffu + ((u >> 16) & 1u)) >> 16; }
DI unsigned pk2(float lo, float hi) { return f2bf(lo) | (f2bf(hi) << 16); }
DI float wave_sum(float v) {
#pragma unroll
    for (int o = 1; o < 64; o <<= 1) v += __shfl_xor(v, o);
    return v;
}
#define XB_TMO      128
#define XB_XCNT(j)  (256  + 64 * (j))
#define XB_XSUB(j)  (1280 + 64 * (j))
#define XB_XGEN(j)  (2304 + 64 * (j))
#define XB_TOP      3328
#define XB_TOPGEN   3392
#define XCD_BAR_WORDS 3456
#define XB_SPIN_CAP (1u << 18)

__device__ __forceinline__ unsigned xb_ld(unsigned* p)              { return __hip_atomic_load(p, __ATOMIC_RELAXED, __HIP_MEMORY_SCOPE_AGENT); }
__device__ __forceinline__ unsigned xb_add(unsigned* p, unsigned v) { return __hip_atomic_fetch_add(p, v, __ATOMIC_RELAXED, __HIP_MEMORY_SCOPE_AGENT); }
__device__ __forceinline__ unsigned xb_xcc_id() { return (unsigned)__builtin_amdgcn_s_getreg((3 << 11) | 20) & 0xFu; }
#define XB_SPIN(cond, bar) do { unsigned _sp = 0; while (cond) { __builtin_amdgcn_s_sleep(1); \
    if ((++_sp & 255u) == 0u) { if (xb_ld(&(bar)[XB_TMO])) break; if (_sp > XB_SPIN_CAP) { atomicAdd(&(bar)[XB_TMO], 1u); break; } } } } while (0)

struct XcdBarrier {
    unsigned* bar; unsigned x;
    volatile LAS unsigned* st;
};

__device__ __forceinline__ XcdBarrier xcd_barrier_post(unsigned* bar, volatile LAS unsigned* st) {
    XcdBarrier b; b.bar = bar; b.x = xb_xcc_id(); b.st = st;
    if (threadIdx.x == 0) (void)xb_add(&bar[XB_XCNT(b.x)], 1u);
    return b;
}
__device__ __forceinline__ void xcd_barrier_complete(unsigned* bar, unsigned x, unsigned& nloc, unsigned& nx) {
    const unsigned G = gridDim.x * gridDim.y * gridDim.z;
    unsigned sum, cnt, mine, sp = 0u;
    for (;;) {
        sum = 0u; cnt = 0u; mine = 0u;
#pragma unroll
        for (unsigned j = 0; j < 16; ++j) { const unsigned c = xb_ld(&bar[XB_XCNT(j)]); sum += c; cnt += (c > 0u) ? 1u : 0u; mine = (j == x) ? c : mine; }
        if (sum == G) break;
        __builtin_amdgcn_s_sleep(1);
        if ((++sp & 255u) == 0u) { if (xb_ld(&bar[XB_TMO])) break; if (sp > XB_SPIN_CAP) { atomicAdd(&bar[XB_TMO], 1u); break; } }
    }
    nloc = mine > 0u ? mine : 1u; nx = cnt > 0u ? cnt : 1u;
}

__device__ __forceinline__ void xcd_barrier(const XcdBarrier& b) {
    asm volatile("s_waitcnt vmcnt(0)" ::: "memory");
    __syncthreads();
    if (threadIdx.x == 0) {
        unsigned* bar = b.bar;
        __builtin_amdgcn_s_waitcnt(0);
        unsigned nloc = b.st[0], nx = b.st[1];
        if (nloc == 0u) { xcd_barrier_complete(bar, b.x, nloc, nx); b.st[0] = nloc; b.st[1] = nx; }
        const unsigned old = xb_add(&bar[XB_XSUB(b.x)], 1u);
        const unsigned gen = old / nloc;
        if (old + 1u == (gen + 1u) * nloc) {
            __builtin_amdgcn_fence(__ATOMIC_RELEASE, "agent");
            asm volatile("s_waitcnt vmcnt(0)" ::: "memory");
            const unsigned og = xb_add(&bar[XB_TOP], 1u);
            const unsigned tg = og / nx;
            if (og + 1u == (tg + 1u) * nx) xb_add(&bar[XB_TOPGEN], 1u);
            else XB_SPIN(xb_ld(&bar[XB_TOPGEN]) == tg, bar);
            __builtin_amdgcn_fence(__ATOMIC_ACQUIRE, "agent");
            xb_add(&bar[XB_XGEN(b.x)], 1u);
            asm volatile("s_waitcnt vmcnt(0)" ::: "memory");
        } else {
            XB_SPIN(xb_ld(&bar[XB_XGEN(b.x)]) == gen, bar);
            __builtin_amdgcn_fence(__ATOMIC_ACQUIRE, "agent");
            asm volatile("s_waitcnt vmcnt(0)" ::: "memory");
        }
    }
    __syncthreads();
}
DI void p0_transpose_item(const float* W, int K, int N, bf16* WT, int kb, int nb, int drow0, LAS float* scr, int lane) {
    const int k0 = 64 * kb, n0 = 32 * nb;
#pragma unroll 8
    for (int i = 0; i < 32; ++i) { const int kk = 2 * i + (lane >> 5); scr[kk * 33 + (lane & 31)] = W[(size_t)(k0 + kk) * N + n0 + (lane & 31)]; }
    asm volatile("s_waitcnt lgkmcnt(0)" ::: "memory");
    const int c = lane & 7;
#pragma unroll
    for (int j = 0; j < 4; ++j) { const int n = (lane >> 3) + 8 * j; const LAS float* s = scr + (8 * c) * 33 + n;
        v4u o; o.x = pk2(s[0 * 33], s[1 * 33]); o.y = pk2(s[2 * 33], s[3 * 33]); o.z = pk2(s[4 * 33], s[5 * 33]); o.w = pk2(s[6 * 33], s[7 * 33]);
        *(GAS v4u*)(WT + (size_t)(drow0 + n) * K + k0 + 8 * c) = o; }
    asm volatile("s_waitcnt lgkmcnt(0)" ::: "memory");
}
DI int gu_row(int n, int up) { return 256 * (n >> 7) + (n & 127) + (up ? 128 : 0); }

DI void sincos_d(double r, double& s, double& c) {
    const double z = r * r;
    double ps = -9.18368986379554601e-29; ps = ps * z + 6.44695028438447359e-26; ps = ps * z - 3.86817017063068413e-23; ps = ps * z + 1.95729410633912626e-20; ps = ps * z - 8.22063524662432950e-18;
    ps = ps * z + 2.81145725434552060e-15; ps = ps * z - 7.64716373181981641e-13; ps = ps * z + 1.60590438368216133e-10; ps = ps * z - 2.50521083854417202e-08; ps = ps * z + 2.75573192239858925e-06;
    ps = ps * z - 1.98412698412698413e-04; ps = ps * z + 8.33333333333333322e-03; ps = ps * z - 1.66666666666666657e-01; ps = ps * z + 1.0; s = ps * r;
    double pc = 3.27988923706983776e-30; pc = pc * z - 2.47959626322479759e-27; pc = pc * z + 1.61173757109611839e-24; pc = pc * z - 8.89679139245057408e-22; pc = pc * z + 4.11031762331216484e-19;
    pc = pc * z - 1.56192069685862253e-16; pc = pc * z + 4.77947733238738525e-14; pc = pc * z - 1.14707455977297245e-11; pc = pc * z + 2.08767569878681002e-09; pc = pc * z - 2.75573192239858883e-07;
    pc = pc * z + 2.48015873015873016e-05; pc = pc * z - 1.38888888888888894e-03; pc = pc * z + 4.16666666666666644e-02; pc = pc * z - 0.5; pc = pc * z + 1.0; c = pc;
}

struct Args { const float* in[37]; float* out; unsigned char* ws; int ph_lo, ph_hi; };
static_assert(sizeof(Args) == 37 * 8 + 8 + 8 + 8, "Args has no padding");
typedef const __attribute__((address_space(4))) Args Ptrs;
DI Ptrs* args_here() { Ptrs* p = (Ptrs*)__builtin_amdgcn_kernarg_segment_ptr(); asm volatile("" : "+s"(p)); return p; }

DI void p0_prologue(const Ptrs& P, LAS unsigned char* lds, int gw, int NGW, int wave, int lane) {
    unsigned char* ws = P.ws;
    LAS float* scr = (LAS float*)(lds + RING_OFF + wave * 16384);
    constexpr int I_GU = (DM / 64) * (FF / 32), I_D = (FF / 64) * (DM / 32), I_IN = (DM / 64) * (INC / 32);
    constexpr int NITEMS = 6 * I_GU + I_IN;
    for (int it = gw; it < NITEMS; it += NGW) {
        int r = it;
        if (r < 4 * I_GU) {
            const int which = r / I_GU; r -= which * I_GU; const int nblk = FF / 32, kb = r / nblk, nb = r % nblk;
            const float* W = which == 0 ? P.in[9] : which == 1 ? P.in[10] : which == 2 ? P.in[32] : P.in[33];
            bf16* WT = (bf16*)(ws + (which < 2 ? WS_WGUA : WS_WGUB));
            p0_transpose_item(W, DM, FF, WT, kb, nb, gu_row(32 * nb, which & 1), scr, lane); continue; }
        r -= 4 * I_GU;
        if (r < 2 * I_D) { const int which = r / I_D; r -= which * I_D; const int nblk = DM / 32, kb = r / nblk, nb = r % nblk;
            p0_transpose_item(which ? P.in[34] : P.in[11], FF, DM, (bf16*)(ws + (which ? WS_WDB : WS_WDA)), kb, nb, 32 * nb, scr, lane); continue; }
        r -= 2 * I_D;
        { const int nblk = INC / 32, kb = r / nblk, nb = r % nblk; p0_transpose_item(P.in[12], DM, INC, (bf16*)(ws + WS_WIN), kb, nb, 32 * nb, scr, lane); }
    }
    const int gt = gw * 64 + lane, NGT = NGW * 64;
    { GAS v4u* z = (GAS v4u*)(ws + WS_WIN + (size_t)INC * DM * 2); for (int i = gt; i < (INP - INC) * DM * 2 / 16; i += NGT) z[i] = (v4u){0u, 0u, 0u, 0u}; }
    { bf16* WL = (bf16*)(ws + WS_WL); const float* wl = P.in[20]; const float* al = P.in[22]; const float* gl = P.in[23];
      for (int i = gt; i < 1536 * 256; i += NGT) { const int n = i >> 8, k = i & 255; float v = 0.f;
          if (n < 512) { if (k < 64) v = wl[k * 512 + n]; }
          else if (n < 1024) { if (k >= 64 && k < 128) v = al[(k - 64) * 512 + (n - 512)]; }
          else { if (k >= 128) v = gl[(k - 128) * 512 + (n - 1024)]; }
          WL[i] = (bf16)f2bf(v); } }
    { bf16* WQ = (bf16*)(ws + WS_WQ); const float* uq = P.in[14]; const float* uk = P.in[16];
      for (int i = gt; i < 1280 * 256; i += NGT) { const int n = i >> 8, c = i & 255; float v;
          if (n < 1024) { const int hd = n >> 7, r = n & 127; const float* a = uq + c * 768 + hd * 96; const float* b = uk + r * 512 + hd * 64; float s = 0.f;
              for (int j = 0; j < 64; ++j) s += a[j] * b[j]; v = s; }
          else { const int hd = (n - 1024) >> 5, cp = (n - 1024) & 31, p = (cp >> 1) + 16 * (cp & 1); v = uq[c * 768 + hd * 96 + 64 + p]; }
          WQ[i] = (bf16)f2bf(v); } }
    { bf16* WO = (bf16*)(ws + WS_WO); const float* uv = P.in[17]; const float* wo = P.in[29];
      for (int i = gt; i < 1536 * 1024; i += NGT) { const int k = i >> 10, n = i & 1023; float v;
          if (k < 1024) { const int hd = k >> 7, r = k & 127; const float* a = uv + r * 512 + hd * 64; const float* b = wo + (size_t)(hd * 64) * 1024 + n; float s = 0.f;
              for (int j = 0; j < 64; ++j) s += a[j] * b[(size_t)j * 1024]; v = s; }
          else v = wo[(size_t)(512 + k - 1024) * 1024 + n];
          WO[(size_t)n * 1536 + k] = (bf16)f2bf(v); } }
    { float* ct = (float*)(ws + WS_ROPE); float* st = ct + ROPE_N * 16;
      for (int i = gt; i < ROPE_N * 16; i += NGT) { const int tix = i >> 4, f = i & 15; const double pos = (double)(tix < 8192 ? tix : 16384 + (tix - 8192));
          double inv = 1.0; for (int q = 0; q < f; ++q) inv *= 0.5623413251903491;
          const double ang = pos * inv; const double kq = __builtin_rint(ang * 0.15915494309189535); const double r = __builtin_fma(-kq, 6.283185307179586, ang) - kq * 2.4492935982947064e-16;
          double s, c; sincos_d(r, s, c); ct[i] = (float)c; st[i] = (float)s; } }
    { bf16* XNB = (bf16*)(ws + WS_XNB);
      for (int m = gw; m < M; m += NGW) { const float* xr = m < MP ? P.in[0] + (size_t)m * DM : P.in[1] + (size_t)(m - MP) * DM;
          const GAS f32x4* x4 = (const GAS f32x4*)xr + lane; GAS v2u* o = (GAS v2u*)(XNB + (size_t)m * DM) + lane;
#pragma unroll
          for (int j = 0; j < 4; ++j) { const f32x4 v = x4[64 * j]; o[64 * j] = (v2u){pk2(v.x, v.y), pk2(v.z, v.w)}; } } }
}

DI void ln_phase(const float* Z, const float* g, const float* b, float* Xf, bf16* Xb, const float* part, int nk, const float* sbase, float alpha, float sc, int gw, int NGW, int lane) {
    f32x4 gv[4], bv[4];
#pragma unroll
    for (int j = 0; j < 4; ++j) { gv[j] = ((const GAS f32x4*)g)[lane + 64 * j]; bv[j] = ((const GAS f32x4*)b)[lane + 64 * j]; }
    for (int m = gw; m < M; m += NGW) {
        f32x4 v[4]; float s = 0.f;
        if (m < MP) {
            const GAS f32x4* zr = (const GAS f32x4*)(Z + (size_t)m * DM) + lane;
#pragma unroll
            for (int j = 0; j < 4; ++j) v[j] = zr[64 * j];
        } else {
            const GAS f32x4* br = (const GAS f32x4*)(sbase + (size_t)(m - MP) * DM) + lane; f32x4 a[4];
#pragma unroll
            for (int j = 0; j < 4; ++j) { v[j] = br[64 * j] * alpha; a[j] = (f32x4){0.f, 0.f, 0.f, 0.f}; }
            for (int k = 0; k < nk; ++k) { const GAS f32x4* pr = (const GAS f32x4*)(part + ((size_t)k * MS + (m - MP)) * DM) + lane;
#pragma unroll
                for (int j = 0; j < 4; ++j) a[j] += pr[64 * j]; }
#pragma unroll
            for (int j = 0; j < 4; ++j) v[j] += a[j] * sc;
        }
#pragma unroll
        for (int j = 0; j < 4; ++j) s += (v[j].x + v[j].y) + (v[j].z + v[j].w);
        const float mean = wave_sum(s) * (1.f / DM); float s2 = 0.f;
#pragma unroll
        for (int j = 0; j < 4; ++j) { v[j] = v[j] - mean; s2 += (v[j].x * v[j].x + v[j].y * v[j].y) + (v[j].z * v[j].z + v[j].w * v[j].w); }
        const float rstd = 1.f / sqrtf(wave_sum(s2) * (1.f / DM) + LN_EPS);
#pragma unroll
        for (int j = 0; j < 4; ++j) { v[j] = v[j] * rstd * gv[j] + bv[j]; }
        if (Xf) { GAS f32x4* o = (GAS f32x4*)(Xf + (size_t)m * DM) + lane;
#pragma unroll
            for (int j = 0; j < 4; ++j) o[64 * j] = v[j]; }
        if (Xb) { GAS v2u* o = (GAS v2u*)(Xb + (size_t)m * DM) + lane;
#pragma unroll
            for (int j = 0; j < 4; ++j) o[64 * j] = (v2u){pk2(v[j].x, v[j].y), pk2(v[j].z, v[j].w)}; }
    }
}

DI void prep_a(const Ptrs& P, int gw, int NGW, int lane) {
    unsigned char* ws = P.ws;
    const float* PROJ = (const float*)(ws + WS_PROJ);
    bf16* CQN = (bf16*)(ws + WS_CQN); bf16* CKVB = (bf16*)(ws + WS_CKVB); bf16* KRB = (bf16*)(ws + WS_KRB);
    float* RKV = (float*)(ws + WS_RKV); bf16* LA = (bf16*)(ws + WS_LA);
    const float* ct = (const float*)(ws + WS_ROPE); const float* st = ct + ROPE_N * 16;
    const float* qg = P.in[13]; const float* kg = P.in[15]; const float* mu = P.in[18]; const float* sshift = P.in[5];
    const f32x4 qg4 = ((const GAS f32x4*)qg)[lane]; const f32x2 kg2 = ((const GAS f32x2*)kg)[lane];
    f32x4 mu4[7];
#pragma unroll
    for (int i = 0; i < 7; ++i) mu4[i] = ((const GAS f32x4*)mu)[lane + 64 * i];
    for (int m = gw; m < M; m += NGW) {
        const bool samp = m >= MP; const int ms = m - MP;
        const int bb = samp ? (ms >> 3) : (m >> 13), t = samp ? (ms & 7) : (m & 8191), tix = samp ? 8192 + t : t;
        const float* pr = PROJ + (size_t)m * INP;
        { const f32x4 v = ((const GAS f32x4*)pr)[lane]; const float ss = wave_sum((v.x * v.x + v.y * v.y) + (v.z * v.z + v.w * v.w));
          const float rs = 1.f / sqrtf(ss * (1.f / QR) + RMS_EPS);
          ((GAS v2u*)(CQN + (size_t)m * QR))[lane] = (v2u){pk2(v.x * rs * qg4.x, v.y * rs * qg4.y), pk2(v.z * rs * qg4.z, v.w * rs * qg4.w)}; }
        { const f32x2 v = ((const GAS f32x2*)(pr + QR))[lane]; const float ss = wave_sum(v.x * v.x + v.y * v.y);
          const float rs = 1.f / sqrtf(ss * (1.f / KVR) + RMS_EPS); const float a = v.x * rs * kg2.x, b = v.y * rs * kg2.y;
          float* o = samp ? P.out + O_CKVS + (size_t)ms * KVR : P.out + O_CKVP + (size_t)m * KVR;
          ((GAS f32x2*)o)[lane] = (f32x2){a, b}; ((GAS unsigned*)(CKVB + (size_t)m * KVR))[lane] = pk2(a, b); }
        { const int l31 = lane & 31; const float v = pr[QR + KVR + l31]; const float pv = __shfl_xor(v, 16); const int p = lane & 15;
          const float c = ct[tix * 16 + p], s = st[tix * 16 + p];
          const float o = (l31 < 16) ? v * c - pv * s : pv * s + v * c;
          if (lane < 32) { float* op = samp ? P.out + O_KRS + (size_t)ms * RD : P.out + O_KRP + (size_t)m * RD; op[lane] = o; }
          const float ohi = __shfl_down(o, 16);
          if (lane < 16) ((GAS unsigned*)(KRB + (size_t)m * RD))[lane] = pk2(o, ohi); }
        { const GAS f32x4* rw4 = (const GAS f32x4*)(pr + (INC - RWC));
          const GAS f32x4* pv4 = (t == 0) ? (samp ? (const GAS f32x4*)(sshift + (size_t)bb * RWC) : (const GAS f32x4*)nullptr) : (const GAS f32x4*)(pr - INP + (INC - RWC));
          const bool last = samp ? (t == DS - 1) : (t == SEQ - 1);
          float* sh = samp ? P.out + O_SHS + (size_t)bb * RWC : P.out + O_SHP + (size_t)bb * RWC;
#pragma unroll
          for (int i = 0; i < 7; ++i) {
              const f32x4 r = rw4[lane + 64 * i]; const f32x4 pv = pv4 ? pv4[lane + 64 * i] : (f32x4){0.f, 0.f, 0.f, 0.f};
              const f32x4 x = r + (pv - r) * mu4[i];
              if (last) ((GAS f32x4*)sh)[lane + 64 * i] = r;
              if (i < 6) ((GAS f32x4*)(RKV + (size_t)m * 1536))[lane + 64 * i] = x;
              else { f32x4 y;
                  if (lane < 16) { for (int j = 0; j < 4; ++j) { const float e = __expf(2.f * x[j]); y[j] = 1.f - 2.f / (e + 1.f); } }
                  else if (lane < 32) y = x;
                  else { for (int j = 0; j < 4; ++j) y[j] = 1.f / (1.f + __expf(-x[j])); }
                  ((GAS v2u*)(LA + (size_t)m * 256))[lane] = (v2u){pk2(y.x, y.y), pk2(y.z, y.w)}; }
          } }
    }
}

DI float red8(float v) { v += __shfl_xor(v, 1); v += __shfl_xor(v, 2); v += __shfl_xor(v, 4); return v; }
DI void prep_c(const Ptrs& P, int gw, int NGW, int lane) {
    unsigned char* ws = P.ws;
    const float* RKV = (const float*)(ws + WS_RKV); const float* LO = (const float*)(ws + WS_LO);
    float* SC5 = (float*)(ws + WS_SC5); float* G = (float*)(ws + WS_G); float* SCAL = (float*)(ws + WS_SCAL);
    constexpr size_t ASZ = (size_t)M * RWD;
    const int c0 = lane * 8;
    float w0v[8], a0v[8], kkv[8], kav[8], rkv[8];
#pragma unroll
    for (int j = 0; j < 8; ++j) { w0v[j] = P.in[19][c0 + j]; a0v[j] = P.in[21][c0 + j]; kkv[j] = P.in[24][c0 + j]; kav[j] = P.in[25][c0 + j]; rkv[j] = P.in[26][c0 + j]; }
    for (int m = gw; m < M; m += NGW) {
        const float* rk = RKV + (size_t)m * 1536 + c0; const float* lo = LO + (size_t)m * 1536 + c0;
        float r[8], k[8], wl[8], al[8], gl[8];
        { const f32x4 a = ((const GAS f32x4*)rk)[0], b = ((const GAS f32x4*)rk)[1]; r[0]=a.x; r[1]=a.y; r[2]=a.z; r[3]=a.w; r[4]=b.x; r[5]=b.y; r[6]=b.z; r[7]=b.w; }
        { const f32x4 a = ((const GAS f32x4*)(rk + 512))[0], b = ((const GAS f32x4*)(rk + 512))[1]; k[0]=a.x; k[1]=a.y; k[2]=a.z; k[3]=a.w; k[4]=b.x; k[5]=b.y; k[6]=b.z; k[7]=b.w; }
        { const f32x4 a = ((const GAS f32x4*)lo)[0], b = ((const GAS f32x4*)lo)[1]; wl[0]=a.x; wl[1]=a.y; wl[2]=a.z; wl[3]=a.w; wl[4]=b.x; wl[5]=b.y; wl[6]=b.z; wl[7]=b.w; }
        { const f32x4 a = ((const GAS f32x4*)(lo + 512))[0], b = ((const GAS f32x4*)(lo + 512))[1]; al[0]=a.x; al[1]=a.y; al[2]=a.z; al[3]=a.w; al[4]=b.x; al[5]=b.y; al[6]=b.z; al[7]=b.w; }
        { const f32x4 a = ((const GAS f32x4*)(lo + 1024))[0], b = ((const GAS f32x4*)(lo + 1024))[1]; gl[0]=a.x; gl[1]=a.y; gl[2]=a.z; gl[3]=a.w; gl[4]=b.x; gl[5]=b.y; gl[6]=b.z; gl[7]=b.w; }
        float dec[8], av[8], kk[8], kp[8]; float nn = 0.f;
#pragma unroll
        for (int j = 0; j < 8; ++j) {
            const float z = -(w0v[j] + wl[j]);
            const float sp = fmaxf(z, 0.f) + log1pf(__expf(-fabsf(z)));
            const float w = -sp - 0.5f; dec[j] = __expf(-__expf(w));
            av[j] = 1.f / (1.f + __expf(-(a0v[j] + al[j])));
            kk[j] = k[j] * kkv[j]; nn += kk[j] * kk[j];
            kp[j] = k[j] * (1.f + (av[j] - 1.f) * kav[j]);
        }
        nn = red8(nn); const float inv = 1.f / fmaxf(sqrtf(nn), 1e-12f);
        float as[8], bs[8], wr[8]; float br = 0.f, kr = 0.f, bon = 0.f;
#pragma unroll
        for (int j = 0; j < 8; ++j) { const float kn = kk[j] * inv; as[j] = -kn; bs[j] = kn * av[j]; wr[j] = dec[j] * r[j]; br += bs[j] * r[j]; kr += kp[j] * r[j]; bon += r[j] * kp[j] * rkv[j]; }
        br = red8(br); kr = red8(kr); bon = red8(bon);
        float* o = SC5 + (size_t)m * RWD + c0;
        ((GAS f32x4*)o)[0] = (f32x4){as[0], as[1], as[2], as[3]}; ((GAS f32x4*)o)[1] = (f32x4){as[4], as[5], as[6], as[7]}; o += ASZ;
        ((GAS f32x4*)o)[0] = (f32x4){wr[0], wr[1], wr[2], wr[3]}; ((GAS f32x4*)o)[1] = (f32x4){wr[4], wr[5], wr[6], wr[7]}; o += ASZ;
        ((GAS f32x4*)o)[0] = (f32x4){dec[0], dec[1], dec[2], dec[3]}; ((GAS f32x4*)o)[1] = (f32x4){dec[4], dec[5], dec[6], dec[7]}; o += ASZ;
        ((GAS f32x4*)o)[0] = (f32x4){bs[0], bs[1], bs[2], bs[3]}; ((GAS f32x4*)o)[1] = (f32x4){bs[4], bs[5], bs[6], bs[7]}; o += ASZ;
        ((GAS f32x4*)o)[0] = (f32x4){kp[0], kp[1], kp[2], kp[3]}; ((GAS f32x4*)o)[1] = (f32x4){kp[4], kp[5], kp[6], kp[7]};
        float* go = G + (size_t)m * RWD + c0;
        ((GAS f32x4*)go)[0] = (f32x4){gl[0], gl[1], gl[2], gl[3]}; ((GAS f32x4*)go)[1] = (f32x4){gl[4], gl[5], gl[6], gl[7]};
        if ((lane & 7) == 0) ((GAS f32x4*)(SCAL + ((size_t)m * 8 + (lane >> 3)) * 4))[0] = (f32x4){br * 0.0625f, kr * 0.0625f, bon, 0.f};
    }
}

DI void post_phase(const Ptrs& P, int gw, int NGW, int lane) {
    unsigned char* ws = P.ws;
    bf16* OM = (bf16*)(ws + WS_OM);
    { const float* PO = (const float*)(ws + WS_PO); const float* PML = (const float*)(ws + WS_PML);
      for (int it = gw; it < DB * 64; it += NGW) { const int b = it >> 6, qr = it & 63;
          float mi[8], li[8]; float mx = -3.0e38f;
#pragma unroll
          for (int s = 0; s < 8; ++s) { const f32x2 ml = ((const GAS f32x2*)PML)[(size_t)(b * 8 + s) * 64 + qr]; mi[s] = ml.x; li[s] = ml.y; mx = fmaxf(mx, ml.x); }
          float L = 0.f; f32x2 acc = {0.f, 0.f};
#pragma unroll
          for (int s = 0; s < 8; ++s) { const float w = __builtin_amdgcn_exp2f(mi[s] - mx); L += li[s] * w;
              const f32x2 o = ((const GAS f32x2*)(PO + ((size_t)(b * 8 + s) * 64 + qr) * 128))[lane]; acc += o * w; }
          const float inv = 1.f / L; const int tq = qr >> 3, hd = qr & 7;
          ((GAS unsigned*)(OM + (size_t)(MP + b * 8 + tq) * 1536 + hd * 128))[lane] = pk2(acc.x * inv, acc.y * inv); } }
    { const float* Y = (const float*)(ws + WS_Y); const float* RKV = (const float*)(ws + WS_RKV); const float* G = (const float*)(ws + WS_G); const float* SCAL = (const float*)(ws + WS_SCAL);
      const int c0 = lane * 8; float lg[8], lb[8];
#pragma unroll
      for (int j = 0; j < 8; ++j) { lg[j] = P.in[27][c0 + j]; lb[j] = P.in[28][c0 + j]; }
      for (int m = gw; m < M; m += NGW) {
          float y[8], v[8], g[8];
          { const GAS f32x4* p = (const GAS f32x4*)(Y + (size_t)m * RWD + c0); const f32x4 a = p[0], b = p[1]; y[0]=a.x; y[1]=a.y; y[2]=a.z; y[3]=a.w; y[4]=b.x; y[5]=b.y; y[6]=b.z; y[7]=b.w; }
          { const GAS f32x4* p = (const GAS f32x4*)(RKV + (size_t)m * 1536 + 1024 + c0); const f32x4 a = p[0], b = p[1]; v[0]=a.x; v[1]=a.y; v[2]=a.z; v[3]=a.w; v[4]=b.x; v[5]=b.y; v[6]=b.z; v[7]=b.w; }
          { const GAS f32x4* p = (const GAS f32x4*)(G + (size_t)m * RWD + c0); const f32x4 a = p[0], b = p[1]; g[0]=a.x; g[1]=a.y; g[2]=a.z; g[3]=a.w; g[4]=b.x; g[5]=b.y; g[6]=b.z; g[7]=b.w; }
          const float bon = SCAL[((size_t)m * 8 + (lane >> 3)) * 4 + 2];
          float s = 0.f;
#pragma unroll
          for (int j = 0; j < 8; ++j) s += y[j];
          const float mean = red8(s) * (1.f / 64.f); float q = 0.f;
#pragma unroll
          for (int j = 0; j < 8; ++j) { y[j] -= mean; q += y[j] * y[j]; }
          const float rstd = 1.f / sqrtf(red8(q) * (1.f / 64.f) + GN_EPS);
          float o[8];
#pragma unroll
          for (int j = 0; j < 8; ++j) o[j] = (y[j] * rstd * lg[j] + lb[j] + bon * v[j]) * g[j];
          *(GAS v4u*)(OM + (size_t)m * 1536 + 1024 + c0) = (v4u){pk2(o[0], o[1]), pk2(o[2], o[3]), pk2(o[4], o[5]), pk2(o[6], o[7])};
      } }
}
namespace cs {
typedef float f4 __attribute__((ext_vector_type(4)));
DI unsigned cvtpk(float lo, float hi) { typedef float f2 __attribute__((ext_vector_type(2))); typedef __bf16 b2 __attribute__((ext_vector_type(2))); f2 v = {lo, hi}; b2 b = __builtin_convertvector(v, b2); return __builtin_bit_cast(unsigned, b); }
DI unsigned short cvt1(float x) { return (unsigned short)(cvtpk(x, 0.f) & 0xffffu); }
#define CS_MFMA(a, b, c) __builtin_amdgcn_mfma_f32_16x16x32_bf16((a), (b), (c), 0, 0, 0)
#define CS_LWAIT() asm volatile("s_waitcnt lgkmcnt(0)" ::: "memory")
constexpr int NCHUNK = SEQ / 16, NTASK = NB * 8 * NCHUNK;
constexpr int OPS_TASK = 10 * 1024;
constexpr int L_AT = 0, L_RT = 2048, L_BT = 4096, L_KT = 6144, L_BH = 8192, L_KH = 10240, L_AB = 12288, L_AK = 13312, L_RB = 14336, L_RK = 15360;

DI void chunk_prep(const float* SC5, const float* RKV, unsigned char* OPS, float* G15, LAS unsigned char* lds, int gw, int NGW, int wave, int lane) {
    constexpr size_t ASZ = (size_t)M * RWD;
    LAS unsigned char* base = lds + wave * 16384;
    const int d = lane, x = lane & 15, q = lane >> 4;
    for (int task = gw; task < NTASK; task += NGW) {
        const int chain = task / NCHUNK, c = task - chain * NCHUNK, bb = chain >> 3, hd = chain & 7;
        const size_t m0 = (size_t)bb * SEQ + (size_t)c * 16;
        float a[16], b[16], k[16], r[16]; float g = 1.f;
        {   float w[16];
#pragma unroll
            for (int t = 0; t < 16; ++t) { const size_t o = (m0 + t) * RWD + hd * 64 + d;
                a[t] = ((const GAS float*)SC5)[o]; w[t] = ((const GAS float*)SC5)[2 * ASZ + o]; b[t] = ((const GAS float*)SC5)[3 * ASZ + o]; k[t] = ((const GAS float*)SC5)[4 * ASZ + o]; r[t] = ((const GAS float*)RKV)[(m0 + t) * 1536 + hd * 64 + d]; }
#pragma unroll
            for (int t = 0; t < 16; ++t) { const float gm1 = g; g *= w[t]; const float inv = 1.0f / g; a[t] *= gm1; r[t] *= g; b[t] *= inv; k[t] *= inv; }
        }
        ((GAS float*)G15)[(size_t)task * 64 + d] = g;
#pragma unroll
        for (int t = 0; t < 16; ++t) {
            *(LAS unsigned short*)(base + L_AT + (t * 64 + d) * 2) = cvt1(a[t]); *(LAS unsigned short*)(base + L_RT + (t * 64 + d) * 2) = cvt1(r[t]);
            *(LAS unsigned short*)(base + L_BT + (t * 64 + d) * 2) = cvt1(b[t]); *(LAS unsigned short*)(base + L_KT + (t * 64 + d) * 2) = cvt1(k[t]); }
        { v4u h0, h1, k0, k1;
          h0.x = cvtpk(b[0] * g, b[1] * g); h0.y = cvtpk(b[2] * g, b[3] * g); h0.z = cvtpk(b[4] * g, b[5] * g); h0.w = cvtpk(b[6] * g, b[7] * g);
          h1.x = cvtpk(b[8] * g, b[9] * g); h1.y = cvtpk(b[10] * g, b[11] * g); h1.z = cvtpk(b[12] * g, b[13] * g); h1.w = cvtpk(b[14] * g, b[15] * g);
          k0.x = cvtpk(k[0] * g, k[1] * g); k0.y = cvtpk(k[2] * g, k[3] * g); k0.z = cvtpk(k[4] * g, k[5] * g); k0.w = cvtpk(k[6] * g, k[7] * g);
          k1.x = cvtpk(k[8] * g, k[9] * g); k1.y = cvtpk(k[10] * g, k[11] * g); k1.z = cvtpk(k[12] * g, k[13] * g); k1.w = cvtpk(k[14] * g, k[15] * g);
          *(LAS v4u*)(base + L_BH + d * 32) = h0; *(LAS v4u*)(base + L_BH + d * 32 + 16) = h1; *(LAS v4u*)(base + L_KH + d * 32) = k0; *(LAS v4u*)(base + L_KH + d * 32 + 16) = k1; }
        CS_LWAIT();
        { f4 gab = {0.f, 0.f, 0.f, 0.f}, gak = gab, grb = gab, grk = gab;
#pragma unroll
          for (int kb = 0; kb < 2; ++kb) { const int fo = (x * 64 + 32 * kb + 8 * q) * 2;
              const bf16x8 fa = *(const LAS bf16x8*)(base + L_AT + fo), fr = *(const LAS bf16x8*)(base + L_RT + fo), fb = *(const LAS bf16x8*)(base + L_BT + fo), fk = *(const LAS bf16x8*)(base + L_KT + fo);
              gab = CS_MFMA(fb, fa, gab); gak = CS_MFMA(fk, fa, gak); grb = CS_MFMA(fb, fr, grb); grk = CS_MFMA(fk, fr, grk); }
#pragma unroll
          for (int rr = 0; rr < 4; ++rr) { const int u = 4 * q + rr; if (!(u < x)) { gab[rr] = 0.f; gak[rr] = 0.f; } if (!(u <= x)) { grb[rr] = 0.f; grk[rr] = 0.f; } }
          const int go = (x * 16 + 4 * q) * 4;
          *(LAS f4*)(base + L_AB + go) = gab; *(LAS f4*)(base + L_AK + go) = gak; *(LAS f4*)(base + L_RB + go) = grb; *(LAS f4*)(base + L_RK + go) = grk; }
        CS_LWAIT();
        float mm[16];
#pragma unroll
        for (int t = 0; t < 16; ++t) mm[t] = *(const LAS float*)(base + L_AK + (t * 16 + x) * 4);
#pragma unroll
        for (int t = 1; t < 16; ++t) {
            float ab[16];
#pragma unroll
            for (int u4 = 0; u4 < 4; ++u4) if (4 * u4 < t) { const f4 v = *(const LAS f4*)(base + L_AB + (t * 16 + 4 * u4) * 4); ab[4 * u4] = v.x; ab[4 * u4 + 1] = v.y; ab[4 * u4 + 2] = v.z; ab[4 * u4 + 3] = v.w; }
#pragma unroll
            for (int u = 0; u < 16; ++u) if (u < t) { a[t] = fmaf(a[u], ab[u], a[t]); mm[t] = fmaf(mm[u], ab[u], mm[t]); }
        }
        CS_LWAIT();
#pragma unroll
        for (int t = 0; t < 16; ++t) { *(LAS unsigned short*)(base + L_AT + (t * 64 + d) * 2) = cvt1(a[t]); *(LAS float*)(base + L_AK + (t * 16 + x) * 4) = mm[t]; }
        CS_LWAIT();
        unsigned char* ob = OPS + (size_t)task * OPS_TASK + lane * 16;
#pragma unroll
        for (int kb = 0; kb < 2; ++kb) { const int fo = (x * 64 + 32 * kb + 4 * q) * 2;
            const v2u w0 = *(const LAS v2u*)(base + L_AT + fo), w1 = *(const LAS v2u*)(base + L_AT + fo + 32), r0 = *(const LAS v2u*)(base + L_RT + fo), r1 = *(const LAS v2u*)(base + L_RT + fo + 32);
            *(GAS v4u*)(ob + kb * 1024) = (v4u){w0.x, w0.y, w1.x, w1.y}; *(GAS v4u*)(ob + (3 + kb) * 1024) = (v4u){r0.x, r0.y, r1.x, r1.y}; }
        { const int go = (x * 16 + 4 * q) * 4; const f4 m2 = *(const LAS f4*)(base + L_AK + go), rb = *(const LAS f4*)(base + L_RB + go), rk = *(const LAS f4*)(base + L_RK + go);
          *(GAS v4u*)(ob + 2 * 1024) = (v4u){0u, 0u, cvtpk(m2.x, m2.y), cvtpk(m2.z, m2.w)};
          *(GAS v4u*)(ob + 5 * 1024) = (v4u){cvtpk(rb.x, rb.y), cvtpk(rb.z, rb.w), cvtpk(rk.x, rk.y), cvtpk(rk.z, rk.w)}; }
#pragma unroll
        for (int dt = 0; dt < 4; ++dt) { const int fo = ((16 * dt + x) * 16 + 4 * q) * 2; const v2u h = *(const LAS v2u*)(base + L_BH + fo), kk = *(const LAS v2u*)(base + L_KH + fo);
            *(GAS v4u*)(ob + (6 + dt) * 1024) = (v4u){h.x, h.y, kk.x, kk.y}; }
        CS_LWAIT();
    }
}

constexpr int CBUF = 16384, CNBUF = 5, C_YOFF = CNBUF * CBUF, C_YBUF = 16 * 64 * 4;
static_assert(C_YOFF + 2 * C_YBUF <= RING_BYTES, "chunked scan LDS map");
DI void cscan_item(LAS unsigned char* lds, const unsigned char* OPS, const float* G15, const float* RKV, float* Y, float* fin, int chain, int tid, int wave, int lane) {
    const int bb = chain >> 3, hd = chain & 7, i = lane & 15, q = lane >> 4, rowbase = 16 * (wave & 3);
    const bool comp = wave < 4;
    const size_t m0 = (size_t)bb * SEQ, task0 = (size_t)chain * NCHUNK;
    const char* sp[2]; unsigned sstr[2];
#pragma unroll
    for (int k2 = 0; k2 < 2; ++k2) { int slot = wave + 8 * k2; if (slot == 15) slot = 0;
        if (slot < 10) { sp[k2] = (const char*)(OPS + (task0 * 10 + slot) * 1024 + lane * 16); sstr[k2] = OPS_TASK; }
        else if (slot == 10) { sp[k2] = (const char*)(G15 + task0 * 64) + (lane & 15) * 16; sstr[k2] = 256; }
        else { sp[k2] = (const char*)(RKV + (m0 + 4 * (slot - 11) + (lane >> 4)) * 1536 + 1024 + hd * 64) + (lane & 15) * 16; sstr[k2] = 16 * 1536 * 4; } }
#define CS_DMA(c) do { const int cn_ = min((c), NCHUNK - 1); LAS unsigned char* db_ = lds + ((c) % CNBUF) * CBUF + wave * 1024; _Pragma("unroll") for (int k2 = 0; k2 < 2; ++k2) \
        __builtin_amdgcn_global_load_lds((const GAS unsigned*)(sp[k2] + (size_t)cn_ * sstr[k2]), (LAS unsigned*)(db_ + k2 * 8192), 16, 0, 0); } while (0)
#define CS_FLUSH(cc) do { const int t_ = (tid - 256) >> 4, c4_ = (tid - 256) & 15; \
        *(GAS f4*)(Y + (m0 + (size_t)(cc) * 16 + t_) * RWD + hd * 64 + 4 * c4_) = *(const LAS f4*)(lds + C_YOFF + ((cc) & 1) * C_YBUF + (t_ * 64 + 4 * c4_) * 4); } while (0)
    CS_DMA(0); CS_DMA(1); CS_DMA(2);
    asm volatile("s_waitcnt vmcnt(4) lgkmcnt(0)" ::: "memory"); __builtin_amdgcn_s_barrier(); asm volatile("" ::: "memory");
    f4 sacc[4];
#pragma unroll
    for (int dt = 0; dt < 4; ++dt) sacc[dt] = (f4){0.f, 0.f, 0.f, 0.f};
    for (int c = 0; c < NCHUNK; ++c) {
        CS_DMA(c + 3);
        if (comp) {
            const LAS unsigned char* buf = lds + (c % CNBUF) * CBUF;
            const LAS unsigned char* fb = buf + lane * 16;
            bf16x8 sb0, sb1;
            { v4u w; w.x = cvtpk(sacc[0].x, sacc[0].y); w.y = cvtpk(sacc[0].z, sacc[0].w); w.z = cvtpk(sacc[1].x, sacc[1].y); w.w = cvtpk(sacc[1].z, sacc[1].w); sb0 = __builtin_bit_cast(bf16x8, w);
              w.x = cvtpk(sacc[2].x, sacc[2].y); w.y = cvtpk(sacc[2].z, sacc[2].w); w.z = cvtpk(sacc[3].x, sacc[3].y); w.w = cvtpk(sacc[3].z, sacc[3].w); sb1 = __builtin_bit_cast(bf16x8, w); }
            const LAS float* vp = (const LAS float*)(buf + 11 * 1024) + (4 * q) * 64 + rowbase + i;
            const float v0 = vp[0], v1 = vp[64], v2 = vp[128], v3 = vp[192];
            const unsigned vlo = cvtpk(v0, v1), vhi = cvtpk(v2, v3);
            const bf16x8 uv0 = __builtin_bit_cast(bf16x8, (v4u){0u, 0u, vlo, vhi});
            f4 u = {0.f, 0.f, 0.f, 0.f};
            u = CS_MFMA(*(const LAS bf16x8*)(fb), sb0, u); u = CS_MFMA(*(const LAS bf16x8*)(fb + 1024), sb1, u); u = CS_MFMA(*(const LAS bf16x8*)(fb + 2048), uv0, u);
            const bf16x8 uv = __builtin_bit_cast(bf16x8, (v4u){cvtpk(u.x, u.y), cvtpk(u.z, u.w), vlo, vhi});
            f4 y = {0.f, 0.f, 0.f, 0.f};
            y = CS_MFMA(*(const LAS bf16x8*)(fb + 3072), sb0, y); y = CS_MFMA(*(const LAS bf16x8*)(fb + 4096), sb1, y); y = CS_MFMA(*(const LAS bf16x8*)(fb + 5120), uv, y);
            LAS float* yb = (LAS float*)(lds + C_YOFF + (c & 1) * C_YBUF) + (4 * q) * 64 + rowbase + i;
            yb[0] = y.x; yb[64] = y.y; yb[128] = y.z; yb[192] = y.w;
#pragma unroll
            for (int dt = 0; dt < 4; ++dt) { const f4 gg = *(const LAS f4*)(buf + 10 * 1024 + (16 * dt + 4 * q) * 4); sacc[dt] = CS_MFMA(*(const LAS bf16x8*)(fb + (6 + dt) * 1024), uv, sacc[dt] * gg); }
            asm volatile("s_waitcnt vmcnt(4) lgkmcnt(0)" ::: "memory");
        } else {
            if (c >= 1) CS_FLUSH(c - 1);
            if (c == 0) asm volatile("s_waitcnt vmcnt(4) lgkmcnt(0)" ::: "memory"); else if (c == 1) asm volatile("s_waitcnt vmcnt(5) lgkmcnt(0)" ::: "memory"); else asm volatile("s_waitcnt vmcnt(6) lgkmcnt(0)" ::: "memory");
        }
        __builtin_amdgcn_s_barrier(); asm volatile("" ::: "memory");
    }
    if (!comp) CS_FLUSH(NCHUNK - 1);
    else {
        float* fo = fin + (size_t)chain * 4096 + (size_t)(rowbase + i) * 64 + 4 * q;
#pragma unroll
        for (int dt = 0; dt < 4; ++dt) *(GAS f4*)(fo + 16 * dt) = sacc[dt];
    }
#undef CS_DMA
#undef CS_FLUSH
    asm volatile("s_waitcnt vmcnt(0) lgkmcnt(0)" ::: "memory"); __builtin_amdgcn_s_barrier(); asm volatile("" ::: "memory");
}
}
namespace att {
constexpr int KSTEP_B = 1152, SUB_BYTES = 10 * KSTEP_B;
DI unsigned img_off(unsigned row, unsigned ch) { return (unsigned)KSTEP_B * (ch >> 1) + 32u * row + 16u * ((ch & 1u) ^ ((row >> 3) & 1u)); }
DI unsigned kvmap(unsigned r) { return (r & ~12u) | ((r & 4u) << 1) | ((r & 8u) >> 1); }
DI unsigned row_base(unsigned lane) { const unsigned kr = kvmap(lane & 31u), h = lane >> 5; return 32u * kr + 16u * (h ^ ((kr >> 3) & 1u)); }
DI unsigned tr_base(unsigned lane) { const unsigned h = lane >> 5, blk = (lane >> 4) & 1u, q = (lane & 15u) >> 2, p = lane & 3u;
    return (unsigned)KSTEP_B * blk + 32u * (8u * h + q) + 16u * ((p >> 1) ^ h) + 8u * (p & 1u); }
DI unsigned cvtpk(float lo, float hi) { typedef float f2 __attribute__((ext_vector_type(2))); typedef __bf16 b2 __attribute__((ext_vector_type(2))); f2 v = {lo, hi}; b2 b = __builtin_convertvector(v, b2); return __builtin_bit_cast(unsigned, b); }
DI s16x4 vtr(const LAS unsigned char* p) { typedef short v4i16_t __attribute__((ext_vector_type(4))); return __builtin_bit_cast(s16x4, __builtin_amdgcn_ds_read_tr16_b64_v4i16((LAS v4i16_t*)p)); }
#define ATT_MFMA(a, b, c) __builtin_amdgcn_mfma_f32_32x32x16_bf16((a), (b), (c), 0, 0, 0)

constexpr float DEFER_THR = 8.0f;
DI float xhalf_max(float v) { auto rr = __builtin_amdgcn_permlane32_swap(__float_as_uint(v), __float_as_uint(v), false, false); return fmaxf(__uint_as_float(rr[0]), __uint_as_float(rr[1])); }
DI float xhalf_sum(float v) { auto rr = __builtin_amdgcn_permlane32_swap(__float_as_uint(v), __float_as_uint(v), false, false); return __uint_as_float(rr[0]) + __uint_as_float(rr[1]); }
DI bf16x8 pack8(const f32x16& x, int s) { v4u w; w.x = cvtpk(x[8 * s], x[8 * s + 1]); w.y = cvtpk(x[8 * s + 2], x[8 * s + 3]); w.z = cvtpk(x[8 * s + 4], x[8 * s + 5]); w.w = cvtpk(x[8 * s + 6], x[8 * s + 7]); return __builtin_bit_cast(bf16x8, w); }

template <bool MASK>
DI void subtile(const LAS unsigned char* img, const bf16x8 (&qf)[10], float& mrun, float& lrun, f32x16 (&o)[4], int lane, int qlim) {
    __builtin_amdgcn_sched_barrier(0);
    const unsigned h = lane >> 5;
    const LAS unsigned char* rb = img + row_base(lane); const LAS unsigned char* tb = img + tr_base(lane);
    f32x16 x;
#pragma unroll
    for (int i = 0; i < 16; ++i) x[i] = 0.f;
#pragma unroll
    for (int s = 0; s < 10; ++s) { const bf16x8 a = *(const LAS bf16x8*)(rb + KSTEP_B * s); x = ATT_MFMA(a, qf[s], x); }
    if (MASK) {
#pragma unroll
        for (int i = 0; i < 16; ++i) { const int kv = 16 * (i >> 3) + 8 * (int)h + (i & 7); if (kv > qlim) x[i] = -1e30f; }
    }
    float mx = x[0];
#pragma unroll
    for (int i = 1; i < 16; ++i) mx = fmaxf(mx, x[i]);
    mx = xhalf_max(mx);
    if (!__all(mx - mrun <= DEFER_THR)) {
        const float mn = fmaxf(mrun, mx), corr = __builtin_amdgcn_exp2f(mrun - mn); mrun = mn; lrun *= corr;
#pragma unroll
        for (int d = 0; d < 4; ++d)
#pragma unroll
            for (int i = 0; i < 16; ++i) o[d][i] *= corr;
    }
    float ls = 0.f;
#pragma unroll
    for (int i = 0; i < 16; ++i) { x[i] = __builtin_amdgcn_exp2f(x[i] - mrun); ls += x[i]; }
    lrun += ls;
    const bf16x8 pb0 = pack8(x, 0), pb1 = pack8(x, 1);
#pragma unroll
    for (int d = 0; d < 4; ++d) {
        { const s16x4 lo = vtr(tb + 2 * KSTEP_B * d), hi = vtr(tb + 2 * KSTEP_B * d + 128); o[d] = ATT_MFMA(__builtin_shufflevector(lo, hi, 0, 1, 2, 3, 4, 5, 6, 7), pb0, o[d]); }
        { const s16x4 lo = vtr(tb + 2 * KSTEP_B * d + 512), hi = vtr(tb + 2 * KSTEP_B * d + 512 + 128); o[d] = ATT_MFMA(__builtin_shufflevector(lo, hi, 0, 1, 2, 3, 4, 5, 6, 7), pb1, o[d]); }
    }
}
DI void tile64(const LAS unsigned char* img, const bf16x8 (&qf)[10], float& mrun, float& lrun, f32x16 (&o)[4], int lane) {
    __builtin_amdgcn_sched_barrier(0);
    const LAS unsigned char* rb = img + row_base(lane); const LAS unsigned char* tb = img + tr_base(lane);
    f32x16 p0, p1;
#pragma unroll
    for (int i = 0; i < 16; ++i) { p0[i] = 0.f; p1[i] = 0.f; }
#pragma unroll
    for (int s = 0; s < 10; ++s) {
        const bf16x8 a0 = *(const LAS bf16x8*)(rb + KSTEP_B * s), a1 = *(const LAS bf16x8*)(rb + SUB_BYTES + KSTEP_B * s);
        p0 = ATT_MFMA(a0, qf[s], p0); p1 = ATT_MFMA(a1, qf[s], p1);
    }
    float mx = fmaxf(p0[0], p1[0]);
#pragma unroll
    for (int i = 1; i < 16; ++i) mx = fmaxf(mx, fmaxf(p0[i], p1[i]));
    mx = xhalf_max(mx);
    if (!__all(mx - mrun <= DEFER_THR)) {
        const float mn = fmaxf(mrun, mx), corr = __builtin_amdgcn_exp2f(mrun - mn); mrun = mn; lrun *= corr;
#pragma unroll
        for (int d = 0; d < 4; ++d)
#pragma unroll
            for (int i = 0; i < 16; ++i) o[d][i] *= corr;
    }
    float ls = 0.f;
#pragma unroll
    for (int i = 0; i < 16; ++i) { p0[i] = __builtin_amdgcn_exp2f(p0[i] - mrun); ls += p0[i]; }
    const bf16x8 pa = pack8(p0, 0), pb = pack8(p0, 1);
#pragma unroll
    for (int d = 0; d < 4; ++d) {
        { const s16x4 lo = vtr(tb + 2 * KSTEP_B * d), hi = vtr(tb + 2 * KSTEP_B * d + 128); o[d] = ATT_MFMA(__builtin_shufflevector(lo, hi, 0, 1, 2, 3, 4, 5, 6, 7), pa, o[d]); }
        { const s16x4 lo = vtr(tb + 2 * KSTEP_B * d + 512), hi = vtr(tb + 2 * KSTEP_B * d + 512 + 128); o[d] = ATT_MFMA(__builtin_shufflevector(lo, hi, 0, 1, 2, 3, 4, 5, 6, 7), pb, o[d]); }
    }
#pragma unroll
    for (int i = 0; i < 16; ++i) { p1[i] = __builtin_amdgcn_exp2f(p1[i] - mrun); ls += p1[i]; }
    lrun += ls;
    const bf16x8 pc = pack8(p1, 0), pd = pack8(p1, 1);
#pragma unroll
    for (int d = 0; d < 4; ++d) {
        { const s16x4 lo = vtr(tb + SUB_BYTES + 2 * KSTEP_B * d), hi = vtr(tb + SUB_BYTES + 2 * KSTEP_B * d + 128); o[d] = ATT_MFMA(__builtin_shufflevector(lo, hi, 0, 1, 2, 3, 4, 5, 6, 7), pc, o[d]); }
        { const s16x4 lo = vtr(tb + SUB_BYTES + 2 * KSTEP_B * d + 512), hi = vtr(tb + SUB_BYTES + 2 * KSTEP_B * d + 512 + 128); o[d] = ATT_MFMA(__builtin_shufflevector(lo, hi, 0, 1, 2, 3, 4, 5, 6, 7), pd, o[d]); }
    }
}

DI void prompt_unit(LAS unsigned char* lds, const bf16* QB, const bf16* CKVB, const bf16* KRB, bf16* OM, int b, int qblk, int tid, int wave, int lane) {
    const int r = lane & 31, h = lane >> 5;
    const int row0 = b * SEQ + qblk * 32, kb = b * SEQ;
    bf16x8 qf[10];
    { const bf16* qp = QB + (size_t)(row0 + r) * 1280 + wave * 160 + 8 * h;
#pragma unroll
      for (int s = 0; s < 10; ++s) qf[s] = *(const GAS bf16x8*)(qp + 16 * s); }
    f32x16 o[4];
#pragma unroll
    for (int d = 0; d < 4; ++d)
#pragma unroll
        for (int i = 0; i < 16; ++i) o[d][i] = 0.f;
    float mrun = -1e30f, lrun = 0.f;
    const int nsub = qblk + 1, ntile = (nsub + 1) >> 1;
    const int lrow0 = tid >> 4, lch = tid & 15, lrow1 = lrow0 + 32;
    const unsigned ld0 = (unsigned)(lrow0 >> 5) * SUB_BYTES + img_off(lrow0 & 31, lch), ld1 = (unsigned)(lrow1 >> 5) * SUB_BYTES + img_off(lrow1 & 31, lch);
    const int rrow = tid >> 2, rc = tid & 3; const unsigned rd = (unsigned)(rrow >> 5) * SUB_BYTES + img_off(rrow & 31, 16 + rc);
    const bf16* g0 = CKVB + (size_t)(kb + lrow0) * KVR + lch * 8; const bf16* g1 = CKVB + (size_t)(kb + lrow1) * KVR + lch * 8; const bf16* g2 = KRB + (size_t)(kb + rrow) * RD + rc * 8;
    v4u s0 = *(const GAS v4u*)g0, s1 = *(const GAS v4u*)g1, s2 = (tid < 256) ? *(const GAS v4u*)g2 : (v4u){0u, 0u, 0u, 0u};
    *(LAS v4u*)(lds + ld0) = s0; *(LAS v4u*)(lds + ld1) = s1; if (tid < 256) *(LAS v4u*)(lds + rd) = s2;
    __syncthreads();
    const int nfull = qblk >> 1;
#define PU_LOAD(tn) do { const size_t adv = (size_t)(tn) * 64; s0 = *(const GAS v4u*)(g0 + adv * KVR); s1 = *(const GAS v4u*)(g1 + adv * KVR); if (tid < 256) s2 = *(const GAS v4u*)(g2 + adv * RD); } while (0)
#define PU_WRITE(par) do { LAS unsigned char* nb = lds + (par) * (2 * SUB_BYTES); *(LAS v4u*)(nb + ld0) = s0; *(LAS v4u*)(nb + ld1) = s1; if (tid < 256) *(LAS v4u*)(nb + rd) = s2; } while (0)
    for (int t = 0; t < nfull; ++t) {
        PU_LOAD(t + 1);
        const LAS unsigned char* img = lds + (t & 1) * (2 * SUB_BYTES);
        tile64(img, qf, mrun, lrun, o, lane);
        PU_WRITE((t + 1) & 1); __syncthreads();
    }
    { const LAS unsigned char* img = lds + (nfull & 1) * (2 * SUB_BYTES);
      if (qblk & 1) { subtile<false>(img, qf, mrun, lrun, o, lane, 0); img += SUB_BYTES; }
      subtile<true>(img, qf, mrun, lrun, o, lane, r);
      __syncthreads(); }
#undef PU_LOAD
#undef PU_WRITE
    const float inv = 1.f / xhalf_sum(lrun);
    bf16* op = OM + (size_t)(row0 + r) * 1536 + wave * 128 + 4 * h;
#pragma unroll
    for (int d = 0; d < 4; ++d)
#pragma unroll
        for (int g = 0; g < 4; ++g)
            *(GAS v2u*)(op + 32 * d + 8 * g) = (v2u){pk2(o[d][4 * g] * inv, o[d][4 * g + 1] * inv), pk2(o[d][4 * g + 2] * inv, o[d][4 * g + 3] * inv)};
}

DI void sample_unit(LAS unsigned char* lds, const bf16* QB, const bf16* CKVB, const bf16* KRB, const float* cckv, const float* ckr, const int* ptab, float* PO, float* PML,
                    int b, int sp, int tid, int wave, int lane) {
    const int r = lane & 31, h = lane >> 5, qt = wave & 1, ks = wave >> 1;
    const int qr = 32 * qt + r, tq = qr >> 3, hd = qr & 7;
    bf16x8 qf[10];
    { const bf16* qp = QB + (size_t)(MP + b * DS + tq) * 1280 + hd * 160 + 8 * h;
#pragma unroll
      for (int s = 0; s < 10; ++s) qf[s] = *(const GAS bf16x8*)(qp + 16 * s); }
    f32x16 o[4];
#pragma unroll
    for (int d = 0; d < 4; ++d)
#pragma unroll
        for (int i = 0; i < 16; ++i) o[d][i] = 0.f;
    float mrun = -1e30f, lrun = 0.f;
    constexpr int PBUF = 4 * SUB_BYTES;
    unsigned ldl[4];
#pragma unroll
    for (int i = 0; i < 4; ++i) { const int row = (tid >> 4) + 32 * i; ldl[i] = (unsigned)(row >> 5) * SUB_BYTES + img_off(row & 31, tid & 15); }
    const int rrow = tid >> 2; const unsigned ldr = (unsigned)(rrow >> 5) * SUB_BYTES + img_off(rrow & 31, 16 + (tid & 3));
    const int* pt = ptab + b * NPAGE + sp * 64;
    f32x4 sl[8], sr[2];
    { const int pg = pt[0]; const float* pl = cckv + (size_t)pg * (PAGE * KVR) + (size_t)(tid >> 4) * KVR + (tid & 15) * 8; const float* prp = ckr + (size_t)pg * (PAGE * RD) + (size_t)rrow * RD + (tid & 3) * 4;
#pragma unroll
      for (int i = 0; i < 4; ++i) { sl[2 * i] = *(const GAS f32x4*)(pl + (size_t)i * 32 * KVR); sl[2 * i + 1] = *(const GAS f32x4*)(pl + (size_t)i * 32 * KVR + 4); }
      sr[0] = *(const GAS f32x4*)prp; sr[1] = *(const GAS f32x4*)(prp + 16); }
#define SAMP_WRITE(buf) do { _Pragma("unroll") for (int i = 0; i < 4; ++i) *(LAS v4u*)((buf) + ldl[i]) = (v4u){cvtpk(sl[2*i].x, sl[2*i].y), cvtpk(sl[2*i].z, sl[2*i].w), cvtpk(sl[2*i+1].x, sl[2*i+1].y), cvtpk(sl[2*i+1].z, sl[2*i+1].w)}; \
        *(LAS v4u*)((buf) + ldr) = (v4u){cvtpk(sr[0].x, sr[1].x), cvtpk(sr[0].y, sr[1].y), cvtpk(sr[0].z, sr[1].z), cvtpk(sr[0].w, sr[1].w)}; } while (0)
    SAMP_WRITE(lds);
    __syncthreads();
    for (int p = 0; p < 64; ++p) {
        const bool more = p + 1 < 64;
        if (more) { const int pg = pt[p + 1]; const float* pl = cckv + (size_t)pg * (PAGE * KVR) + (size_t)(tid >> 4) * KVR + (tid & 15) * 8; const float* prp = ckr + (size_t)pg * (PAGE * RD) + (size_t)rrow * RD + (tid & 3) * 4;
#pragma unroll
            for (int i = 0; i < 4; ++i) { sl[2 * i] = *(const GAS f32x4*)(pl + (size_t)i * 32 * KVR); sl[2 * i + 1] = *(const GAS f32x4*)(pl + (size_t)i * 32 * KVR + 4); }
            sr[0] = *(const GAS f32x4*)prp; sr[1] = *(const GAS f32x4*)(prp + 16); }
        subtile<false>(lds + (p & 1) * PBUF + ks * SUB_BYTES, qf, mrun, lrun, o, lane, 0);
        if (more) { LAS unsigned char* nb = lds + ((p + 1) & 1) * PBUF; SAMP_WRITE(nb); }
        __syncthreads();
    }
#undef SAMP_WRITE
    if (sp == 0) {
        LAS unsigned char* nb = lds;
        { const int row = tid >> 4, ch = tid & 15; v4u v = {0u, 0u, 0u, 0u}; if (row < DS) v = *(const GAS v4u*)(CKVB + (size_t)(MP + b * DS + row) * KVR + ch * 8); *(LAS v4u*)(nb + img_off(row, ch)) = v; }
        if (tid < 128) { const int row = tid >> 2, c = tid & 3; v4u v = {0u, 0u, 0u, 0u}; if (row < DS) v = *(const GAS v4u*)(KRB + (size_t)(MP + b * DS + row) * RD + c * 8); *(LAS v4u*)(nb + img_off(row, 16 + c)) = v; }
        __syncthreads();
        if (ks == 0) subtile<true>(nb, qf, mrun, lrun, o, lane, tq);
        __syncthreads();
    }
    const float lt = xhalf_sum(lrun);
    const int idx = b * 8 + sp * 4 + ks;
    if (h == 0) ((GAS f32x2*)PML)[(size_t)idx * 64 + qr] = (f32x2){mrun, lt};
    float* op = PO + ((size_t)idx * 64 + qr) * 128 + 4 * h;
#pragma unroll
    for (int d = 0; d < 4; ++d)
#pragma unroll
        for (int g = 0; g < 4; ++g) *(GAS f32x4*)(op + 32 * d + 8 * g) = (f32x4){o[d][4 * g], o[d][4 * g + 1], o[d][4 * g + 2], o[d][4 * g + 3]};
}
}

DI float rowsum16(float v) {
    v += __builtin_bit_cast(float, __builtin_amdgcn_update_dpp(0, __builtin_bit_cast(int, v), 0x128, 0xf, 0xf, false));
    v += __builtin_bit_cast(float, __builtin_amdgcn_update_dpp(0, __builtin_bit_cast(int, v), 0x124, 0xf, 0xf, false));
    v += __builtin_bit_cast(float, __builtin_amdgcn_update_dpp(0, __builtin_bit_cast(int, v), 0x122, 0xf, 0xf, false));
    v += __builtin_bit_cast(float, __builtin_amdgcn_update_dpp(0, __builtin_bit_cast(int, v), 0x121, 0xf, 0xf, false));
    return v;
}
constexpr int SCAN_STRIDE = 340, SCAN_CHUNK = 16, SCAN_PIECES = 85, SCAN_NBUF = 5, SCAN_AHEAD = 3;
constexpr int SCAN_BUF = 1536 * 16, SCAN_YOFF = SCAN_NBUF * SCAN_BUF, SCAN_YBUF = SCAN_CHUNK * 16 * 4;
static_assert(SCAN_YOFF + 2 * SCAN_YBUF <= RING_BYTES && SCAN_CHUNK * SCAN_PIECES <= 1536, "scan LDS map");
DI float dot4(const f32x4& x, const f32x4& y) { return fmaf(x.y, y.y, x.x * y.x) + fmaf(x.w, y.w, x.z * y.z); }
template <int VAR> DI void scan_item(LAS unsigned char* lds, const float* SC5, const float* RKV, const float* SCAL, float* Y, const float* init, float* fin, int m0, int T, int hd, int quarter, int tid, int wave, int lane) {
    constexpr size_t ASZ = (size_t)M * RWD;
    const int j = lane & 15, rowl = (wave & 3) * 4 + (lane >> 4), row = quarter * 16 + rowl;
    const bool isA = wave < 4;
    const int nchunk = (T + SCAN_CHUNK - 1) / SCAN_CHUNK, nst0 = min(SCAN_CHUNK, T);
    const char* sp[3]; unsigned sstr[3];
#pragma unroll
    for (int i = 0; i < 3; ++i) { int q = tid + 512 * i; if (q >= nst0 * SCAN_PIECES) q = 0;
        const int st = q / SCAN_PIECES, pc = q - st * SCAN_PIECES; const size_t mm = (size_t)(m0 + st); const float* src;
        if (pc < 80) { src = SC5 + (size_t)(pc >> 4) * ASZ + mm * RWD + hd * 64 + (pc & 15) * 4; sstr[i] = SCAN_CHUNK * RWD * 4; }
        else if (pc < 84) { src = RKV + mm * 1536 + 1024 + hd * 64 + quarter * 16 + (pc - 80) * 4; sstr[i] = SCAN_CHUNK * 1536 * 4; }
        else { src = SCAL + (mm * 8 + hd) * 4; sstr[i] = SCAN_CHUNK * 32 * 4; }
        sp[i] = (const char*)src; }
#define SCAN_DMA(c) do { const int cn_ = min((c), nchunk - 1); LAS unsigned char* db_ = lds + ((c) % SCAN_NBUF) * SCAN_BUF + wave * 1024; _Pragma("unroll") for (int i = 0; i < 3; ++i) \
        __builtin_amdgcn_global_load_lds((const GAS unsigned*)(sp[i] + (size_t)cn_ * sstr[i]), (LAS unsigned*)(db_ + i * 8192), 16, 0, 0); } while (0)
#define SCAN_WAIT_BAR() do { asm volatile("s_waitcnt vmcnt(3) lgkmcnt(0)" ::: "memory"); __builtin_amdgcn_s_barrier(); asm volatile("" ::: "memory"); } while (0)
    SCAN_DMA(0); SCAN_DMA(1); SCAN_DMA(2);
    asm volatile("s_waitcnt vmcnt(3) lgkmcnt(0)" ::: "memory"); __builtin_amdgcn_s_barrier(); asm volatile("" ::: "memory");
    f32x4 s = (f32x4){0.f, 0.f, 0.f, 0.f}, t, bq; float sa = 0.f, P1 = 0.f, P2 = 0.f, ypv = 0.f, br16 = 0.f;
    f32x4 cw, ck, cwr, cb4, ca; float cvv = 0.f; f32x2 csc;
#define SCAN_OP(g, off) (*(const LAS f32x4*)(lds + (((g) >> 4) % SCAN_NBUF) * SCAN_BUF + ((g) & 15) * (SCAN_STRIDE * 4) + (off) * 4 + 16 * j))
    if (isA) {
        if (init) s = *(const GAS f32x4*)(init + (size_t)row * 64 + 4 * j);
        const f32x4 a0 = SCAN_OP(0, 0), wr0 = SCAN_OP(0, 64), w0 = SCAN_OP(0, 128), b0 = SCAN_OP(0, 192), k0 = SCAN_OP(0, 256), a1 = SCAN_OP(1, 0);
        const LAS float* m0p = (const LAS float*)lds; const float vv0 = m0p[320 + rowl]; const f32x2 sc0 = *(const LAS f32x2*)(m0p + 336);
        sa = rowsum16(dot4(s, a0));
        t = s * w0 + k0 * vv0; bq = b0;
        P2 = dot4(t, a1); P1 = dot4(b0, a1);
        ypv = fmaf(vv0, sc0.y, dot4(s, wr0)); br16 = sc0.x;
        cw = SCAN_OP(1, 128); ck = SCAN_OP(1, 256); cwr = SCAN_OP(1, 64); cb4 = SCAN_OP(1, 192); ca = SCAN_OP(2, 0);
        { const LAS float* p1 = (const LAS float*)(lds + SCAN_STRIDE * 4); cvv = p1[320 + rowl]; csc = *(const LAS f32x2*)(p1 + 336); }
    }
    for (int c = 0; c < nchunk; ++c) {
        SCAN_DMA(c + SCAN_AHEAD);
        if (!isA && c >= 1) {
            const int cc = c - 1, t_ = tid - 256, st = t_ >> 4, r16 = t_ & 15;
            if (st < min(SCAN_CHUNK, T - cc * SCAN_CHUNK))
                Y[(size_t)(m0 + cc * SCAN_CHUNK + st) * RWD + hd * 64 + quarter * 16 + r16] = *(const LAS float*)(lds + SCAN_YOFF + (cc & 1) * SCAN_YBUF + (st * 16 + r16) * 4);
        }
        if (isA) {
            const int nst = min(SCAN_CHUNK, T - c * SCAN_CHUNK);
            const LAS unsigned char* b0p = lds + (c % SCAN_NBUF) * SCAN_BUF + 16 * j; const LAS unsigned char* b1p = lds + ((c + 1) % SCAN_NBUF) * SCAN_BUF + 16 * j;
            LAS float* yb = (LAS float*)(lds + SCAN_YOFF + (c & 1) * SCAN_YBUF) + rowl;
#pragma unroll
            for (int st = 0; st < SCAN_CHUNK; ++st) {
                if (st >= nst) break;
                const LAS unsigned char* q2 = (st + 2 < SCAN_CHUNK ? b0p + (st + 2) * (SCAN_STRIDE * 4) : b1p + (st + 2 - SCAN_CHUNK) * (SCAN_STRIDE * 4));
                const LAS unsigned char* q3 = (st + 3 < SCAN_CHUNK ? b0p + (st + 3) * (SCAN_STRIDE * 4) : b1p + (st + 3 - SCAN_CHUNK) * (SCAN_STRIDE * 4));
                const f32x4 nw = *(const LAS f32x4*)(q2 + 512), nk = *(const LAS f32x4*)(q2 + 1024), nwr = *(const LAS f32x4*)(q2 + 256), nb4 = *(const LAS f32x4*)(q2 + 768), na = *(const LAS f32x4*)(q3);
                const float nvv = *(const LAS float*)(q2 - 16 * j + (320 + rowl) * 4); const f32x2 nsc = *(const LAS f32x2*)(q2 - 16 * j + 336 * 4);
                float part = fmaf(sa, P1, P2);
                float yp = fmaf(sa, br16, ypv);
                s = bq * sa + t;
                if (VAR == 3) { part *= 0.99f; yp *= 0.99f; } else if (VAR == 2) { part = rowsum16(part); yp *= 0.99f; } else { part = rowsum16(part); yp = rowsum16(yp); }
                yb[st * 16] = yp;
                t = s * cw + ck * cvv; bq = cb4;
                P2 = dot4(t, ca); P1 = dot4(cb4, ca);
                ypv = fmaf(cvv, csc.y, dot4(s, cwr)); br16 = csc.x;
                sa = part;
                cw = nw; ck = nk; cwr = nwr; cb4 = nb4; ca = na; cvv = nvv; csc = nsc;
            }
        }
        if (isA || c == 0) asm volatile("s_waitcnt vmcnt(3) lgkmcnt(0)" ::: "memory"); else if (c == 1) asm volatile("s_waitcnt vmcnt(4) lgkmcnt(0)" ::: "memory"); else asm volatile("s_waitcnt vmcnt(5) lgkmcnt(0)" ::: "memory");
        __builtin_amdgcn_s_barrier(); asm volatile("" ::: "memory");
    }
    if (!isA) { const int cc = nchunk - 1, t_ = tid - 256, st = t_ >> 4, r16 = t_ & 15;
        if (st < min(SCAN_CHUNK, T - cc * SCAN_CHUNK))
            Y[(size_t)(m0 + cc * SCAN_CHUNK + st) * RWD + hd * 64 + quarter * 16 + r16] = *(const LAS float*)(lds + SCAN_YOFF + (cc & 1) * SCAN_YBUF + (st * 16 + r16) * 4); }
#undef SCAN_DMA
#undef SCAN_WAIT_BAR
#undef SCAN_OP
    if (isA) *(GAS f32x4*)(fin + (size_t)row * 64 + 4 * j) = s;
    asm volatile("s_waitcnt vmcnt(0) lgkmcnt(0)" ::: "memory"); __builtin_amdgcn_s_barrier(); asm volatile("" ::: "memory");
}

constexpr int Q_PSCAN = 32, Q_SATT = 256, Q_PATT = 1024, Q_SSCAN = 4096, Q_TOTAL = Q_PSCAN + Q_SATT + Q_PATT + Q_SSCAN;
template <int MODE, int VAR> DI void mixer_phase(const Ptrs& P, LAS unsigned char* lds, volatile LAS unsigned* MISC, gu32* ctl, int tid, int wave, int lane) {
    unsigned char* ws = P.ws;
    const bf16* QB = (const bf16*)(ws + WS_QB); const bf16* CKVB = (const bf16*)(ws + WS_CKVB); const bf16* KRB = (const bf16*)(ws + WS_KRB); bf16* OM = (bf16*)(ws + WS_OM);
    const float* SC5 = (const float*)(ws + WS_SC5); const float* RKV = (const float*)(ws + WS_RKV); const float* SCAL = (const float*)(ws + WS_SCAL); float* Y = (float*)(ws + WS_Y);
#define Q_POP() do { if (tid == 0) MISC[0] = __hip_atomic_fetch_add(ctl + CW_QHEAD, 1u, RLX_AGENT); __syncthreads(); it = (int)MISC[0]; __syncthreads(); it = __builtin_amdgcn_readfirstlane(it); } while (0)
    int it; Q_POP();
#ifndef MK_SKIP_PSCAN
    if (MODE == 0 || MODE == 1)
    while (it < Q_PSCAN) {
        if (VAR == 0) cs::cscan_item(lds, ws + WS_OPS, (const float*)(ws + WS_G15), RKV, Y, P.out + O_WKVP, it, tid, wave, lane);
        else cs::cscan_item(lds, ws + WS_OPS, (const float*)(ws + WS_G15), RKV, (float*)(ws + WS_END), (float*)(ws + WS_END + 80 * MiB), it, tid, wave, lane);
        Q_POP(); }
#endif
    if (MODE == 2 || MODE == 3) { while (it < Q_PSCAN) Q_POP(); }
    if (MODE == 3) { while (it < Q_PSCAN + Q_SATT) Q_POP(); }
#ifndef MK_SKIP_SATT
    if (MODE == 0 || MODE == 2)
    while (it < Q_PSCAN + Q_SATT) {
        const int u = it - Q_PSCAN; att::sample_unit(lds, QB, CKVB, KRB, P.in[2], P.in[3], (const int*)P.in[6], (float*)(ws + WS_PO), (float*)(ws + WS_PML), u >> 1, u & 1, tid, wave, lane);
        Q_POP(); }
#endif
#ifndef MK_SKIP_PATT
    if (MODE == 0 || MODE == 3)
    while (it < Q_PSCAN + Q_SATT + Q_PATT) {
        const int u = it - Q_PSCAN - Q_SATT; att::prompt_unit(lds, QB, CKVB, KRB, OM, u & 3, 255 - (u >> 2), tid, wave, lane);
        Q_POP(); }
#endif
#ifndef MK_SKIP_SSCAN
    if (MODE == 0)
    while (it < Q_TOTAL) {
        const int u = it - Q_PSCAN - Q_SATT - Q_PATT, ch = u >> 2, qtr = u & 3, b = ch >> 3, hd = ch & 7;
        scan_item<0>(lds, SC5, RKV, SCAL, Y, P.in[4] + (size_t)ch * 4096, P.out + O_WKVS + (size_t)ch * 4096, MP + b * DS, DS, hd, qtr, tid, wave, lane);
        Q_POP(); }
#endif
#undef Q_POP
}
constexpr int N_PHASES = 15;
#ifndef MK_REP_MIX
#define MK_REP_MIX 1
#endif
#ifndef MK_DUP_VAR
#define MK_DUP_VAR 0
#endif
#ifndef MK_DUP_MODE
#define MK_DUP_MODE 0
#endif
#ifndef MK_REP_EW
#define MK_REP_EW 1
#endif
#ifndef MK_REP_GEMM
#define MK_REP_GEMM 1
#endif
#define DUP_1(...)
#define DUP_2(...) xcd_barrier(bar); __VA_ARGS__
#define DUP_CAT(a, b) a##b
#define DUP_SEL(n) DUP_CAT(DUP_, n)

__global__ void __launch_bounds__(NWAVES * 64, 2) mk_fwd(Args args) {
    extern __shared__ __attribute__((aligned(16))) unsigned char lds_raw[];
    LAS unsigned char* lds = (LAS unsigned char*)lds_raw;
    volatile LAS unsigned* MISC = (volatile LAS unsigned*)(lds + MISC_OFF);
    const int tid = threadIdx.x, lane = tid & 63, wave = __builtin_amdgcn_readfirstlane(tid >> 6);
    const int G = gridDim.x, bx = blockIdx.x;
    const int gw = bx * NWAVES + wave, NGW = G * NWAVES;
    unsigned char* ws = args.ws;
#define P (*args_here())
    gu32* ctl = (gu32*)(ws + WS_CTL);
    for (int u = tid; u < (LDS_BYTES - LDSCTL_OFF) / 4; u += NWAVES * 64) ((LAS unsigned*)(lds + LDSCTL_OFF))[u] = 0u;
    __syncthreads();
    const int lo = args.ph_lo, hi = args.ph_hi;
    const bool one_launch = (hi - lo) > 1;
    XcdBarrier bar; bar.bar = (unsigned*)(ctl + CW_BAR); bar.x = 0; bar.st = nullptr;
    if (one_launch) bar = xcd_barrier_post((unsigned*)(ctl + CW_BAR), MISC + 8);
#ifndef MK_ONLY
#define MK_ONLY -1
#endif
#define IN(k) ((MK_ONLY < 0 || (k) == MK_ONLY) && lo <= (k) && (k) < hi)
#define SEAM(k) do { if (IN(k) && IN((k) + 1)) xcd_barrier(bar); } while (0)
    bf16* XNB = (bf16*)(ws + WS_XNB); bf16* HB = (bf16*)(ws + WS_HB); float* Z = (float*)(ws + WS_Z); float* X1 = (float*)(ws + WS_X1); float* X2 = (float*)(ws + WS_X2);
    const float* cosT = (const float*)(ws + WS_ROPE); const float* sinT = cosT + ROPE_N * 16;

    if (IN(0)) { p0_prologue(P, lds, gw, NGW, wave, lane); SEAM(0); }
#define PH1_BODY do {    \
        pg8::Gemm g{XNB, (const bf16*)(ws + WS_WGUA), M, 2 * FF, DM}; pg8::StaticOrder S; S.init(M, 2 * FF, G, bx); \
        pg8::EpiSwiGLU E{HB, FF}; \
        pg8::gemm_phase<pg8::EpiSwiGLU, pg8::StaticOrder, true, true>(lds + RING_OFF, g, S, E); } while (0)
    if (IN(1)) { PH1_BODY; DUP_SEL(MK_REP_GEMM)(PH1_BODY;) SEAM(1); }
#define SPLIT_BODY(Aop, Wop, KFULL) do { int k256 = 256; asm volatile("" : "+s"(k256)); \
        pg8::Gemm g{Aop, Wop, M, DM, k256, KFULL}; pg8::SplitOrder S; S.init(MS / 256, DM / 256, (KFULL) / 256, MP / 256, G, bx); \
        pg8::EpiPart E{(float*)(ws + WS_PART), DM, MP, (size_t)MS * DM}; \
        pg8::gemm_phase<pg8::EpiPart, pg8::SplitOrder, true, true>(lds + RING_OFF, g, S, E); } while (0)
#define PH2_BODY do {    \
        { pg8::Gemm g{HB, (const bf16*)(ws + WS_WDA), MP, DM, FF, 0}; pg8::StaticOrder S; S.init(MP, DM, G, bx); \
          pg8::EpiResid E{P.in[0], P.in[0], MP, Z, DM, ALPHA, 0.5f}; \
          pg8::gemm_phase<pg8::EpiResid, pg8::StaticOrder, true, true>(lds + RING_OFF, g, S, E); } \
        SPLIT_BODY(HB, (const bf16*)(ws + WS_WDA), FF); } while (0)
    if (IN(2)) { PH2_BODY; DUP_SEL(MK_REP_GEMM)(PH2_BODY;) SEAM(2); }
#define PH3_BODY do { ln_phase(Z, P.in[7], P.in[8], X1, XNB, (const float*)(ws + WS_PART), FF / 256, P.in[1], ALPHA, 0.5f, gw, NGW, lane); } while (0)
    if (IN(3)) { PH3_BODY; DUP_SEL(MK_REP_EW)(PH3_BODY;) SEAM(3); }
#define PH4_BODY do {    \
        pg8::Gemm g{XNB, (const bf16*)(ws + WS_WIN), M, INP, DM}; pg8::StaticOrder S; S.init(M, INP, G, bx); \
        pg8::EpiF32 E{(float*)(ws + WS_PROJ), INP}; \
        pg8::gemm_phase<pg8::EpiF32, pg8::StaticOrder, true, true>(lds + RING_OFF, g, S, E); } while (0)
    if (IN(4)) { PH4_BODY; DUP_SEL(MK_REP_GEMM)(PH4_BODY;) SEAM(4); }
#define PH5_BODY do { prep_a(P, gw, NGW, lane); } while (0)
    if (IN(5)) { PH5_BODY; DUP_SEL(MK_REP_EW)(PH5_BODY;) SEAM(5); }
#define PH6_BODY do {    \
        int k256 = 256; asm volatile("" : "+s"(k256));           \
        { pg8::Gemm g{(const bf16*)(ws + WS_CQN), (const bf16*)(ws + WS_WQ), M, 1280, k256}; pg8::StaticOrder S; S.init(M, 1280, G, bx); \
          pg8::EpiQ E{(bf16*)(ws + WS_QB), cosT, sinT, QSCALE}; \
          pg8::gemm_phase<pg8::EpiQ, pg8::StaticOrder, true, true>(lds + RING_OFF, g, S, E); } \
        { pg8::Gemm g{(const bf16*)(ws + WS_LA), (const bf16*)(ws + WS_WL), M, 1536, k256}; pg8::StaticOrder S; S.init(M, 1536, G, bx); \
          pg8::EpiF32 E{(float*)(ws + WS_LO), 1536}; \
          pg8::gemm_phase<pg8::EpiF32, pg8::StaticOrder, true, true>(lds + RING_OFF, g, S, E); } \
        } while (0)
    if (IN(6)) { PH6_BODY; DUP_SEL(MK_REP_GEMM)(PH6_BODY;) SEAM(6); }
#define PH7_BODY do { prep_c(P, gw, NGW, lane); xcd_barrier(bar); cs::chunk_prep((const float*)(ws + WS_SC5), (const float*)(ws + WS_RKV), ws + WS_OPS, (float*)(ws + WS_G15), lds, gw, NGW, wave, lane); } while (0)
    if (IN(7)) { PH7_BODY; DUP_SEL(MK_REP_EW)(PH7_BODY;) SEAM(7); }
    if (IN(8)) { mixer_phase<0, 0>(P, lds, MISC, ctl, tid, wave, lane); DUP_SEL(MK_REP_MIX)(mixer_phase<MK_DUP_MODE, MK_DUP_VAR>(P, lds, MISC, ctl + 64, tid, wave, lane);) SEAM(8); }
#define PH9_BODY do { post_phase(P, gw, NGW, lane); } while (0)
    if (IN(9)) { PH9_BODY; DUP_SEL(MK_REP_EW)(PH9_BODY;) SEAM(9); }
#define PH10_BODY do {   \
        { pg8::Gemm g{(const bf16*)(ws + WS_OM), (const bf16*)(ws + WS_WO), MP, DM, 1536, 0}; pg8::StaticOrder S; S.init(MP, DM, G, bx); \
          pg8::EpiResid E{X1, X1, M, Z, DM, ALPHA, 1.0f}; \
          pg8::gemm_phase<pg8::EpiResid, pg8::StaticOrder, true, true>(lds + RING_OFF, g, S, E); } \
        SPLIT_BODY((const bf16*)(ws + WS_OM), (const bf16*)(ws + WS_WO), 1536); } while (0)
    if (IN(10)) { PH10_BODY; DUP_SEL(MK_REP_GEMM)(PH10_BODY;) SEAM(10); }
#define PH11_BODY do { ln_phase(Z, P.in[30], P.in[31], X2, XNB, (const float*)(ws + WS_PART), 1536 / 256, X1 + (size_t)MP * DM, ALPHA, 1.0f, gw, NGW, lane); } while (0)
    if (IN(11)) { PH11_BODY; DUP_SEL(MK_REP_EW)(PH11_BODY;) SEAM(11); }
#define PH12_BODY do {   \
        pg8::Gemm g{XNB, (const bf16*)(ws + WS_WGUB), M, 2 * FF, DM}; pg8::StaticOrder S; S.init(M, 2 * FF, G, bx); \
        pg8::EpiSwiGLU E{HB, FF}; \
        pg8::gemm_phase<pg8::EpiSwiGLU, pg8::StaticOrder, true, true>(lds + RING_OFF, g, S, E); } while (0)
    if (IN(12)) { PH12_BODY; DUP_SEL(MK_REP_GEMM)(PH12_BODY;) SEAM(12); }
#define PH13_BODY do {   \
        { pg8::Gemm g{HB, (const bf16*)(ws + WS_WDB), MP, DM, FF, 0}; pg8::StaticOrder S; S.init(MP, DM, G, bx); \
          pg8::EpiResid E{X2, X2, M, Z, DM, ALPHA, 0.5f}; \
          pg8::gemm_phase<pg8::EpiResid, pg8::StaticOrder, true, true>(lds + RING_OFF, g, S, E); } \
        SPLIT_BODY(HB, (const bf16*)(ws + WS_WDB), FF); } while (0)
    if (IN(13)) { PH13_BODY; DUP_SEL(MK_REP_GEMM)(PH13_BODY;) SEAM(13); }
#define PH14_BODY do { ln_phase(Z, P.in[35], P.in[36], P.out + O_YP, nullptr, (const float*)(ws + WS_PART), FF / 256, X2 + (size_t)MP * DM, ALPHA, 0.5f, gw, NGW, lane); } while (0)
    if (IN(14)) { PH14_BODY; DUP_SEL(MK_REP_EW)(PH14_BODY;) }
#undef IN
#undef SEAM
#undef P
}

#ifndef MK_PER_PHASE
#define MK_PER_PHASE 0
#endif
extern "C" void kernel_launch(void* const* d_in, const int* in_sizes, int n_in, void* d_out, int out_size, void* d_ws, size_t ws_size, hipStream_t stream) {
    static int grid = 0;
    if (grid == 0) {
        if (n_in != 37 || (size_t)out_size != O_END || ws_size < WS_END) { fprintf(stderr, "kernel_launch: unexpected shapes: n_in %d out %d ws %zu\n", n_in, out_size, ws_size); grid = -1; return; }
        int dev = 0, cus = 0, per_cu = 0;
        if (hipGetDevice(&dev) != hipSuccess || hipDeviceGetAttribute(&cus, hipDeviceAttributeMultiprocessorCount, dev) != hipSuccess) { grid = -1; return; }
        if (hipFuncSetAttribute((const void*)mk_fwd, hipFuncAttributeMaxDynamicSharedMemorySize, LDS_BYTES) != hipSuccess) { fprintf(stderr, "kernel_launch: hipFuncSetAttribute failed\n"); grid = -1; return; }
        if (hipOccupancyMaxActiveBlocksPerMultiprocessor(&per_cu, (const void*)mk_fwd, NWAVES * 64, LDS_BYTES) != hipSuccess || per_cu < 1) { fprintf(stderr, "kernel_launch: occupancy query says %d\n", per_cu); }
        (void)hipGetLastError();
        grid = cus;
    }
    if (grid < 0) return;
    if (hipMemsetAsync((char*)d_ws + WS_CTL, 0, CTL_ZERO_BYTES, stream) != hipSuccess) return;
    Args a{};
    for (int i = 0; i < 37; ++i) a.in[i] = (const float*)d_in[i];
    a.out = (float*)d_out; a.ws = (unsigned char*)d_ws;
#if MK_PER_PHASE
    for (int p = 0; p < N_PHASES; ++p) { a.ph_lo = p; a.ph_hi = p + 1; hipLaunchKernelGGL(mk_fwd, dim3(grid), dim3(NWAVES * 64), LDS_BYTES, stream, a); }
#else
    a.ph_lo = 0; a.ph_hi = N_PHASES;
    hipLaunchKernelGGL(mk_fwd, dim3(grid), dim3(NWAVES * 64), LDS_BYTES, stream, a);
#endif
    const hipError_t le = hipPeekAtLastError();
    if (le != hipSuccess) fprintf(stderr, "kernel_launch: launch failed: %s\n", hipGetErrorName(le));
}
```

```cpp
#include <hip/hip_runtime.h>
#include <cstdio>
#include <cstdint>
namespace pg8 {
#define PG8_LAS __attribute__((address_space(3)))
typedef unsigned short bf16_t;
typedef short bf16x8 __attribute__((ext_vector_type(8)));
typedef float f32x4 __attribute__((ext_vector_type(4)));
typedef unsigned u32x4 __attribute__((ext_vector_type(4)));
constexpr int BM = 256, BK = 64, HALF = 128, HTB = HALF * BK * 2  , STAGE_BYTES = 8 * HTB, NXCD = 8, WGM = 8;

__host__ __device__ __forceinline__ int lds_byte(int r, int c) { const int st = (r >> 4) * 2 + (c >> 5), rr = r & 15, cc = c & 31, ob = rr * 64 + cc * 2; return st * 1024 + (ob ^ (((ob >> 9) & 1) << 5)); }
__host__ __device__ __forceinline__ void stage_rc(int b, int& R, int& C) { const int st = b / 1024, sb = b % 1024, swz = sb ^ (((sb >> 9) & 1) << 5); R = (st >> 1) * 16 + swz / 64; C = (st & 1) * 32 + (swz % 64) / 2; }
__host__ __device__ __forceinline__ int perm32(int rho) { const int n = rho >> 4, i = rho & 15; return 8 * (i >> 2) + 4 * n + (i & 3); }

struct Unit { int pm, pn, pk; };
struct Gemm { const bf16_t* A; const bf16_t* Bt; int M, N, K, ld; };

struct StaticOrder {
    int nM, nN, nwg, G, c;
    __host__ __device__ void init(int M, int N, int G_, int c_) { nM = M / BM; nN = N / BM; nwg = nM * nN; G = G_; c = c_; }
    __host__ __device__ bool next(int i, Unit& u) const {
        const long L = (long)i * G + c; if (L >= nwg) return false;
        int wgid = (int)L; { const int q = nwg / NXCD, r = nwg % NXCD, xcd = wgid % NXCD, off = wgid / NXCD; wgid = (xcd < r ? xcd * (q + 1) : r * (q + 1) + (xcd - r) * q) + off; }
        const int nig = WGM * nN, gid = wgid / nig, fm = gid * WGM, gsz = (nM - fm) < WGM ? (nM - fm) : WGM;
        u.pm = fm + ((wgid % nig) % gsz); u.pn = (wgid % nig) / gsz; u.pk = 0; return true;
    }
    __device__ __forceinline__ void a_ready(const Unit&) const {}
    __device__ __forceinline__ void done(const Unit&) const {}
};
struct SplitOrder {
    int nM, nN, nK, pm0, G, c;
    __host__ __device__ void init(int nM_, int nN_, int nK_, int pm0_, int G_, int c_) { nM = nM_; nN = nN_; nK = nK_; pm0 = pm0_; G = G_; c = c_; }
    __host__ __device__ bool next(int i, Unit& u) const {
        const int L = i * G + c; if (L >= nM * nN * nK) return false;
        const int per = nM * nN, r = L % per; u.pk = L / per; u.pm = pm0 + r / nN; u.pn = r % nN; return true;
    }
    __device__ __forceinline__ void a_ready(const Unit&) const {}
    __device__ __forceinline__ void done(const Unit&) const {}
};
__device__ __forceinline__ unsigned cvt_pk_bf16(float lo, float hi) { unsigned r; asm volatile("v_cvt_pk_bf16_f32 %0, %1, %2" : "=v"(r) : "v"(lo), "v"(hi)); return r; }
__device__ __forceinline__ float silu_mul(float g, float u) { const float e = __builtin_amdgcn_exp2f(-1.4426950408889634f * g); return g * __builtin_amdgcn_rcpf(1.0f + e) * u; }

struct EpiSwiGLU {
    static constexpr bool PERM = true, AFTER_DRAIN = false;
    bf16_t* O; int ldo;
    __device__ __forceinline__ void operator()(const f32x4 (&acc)[2][2][4][2], const Unit& u, int wr, int wc, int fr, int fq) const {
        const int row0 = u.pm * BM + wr * 64 + fr, col0 = u.pn * HALF + wc * 32 + 8 * fq;
#pragma unroll
        for (int ai = 0; ai < 2; ++ai)
#pragma unroll
            for (int m = 0; m < 4; ++m) {
                bf16_t* rowp = O + (size_t)(row0 + ai * HALF + m * 16) * ldo + col0;
                const f32x4 g0 = acc[ai][0][m][0], g1 = acc[ai][0][m][1], u0 = acc[ai][1][m][0], u1 = acc[ai][1][m][1];
                u32x4 w;
                w.x = cvt_pk_bf16(silu_mul(g0[0], u0[0]), silu_mul(g0[1], u0[1])); w.y = cvt_pk_bf16(silu_mul(g0[2], u0[2]), silu_mul(g0[3], u0[3]));
                w.z = cvt_pk_bf16(silu_mul(g1[0], u1[0]), silu_mul(g1[1], u1[1])); w.w = cvt_pk_bf16(silu_mul(g1[2], u1[2]), silu_mul(g1[3], u1[3]));
                *(u32x4*)rowp = w;
            }
    }
};
struct EpiResid {
    static constexpr bool PERM = false, AFTER_DRAIN = false;
    const float* base0; const float* base1; int split; float* Z; int ldc; float alpha, sc;
    __device__ __forceinline__ void operator()(const f32x4 (&acc)[2][2][4][2], const Unit& u, int wr, int wc, int fr, int fq) const {
        const int row0 = u.pm * BM + wr * 64 + fr, col0 = u.pn * BM + wc * 32 + 4 * fq;
        const float* bp = (u.pm * BM < split) ? base0 : base1 - (size_t)split * ldc;
#pragma unroll
        for (int ai = 0; ai < 2; ++ai)
#pragma unroll
            for (int m = 0; m < 4; ++m) {
                const size_t off = (size_t)(row0 + ai * HALF + m * 16) * ldc + col0;
#pragma unroll
                for (int bj = 0; bj < 2; ++bj)
#pragma unroll
                    for (int n = 0; n < 2; ++n) { const size_t o = off + bj * HALF + n * 16; const f32x4 b = *(const f32x4*)(bp + o); *(f32x4*)(Z + o) = b * alpha + acc[ai][bj][m][n] * sc; }
            }
    }
};
struct EpiF32 {
    static constexpr bool PERM = false, AFTER_DRAIN = false;
    float* O; int ldc;
    __device__ __forceinline__ void operator()(const f32x4 (&acc)[2][2][4][2], const Unit& u, int wr, int wc, int fr, int fq) const {
        const int row0 = u.pm * BM + wr * 64 + fr, col0 = u.pn * BM + wc * 32 + 4 * fq;
#pragma unroll
        for (int ai = 0; ai < 2; ++ai)
#pragma unroll
            for (int m = 0; m < 4; ++m) {
                const size_t off = (size_t)(row0 + ai * HALF + m * 16) * ldc + col0;
#pragma unroll
                for (int bj = 0; bj < 2; ++bj)
#pragma unroll
                    for (int n = 0; n < 2; ++n) *(f32x4*)(O + off + bj * HALF + n * 16) = acc[ai][bj][m][n];
            }
    }
};
struct EpiPart {
    static constexpr bool PERM = false, AFTER_DRAIN = false;
    float* O; int ldc; int row0; size_t pstride;
    __device__ __forceinline__ void operator()(const f32x4 (&acc)[2][2][4][2], const Unit& u, int wr, int wc, int fr, int fq) const {
        const int rowb = u.pm * BM - row0 + wr * 64 + fr, col0 = u.pn * BM + wc * 32 + 4 * fq; float* Ob = O + (size_t)u.pk * pstride;
#pragma unroll
        for (int ai = 0; ai < 2; ++ai)
#pragma unroll
            for (int m = 0; m < 4; ++m) {
                const size_t off = (size_t)(rowb + ai * HALF + m * 16) * ldc + col0;
#pragma unroll
                for (int bj = 0; bj < 2; ++bj)
#pragma unroll
                    for (int n = 0; n < 2; ++n) *(f32x4*)(Ob + off + bj * HALF + n * 16) = acc[ai][bj][m][n];
            }
    }
};
struct EpiQ {
    static constexpr bool PERM = true, AFTER_DRAIN = false;
    bf16_t* Q; const float* cosT; const float* sinT; float qscale;
    __device__ __forceinline__ void operator()(const f32x4 (&acc)[2][2][4][2], const Unit& u, int wr, int wc, int fr, int fq) const {
        const int row0 = u.pm * BM + wr * 64 + fr;
        if (u.pn < 4) {
#pragma unroll
            for (int ai = 0; ai < 2; ++ai)
#pragma unroll
                for (int m = 0; m < 4; ++m) {
                    const int row = row0 + ai * HALF + m * 16;
#pragma unroll
                    for (int bj = 0; bj < 2; ++bj) {
                        bf16_t* p = Q + (size_t)row * 1280 + (2 * u.pn + bj) * 160 + wc * 32 + 8 * fq;
                        const f32x4 v0 = acc[ai][bj][m][0] * qscale, v1 = acc[ai][bj][m][1] * qscale;
                        u32x4 w; w.x = cvt_pk_bf16(v0[0], v0[1]); w.y = cvt_pk_bf16(v0[2], v0[3]); w.z = cvt_pk_bf16(v1[0], v1[1]); w.w = cvt_pk_bf16(v1[2], v1[3]);
                        *(u32x4*)p = w;
                    }
                }
        } else {
#pragma unroll
            for (int ai = 0; ai < 2; ++ai)
#pragma unroll
                for (int m = 0; m < 4; ++m) {
                    const int row = row0 + ai * HALF + m * 16;
                    const int tix = row < 32768 ? (row & 8191) : 8192 + ((row - 32768) & 7);
                    const f32x4 c = *(const f32x4*)(cosT + tix * 16 + 4 * fq), s = *(const f32x4*)(sinT + tix * 16 + 4 * fq);
#pragma unroll
                    for (int bj = 0; bj < 2; ++bj) {
                        bf16_t* p = Q + (size_t)row * 1280 + (4 * bj + wc) * 160 + 128 + 8 * fq;
                        const f32x4 v0 = acc[ai][bj][m][0], v1 = acc[ai][bj][m][1];
                        u32x4 w;
                        w.x = cvt_pk_bf16((v0[0] * c[0] - v0[1] * s[0]) * qscale, (v0[0] * s[0] + v0[1] * c[0]) * qscale);
                        w.y = cvt_pk_bf16((v0[2] * c[1] - v0[3] * s[1]) * qscale, (v0[2] * s[1] + v0[3] * c[1]) * qscale);
                        w.z = cvt_pk_bf16((v1[0] * c[2] - v1[1] * s[2]) * qscale, (v1[0] * s[2] + v1[1] * c[2]) * qscale);
                        w.w = cvt_pk_bf16((v1[2] * c[3] - v1[3] * s[3]) * qscale, (v1[2] * s[3] + v1[3] * c[3]) * qscale);
                        *(u32x4*)p = w;
                    }
                }
        }
    }
};
template <class Epi, class Sched, bool ALIGN_EPI = false, bool SP2 = false>
__device__ __forceinline__ void gemm_phase(PG8_LAS unsigned char* lds, const Gemm g, const Sched& S, const Epi& E) {
    const int tid = threadIdx.x, wid = __builtin_amdgcn_readfirstlane(tid >> 6), lane = tid & 63, wr = wid >> 2, wc = wid & 3, fr = lane & 15, fq = lane >> 4;
    const int K = g.K, LD = g.ld ? g.ld : g.K, nt = K / BK;
    unsigned voffA[2], voffB[2];
#pragma unroll
    for (int i = 0; i < 2; ++i) { int R, C; stage_rc(tid * 16 + i * 8192, R, C); const int Rb = Epi::PERM ? ((R & ~31) + perm32(R & 31)) : R;
        voffA[i] = (unsigned)(R * LD + C) * 2u; voffB[i] = (unsigned)(Rb * LD + C) * 2u; }
    const size_t kstep = (size_t)(BK * 2);
    const size_t hstep = (size_t)HALF * LD * 2;
    const size_t tstep = 2 * hstep;
    const unsigned ldsw = (unsigned)wid * 1024u;
    const int aoff = lds_byte(wr * 64 + fr, fq * 8), boff = lds_byte(wc * 32 + fr, fq * 8);
#define PG8_SA(b, h) (((b) * 2 + (h)) * HTB)
#define PG8_SB(b, h) ((4 + (b) * 2 + (h)) * HTB)
#define PG8_STAGE(bufoff, gbase, voff) do { _Pragma("unroll") for (int _i = 0; _i < 2; ++_i) \
        __builtin_amdgcn_global_load_lds((const unsigned*)((const char*)(gbase) + (voff)[_i]), (PG8_LAS unsigned*)(lds + (bufoff) + ldsw + _i * 8192), 16, 0, 0); } while (0)
#define PG8_LDA(dst, b, h) do { _Pragma("unroll") for (int m = 0; m < 4; ++m) _Pragma("unroll") for (int k = 0; k < 2; ++k) dst[m][k] = *(const PG8_LAS bf16x8*)(lds + PG8_SA(b, h) + aoff + m * 2048 + k * 1024); } while (0)
#define PG8_LDB(dst, b, h) do { _Pragma("unroll") for (int n = 0; n < 2; ++n) _Pragma("unroll") for (int k = 0; k < 2; ++k) dst[n][k] = *(const PG8_LAS bf16x8*)(lds + PG8_SB(b, h) + boff + n * 2048 + k * 1024); } while (0)
#define PG8_MMA(ai, bj, At, Bt) do { __builtin_amdgcn_s_setprio(1); _Pragma("unroll") for (int m = 0; m < 4; ++m) _Pragma("unroll") for (int n = 0; n < 2; ++n) _Pragma("unroll") for (int k = 0; k < 2; ++k) \
        acc[ai][bj][m][n] = __builtin_amdgcn_mfma_f32_16x16x32_bf16(Bt[n][k], At[m][k], acc[ai][bj][m][n], 0, 0, 0); __builtin_amdgcn_s_setprio(0); } while (0)
#define PG8_WAIT_V(n) asm volatile("s_waitcnt vmcnt(" #n ")" ::: "memory")
#define PG8_WAIT_L(n) asm volatile("s_waitcnt lgkmcnt(" #n ")" ::: "memory")
#define PG8_BAR __builtin_amdgcn_s_barrier()
#define PG8_SCHED __builtin_amdgcn_sched_barrier(0)
    Unit cur, nxt; int ui = 0;
    if (!S.next(0, cur)) return;
    f32x4 acc[2][2][4][2];
#pragma unroll
    for (int a = 0; a < 2; ++a)
#pragma unroll
        for (int b = 0; b < 2; ++b)
#pragma unroll
            for (int m = 0; m < 4; ++m)
#pragma unroll
                for (int n = 0; n < 2; ++n) acc[a][b][m][n] = (f32x4){0.f, 0.f, 0.f, 0.f};
    bf16x8 At[4][2], B0[2][2], B1[2][2];
    const size_t sstep = (size_t)K * 2;
    const char* cA = (const char*)g.A + (size_t)cur.pm * tstep + (size_t)cur.pk * sstep; const char* cB = (const char*)g.Bt + (size_t)cur.pn * tstep + (size_t)cur.pk * sstep;
    S.a_ready(cur);
    if constexpr (SP2) {
        PG8_STAGE(PG8_SB(0, 0), cB, voffB); PG8_STAGE(PG8_SB(0, 1), cB + hstep, voffB); PG8_STAGE(PG8_SA(0, 0), cA, voffA); PG8_STAGE(PG8_SA(0, 1), cA + hstep, voffA);
        if (wr == 1) PG8_BAR;
        PG8_WAIT_V(2); PG8_BAR;
        PG8_STAGE(PG8_SB(1, 0), cB + kstep, voffB); PG8_STAGE(PG8_SA(1, 0), cA + kstep, voffA); PG8_STAGE(PG8_SB(1, 1), cB + hstep + kstep, voffB);
        PG8_WAIT_V(6); PG8_BAR;
    } else {
        PG8_STAGE(PG8_SB(0, 0), cB, voffB); PG8_STAGE(PG8_SA(0, 0), cA, voffA); PG8_STAGE(PG8_SB(0, 1), cB + hstep, voffB); PG8_STAGE(PG8_SA(0, 1), cA + hstep, voffA);
        if (wr == 1) PG8_BAR;
        PG8_WAIT_V(4); PG8_BAR;
        PG8_STAGE(PG8_SB(1, 0), cB + kstep, voffB); PG8_STAGE(PG8_SA(1, 0), cA + kstep, voffA); PG8_STAGE(PG8_SB(1, 1), cB + hstep + kstep, voffB);
        PG8_WAIT_V(6); PG8_BAR;
    }
    for (;;) {
        const bool has_next = S.next(ui + 1, nxt);
        const char* nA = has_next ? (const char*)g.A + (size_t)nxt.pm * tstep + (size_t)nxt.pk * sstep : cA; const char* nB = has_next ? (const char*)g.Bt + (size_t)nxt.pn * tstep + (size_t)nxt.pk * sstep : cB;
        for (int t = 0; t < nt; t += 2) {
            const bool last = (t == nt - 2);
            const char* a1 = cA + (size_t)(t + 1) * kstep;
            const char* a2 = last ? nA : cA + (size_t)(t + 2) * kstep; const char* b2 = last ? nB : cB + (size_t)(t + 2) * kstep;
            const char* a3 = a2 + kstep; const char* b3 = b2 + kstep;
            if (last && has_next) S.a_ready(nxt);
            if constexpr (SP2) {
            PG8_LDB(B0, 0, 0); PG8_LDB(B1, 0, 1); PG8_SCHED; PG8_LDA(At, 0, 0); PG8_STAGE(PG8_SA(1, 1), a1 + hstep, voffA);
            PG8_WAIT_V(8); PG8_WAIT_L(0); PG8_BAR; PG8_MMA(0, 0, At, B0); PG8_MMA(0, 1, At, B1); PG8_BAR; PG8_SCHED;
            PG8_LDA(At, 0, 1); PG8_STAGE(PG8_SB(0, 0), b2, voffB); PG8_STAGE(PG8_SB(0, 1), b2 + hstep, voffB); PG8_STAGE(PG8_SA(0, 0), a2, voffA);
            PG8_WAIT_V(8); PG8_WAIT_L(0); PG8_BAR; PG8_MMA(1, 0, At, B0); PG8_MMA(1, 1, At, B1); PG8_BAR; PG8_SCHED;
            PG8_LDB(B0, 1, 0); PG8_LDB(B1, 1, 1); PG8_SCHED; PG8_LDA(At, 1, 0); PG8_STAGE(PG8_SA(0, 1), a2 + hstep, voffA);
            PG8_WAIT_V(8); PG8_WAIT_L(0); PG8_BAR; PG8_MMA(0, 0, At, B0); PG8_MMA(0, 1, At, B1); PG8_BAR; PG8_SCHED;
            PG8_LDA(At, 1, 1); PG8_STAGE(PG8_SB(1, 0), b3, voffB); PG8_STAGE(PG8_SB(1, 1), b3 + hstep, voffB); PG8_STAGE(PG8_SA(1, 0), a3, voffA);
            PG8_WAIT_V(8); PG8_WAIT_L(0); PG8_BAR; PG8_MMA(1, 0, At, B0); PG8_MMA(1, 1, At, B1); PG8_BAR; PG8_SCHED;
            } else {
            PG8_LDB(B0, 0, 0); PG8_SCHED; PG8_LDA(At, 0, 0); PG8_STAGE(PG8_SA(1, 1), a1 + hstep, voffA);
            PG8_WAIT_L(8); PG8_BAR; PG8_WAIT_L(0); PG8_MMA(0, 0, At, B0); PG8_BAR; PG8_SCHED;
            PG8_LDB(B1, 0, 1); PG8_STAGE(PG8_SB(0, 0), b2, voffB);
            PG8_BAR; PG8_WAIT_L(0); PG8_MMA(0, 1, At, B1); PG8_BAR;
            PG8_LDA(At, 0, 1); PG8_STAGE(PG8_SA(0, 0), a2, voffA);
            PG8_BAR; PG8_WAIT_L(0); PG8_MMA(1, 0, At, B0); PG8_BAR; PG8_SCHED;
            PG8_STAGE(PG8_SB(0, 1), b2 + hstep, voffB);
            PG8_WAIT_V(6); PG8_BAR; PG8_MMA(1, 1, At, B1); PG8_BAR;
            PG8_LDB(B0, 1, 0); PG8_SCHED; PG8_LDA(At, 1, 0); PG8_STAGE(PG8_SA(0, 1), a2 + hstep, voffA);
            PG8_WAIT_L(8); PG8_BAR; PG8_WAIT_L(0); PG8_MMA(0, 0, At, B0); PG8_BAR; PG8_SCHED;
            PG8_LDB(B1, 1, 1); PG8_STAGE(PG8_SB(1, 0), b3, voffB);
            PG8_BAR; PG8_WAIT_L(0); PG8_MMA(0, 1, At, B1); PG8_BAR;
            PG8_LDA(At, 1, 1); PG8_STAGE(PG8_SA(1, 0), a3, voffA);
            PG8_BAR; PG8_WAIT_L(0); PG8_MMA(1, 0, At, B0); PG8_BAR; PG8_SCHED;
            PG8_STAGE(PG8_SB(1, 1), b3 + hstep, voffB);
            PG8_WAIT_V(6); PG8_BAR; PG8_MMA(1, 1, At, B1); PG8_BAR;
            }
        }
        if constexpr (ALIGN_EPI) { if (wr == 0) PG8_BAR; }
        if constexpr (!Epi::AFTER_DRAIN) { E(acc, cur, wr, wc, fr, fq); S.done(cur); }
        if (!has_next) break;
#pragma unroll
        for (int a = 0; a < 2; ++a)
#pragma unroll
            for (int b = 0; b < 2; ++b)
#pragma unroll
                for (int m = 0; m < 4; ++m)
#pragma unroll
                    for (int n = 0; n < 2; ++n) acc[a][b][m][n] = (f32x4){0.f, 0.f, 0.f, 0.f};
        cur = nxt; cA = nA; cB = nB; ++ui;
        if constexpr (ALIGN_EPI) { if (wr == 1) PG8_BAR; }
    }
    PG8_WAIT_V(0);
    if constexpr (!ALIGN_EPI) { if (wr == 0) PG8_BAR; }
    PG8_BAR;
    if constexpr (Epi::AFTER_DRAIN) { E.fused(acc, cur, wr, wc, fr, fq, lds, wid, lane); S.done(cur); }
#undef PG8_SA
#undef PG8_SB
#undef PG8_STAGE
#undef PG8_LDA
#undef PG8_LDB
#undef PG8_MMA
#undef PG8_WAIT_V
#undef PG8_WAIT_L
#undef PG8_BAR
#undef PG8_SCHED
}
}
constexpr int NWAVES = 8;
constexpr int DM = 1024, SEQ = 8192, NB = 4, DB = 128, DS = 8, FF = 2816;
constexpr int MP = NB * SEQ, MS = DB * DS, M = MP + MS;
constexpr int QR = 256, KVR = 128, RD = 32, RWC = 1792, INC = 2208, INP = 2304, RWD = 512;
constexpr int NPAGE = 128, PAGE = 128;
constexpr float ALPHA = 1.189207115002721f;
constexpr float QSCALE = 0.10206207261596577f * 1.4426950408889634f;
constexpr float LN_EPS = 1e-5f, RMS_EPS = 1e-6f, GN_EPS = 64e-5f;
constexpr size_t O_YP = 0, O_YS = 33554432, O_CKVP = 34603008, O_KRP = 38797312, O_WKVP = 39845888, O_SHP = 39976960,
                 O_CKVS = 39984128, O_KRS = 40115200, O_WKVS = 40147968, O_SHS = 44342272, O_END = 44571648;
constexpr size_t MiB = 1u << 20;
constexpr size_t WS_CTL = 0, CTL_ZERO_BYTES = 1 * MiB;
constexpr size_t WS_WGUA = 2 * MiB, WS_WDA = 13 * MiB, WS_WGUB = 19 * MiB, WS_WDB = 30 * MiB, WS_WIN = 36 * MiB, WS_WQ = 41 * MiB, WS_WO = 42 * MiB, WS_WL = 45 * MiB, WS_ROPE = 46 * MiB;
constexpr size_t WS_XNB = 48 * MiB, WS_HB = 114 * MiB, WS_Z = 296 * MiB, WS_X1 = 428 * MiB, WS_X2 = 560 * MiB, WS_PROJ = 692 * MiB, WS_CQN = 989 * MiB, WS_QB = 1006 * MiB;
constexpr size_t WS_CKVB = 1089 * MiB, WS_KRB = 1098 * MiB, WS_RKV = 1101 * MiB, WS_LA = 1299 * MiB, WS_LO = 1316 * MiB, WS_SC5 = 1514 * MiB, WS_G = 1844 * MiB, WS_SCAL = 1910 * MiB;
constexpr size_t WS_Y = 1915 * MiB, WS_OM = 1981 * MiB, WS_PO = 2080 * MiB, WS_PML = 2112 * MiB, WS_PART = 2113 * MiB, WS_OPS = 2161 * MiB, WS_G15 = 2321 * MiB, WS_END = 2325 * MiB;
constexpr int ROPE_N = 8200;
constexpr int CW_TMO = 0, CW_QHEAD = 64, CW_BAR = 4096;
constexpr int RING_OFF = 0, RING_BYTES = 131072, LDSCTL_OFF = RING_BYTES, MISC_OFF = LDSCTL_OFF + 320, LDS_BYTES = 147456;

#define GAS __attribute__((address_space(1)))
#define LAS __attribute__((address_space(3)))
typedef unsigned short bf16;
typedef unsigned v4u __attribute__((ext_vector_type(4)));
typedef unsigned v2u __attribute__((ext_vector_type(2)));
typedef float f32x4 __attribute__((ext_vector_type(4)));
typedef float f32x2 __attribute__((ext_vector_type(2)));
typedef short bf16x8 __attribute__((ext_vector_type(8)));
typedef short s16x4 __attribute__((ext_vector_type(4)));
typedef float f32x16 __attribute__((ext_vector_type(16)));
typedef GAS unsigned gu32;
#define RLX_AGENT __ATOMIC_RELAXED, __HIP_MEMORY_SCOPE_AGENT
#define DI __device__ __forceinline__
DI unsigned f2bf(float f) { unsigned u = __builtin_bit_cast(unsigned, f); return (u + 0x7fffu + ((u >> 16) & 1u)) >> 16; }
DI unsigned pk2(float lo, float hi) { return f2bf(lo) | (f2bf(hi) << 16); }
DI float wave_sum(float v) {
#pragma unroll
    for (int o = 1; o < 64; o <<= 1) v += __shfl_xor(v, o);
    return v;
}
#define XB_TMO      128
#define XB_XCNT(j)  (256  + 64 * (j))
#define XB_XSUB(j)  (1280 + 64 * (j))
#define XB_XGEN(j)  (2304 + 64 * (j))
#define XB_TOP      3328
#define XB_TOPGEN   3392
#define XCD_BAR_WORDS 3456
#define XB_SPIN_CAP (1u << 18)

__device__ __forceinline__ unsigned xb_ld(unsigned* p)              { return __hip_atomic_load(p, __ATOMIC_RELAXED, __HIP_MEMORY_SCOPE_AGENT); }
__device__ __forceinline__ unsigned xb_add(unsigned* p, unsigned v) { return __hip_atomic_fetch_add(p, v, __ATOMIC_RELAXED, __HIP_MEMORY_SCOPE_AGENT); }
__device__ __forceinline__ unsigned xb_xcc_id() { return (unsigned)__builtin_amdgcn_s_getreg((3 << 11) | 20) & 0xFu; }
#define XB_SPIN(cond, bar) do { unsigned _sp = 0; while (cond) { __builtin_amdgcn_s_sleep(1); \
    if ((++_sp & 255u) == 0u) { if (xb_ld(&(bar)[XB_TMO])) break; if (_sp > XB_SPIN_CAP) { atomicAdd(&(bar)[XB_TMO], 1u); break; } } } } while (0)

struct XcdBarrier {
    unsigned* bar; unsigned x;
    volatile LAS unsigned* st;
};

__device__ __forceinline__ XcdBarrier xcd_barrier_post(unsigned* bar, volatile LAS unsigned* st) {
    XcdBarrier b; b.bar = bar; b.x = xb_xcc_id(); b.st = st;
    if (threadIdx.x == 0) (void)xb_add(&bar[XB_XCNT(b.x)], 1u);
    return b;
}
__device__ __forceinline__ void xcd_barrier_complete(unsigned* bar, unsigned x, unsigned& nloc, unsigned& nx) {
    const unsigned G = gridDim.x * gridDim.y * gridDim.z;
    unsigned sum, cnt, mine, sp = 0u;
    for (;;) {
        sum = 0u; cnt = 0u; mine = 0u;
#pragma unroll
        for (unsigned j = 0; j < 16; ++j) { const unsigned c = xb_ld(&bar[XB_XCNT(j)]); sum += c; cnt += (c > 0u) ? 1u : 0u; mine = (j == x) ? c : mine; }
        if (sum == G) break;
        __builtin_amdgcn_s_sleep(1);
        if ((++sp & 255u) == 0u) { if (xb_ld(&bar[XB_TMO])) break; if (sp > XB_SPIN_CAP) { atomicAdd(&bar[XB_TMO], 1u); break; } }
    }
    nloc = mine > 0u ? mine : 1u; nx = cnt > 0u ? cnt : 1u;
}

__device__ __forceinline__ void xcd_barrier(const XcdBarrier& b) {
    asm volatile("s_waitcnt vmcnt(0)" ::: "memory");
    __syncthreads();
    if (threadIdx.x == 0) {
        unsigned* bar = b.bar;
        __builtin_amdgcn_s_waitcnt(0);
        unsigned nloc = b.st[0], nx = b.st[1];
        if (nloc == 0u) { xcd_barrier_complete(bar, b.x, nloc, nx); b.st[0] = nloc; b.st[1] = nx; }
        const unsigned old = xb_add(&bar[XB_XSUB(b.x)], 1u);
        const unsigned gen = old / nloc;
        if (old + 1u == (gen + 1u) * nloc) {
            __builtin_amdgcn_fence(__ATOMIC_RELEASE, "agent");
            asm volatile("s_waitcnt vmcnt(0)" ::: "memory");
            const unsigned og = xb_add(&bar[XB_TOP], 1u);
            const unsigned tg = og / nx;
            if (og + 1u == (tg + 1u) * nx) xb_add(&bar[XB_TOPGEN], 1u);
            else XB_SPIN(xb_ld(&bar[XB_TOPGEN]) == tg, bar);
            __builtin_amdgcn_fence(__ATOMIC_ACQUIRE, "agent");
            xb_add(&bar[XB_XGEN(b.x)], 1u);
            asm volatile("s_waitcnt vmcnt(0)" ::: "memory");
        } else {
            XB_SPIN(xb_ld(&bar[XB_XGEN(b.x)]) == gen, bar);
            __builtin_amdgcn_fence(__ATOMIC_ACQUIRE, "agent");
            asm volatile("s_waitcnt vmcnt(0)" ::: "memory");
        }
    }
    __syncthreads();
}
DI void p0_transpose_item(const float* W, int K, int N, bf16* WT, int kb, int nb, int drow0, LAS float* scr, int lane) {
    const int k0 = 64 * kb, n0 = 32 * nb;
#pragma unroll 8
    for (int i = 0; i < 32; ++i) { const int kk = 2 * i + (lane >> 5); scr[kk * 33 + (lane & 31)] = W[(size_t)(k0 + kk) * N + n0 + (lane & 31)]; }
    asm volatile("s_waitcnt lgkmcnt(0)" ::: "memory");
    const int c = lane & 7;
#pragma unroll
    for (int j = 0; j < 4; ++j) { const int n = (lane >> 3) + 8 * j; const LAS float* s = scr + (8 * c) * 33 + n;
        v4u o; o.x = pk2(s[0 * 33], s[1 * 33]); o.y = pk2(s[2 * 33], s[3 * 33]); o.z = pk2(s[4 * 33], s[5 * 33]); o.w = pk2(s[6 * 33], s[7 * 33]);
        *(GAS v4u*)(WT + (size_t)(drow0 + n) * K + k0 + 8 * c) = o; }
    asm volatile("s_waitcnt lgkmcnt(0)" ::: "memory");
}
DI int gu_row(int n, int up) { return 256 * (n >> 7) + (n & 127) + (up ? 128 : 0); }

DI void sincos_d(double r, double& s, double& c) {
    const double z = r * r;
    double ps = -9.18368986379554601e-29; ps = ps * z + 6.44695028438447359e-26; ps = ps * z - 3.86817017063068413e-23; ps = ps * z + 1.95729410633912626e-20; ps = ps * z - 8.22063524662432950e-18;
    ps = ps * z + 2.81145725434552060e-15; ps = ps * z - 7.64716373181981641e-13; ps = ps * z + 1.60590438368216133e-10; ps = ps * z - 2.50521083854417202e-08; ps = ps * z + 2.75573192239858925e-06;
    ps = ps * z - 1.98412698412698413e-04; ps = ps * z + 8.33333333333333322e-03; ps = ps * z - 1.66666666666666657e-01; ps = ps * z + 1.0; s = ps * r;
    double pc = 3.27988923706983776e-30; pc = pc * z - 2.47959626322479759e-27; pc = pc * z + 1.61173757109611839e-24; pc = pc * z - 8.89679139245057408e-22; pc = pc * z + 4.11031762331216484e-19;
    pc = pc * z - 1.56192069685862253e-16; pc = pc * z + 4.77947733238738525e-14; pc = pc * z - 1.14707455977297245e-11; pc = pc * z + 2.08767569878681002e-09; pc = pc * z - 2.75573192239858883e-07;
    pc = pc * z + 2.48015873015873016e-05; pc = pc * z - 1.38888888888888894e-03; pc = pc * z + 4.16666666666666644e-02; pc = pc * z - 0.5; pc = pc * z + 1.0; c = pc;
}

struct Args { const float* in[37]; float* out; unsigned char* ws; int ph_lo, ph_hi; };
static_assert(sizeof(Args) == 37 * 8 + 8 + 8 + 8, "Args has no padding");
typedef const __attribute__((address_space(4))) Args Ptrs;
DI Ptrs* args_here() { Ptrs* p = (Ptrs*)__builtin_amdgcn_kernarg_segment_ptr(); asm volatile("" : "+s"(p)); return p; }

DI void p0_prologue(const Ptrs& P, LAS unsigned char* lds, int gw, int NGW, int wave, int lane) {
    unsigned char* ws = P.ws;
    LAS float* scr = (LAS float*)(lds + RING_OFF + wave * 16384);
    constexpr int I_GU = (DM / 64) * (FF / 32), I_D = (FF / 64) * (DM / 32), I_IN = (DM / 64) * (INC / 32);
    constexpr int NITEMS = 6 * I_GU + I_IN;
    for (int it = gw; it < NITEMS; it += NGW) {
        int r = it;
        if (r < 4 * I_GU) {
            const int which = r / I_GU; r -= which * I_GU; const int nblk = FF / 32, kb = r / nblk, nb = r % nblk;
            const float* W = which == 0 ? P.in[9] : which == 1 ? P.in[10] : which == 2 ? P.in[32] : P.in[33];
            bf16* WT = (bf16*)(ws + (which < 2 ? WS_WGUA : WS_WGUB));
            p0_transpose_item(W, DM, FF, WT, kb, nb, gu_row(32 * nb, which & 1), scr, lane); continue; }
        r -= 4 * I_GU;
        if (r < 2 * I_D) { const int which = r / I_D; r -= which * I_D; const int nblk = DM / 32, kb = r / nblk, nb = r % nblk;
            p0_transpose_item(which ? P.in[34] : P.in[11], FF, DM, (bf16*)(ws + (which ? WS_WDB : WS_WDA)), kb, nb, 32 * nb, scr, lane); continue; }
        r -= 2 * I_D;
        { const int nblk = INC / 32, kb = r / nblk, nb = r % nblk; p0_transpose_item(P.in[12], DM, INC, (bf16*)(ws + WS_WIN), kb, nb, 32 * nb, scr, lane); }
    }
    const int gt = gw * 64 + lane, NGT = NGW * 64;
    { GAS v4u* z = (GAS v4u*)(ws + WS_WIN + (size_t)INC * DM * 2); for (int i = gt; i < (INP - INC) * DM * 2 / 16; i += NGT) z[i] = (v4u){0u, 0u, 0u, 0u}; }
    { bf16* WL = (bf16*)(ws + WS_WL); const float* wl = P.in[20]; const float* al = P.in[22]; const float* gl = P.in[23];
      for (int i = gt; i < 1536 * 256; i += NGT) { const int n = i >> 8, k = i & 255; float v = 0.f;
          if (n < 512) { if (k < 64) v = wl[k * 512 + n]; }
          else if (n < 1024) { if (k >= 64 && k < 128) v = al[(k - 64) * 512 + (n - 512)]; }
          else { if (k >= 128) v = gl[(k - 128) * 512 + (n - 1024)]; }
          WL[i] = (bf16)f2bf(v); } }
    { bf16* WQ = (bf16*)(ws + WS_WQ); const float* uq = P.in[14]; const float* uk = P.in[16];
      for (int i = gt; i < 1280 * 256; i += NGT) { const int n = i >> 8, c = i & 255; float v;
          if (n < 1024) { const int hd = n >> 7, r = n & 127; const float* a = uq + c * 768 + hd * 96; const float* b = uk + r * 512 + hd * 64; float s = 0.f;
              for (int j = 0; j < 64; ++j) s += a[j] * b[j]; v = s; }
          else { const int hd = (n - 1024) >> 5, cp = (n - 1024) & 31, p = (cp >> 1) + 16 * (cp & 1); v = uq[c * 768 + hd * 96 + 64 + p]; }
          WQ[i] = (bf16)f2bf(v); } }
    { bf16* WO = (bf16*)(ws + WS_WO); const float* uv = P.in[17]; const float* wo = P.in[29];
      for (int i = gt; i < 1536 * 1024; i += NGT) { const int k = i >> 10, n = i & 1023; float v;
          if (k < 1024) { const int hd = k >> 7, r = k & 127; const float* a = uv + r * 512 + hd * 64; const float* b = wo + (size_t)(hd * 64) * 1024 + n; float s = 0.f;
              for (int j = 0; j < 64; ++j) s += a[j] * b[(size_t)j * 1024]; v = s; }
          else v = wo[(size_t)(512 + k - 1024) * 1024 + n];
          WO[(size_t)n * 1536 + k] = (bf16)f2bf(v); } }
    { float* ct = (float*)(ws + WS_ROPE); float* st = ct + ROPE_N * 16;
      for (int i = gt; i < ROPE_N * 16; i += NGT) { const int tix = i >> 4, f = i & 15; const double pos = (double)(tix < 8192 ? tix : 16384 + (tix - 8192));
          double inv = 1.0; for (int q = 0; q < f; ++q) inv *= 0.5623413251903491;
          const double ang = pos * inv; const double kq = __builtin_rint(ang * 0.15915494309189535); const double r = __builtin_fma(-kq, 6.283185307179586, ang) - kq * 2.4492935982947064e-16;
          double s, c; sincos_d(r, s, c); ct[i] = (float)c; st[i] = (float)s; } }
    { bf16* XNB = (bf16*)(ws + WS_XNB);
      for (int m = gw; m < M; m += NGW) { const float* xr = m < MP ? P.in[0] + (size_t)m * DM : P.in[1] + (size_t)(m - MP) * DM;
          const GAS f32x4* x4 = (const GAS f32x4*)xr + lane; GAS v2u* o = (GAS v2u*)(XNB + (size_t)m * DM) + lane;
#pragma unroll
          for (int j = 0; j < 4; ++j) { const f32x4 v = x4[64 * j]; o[64 * j] = (v2u){pk2(v.x, v.y), pk2(v.z, v.w)}; } } }
}

DI void ln_phase(const float* Z, const float* g, const float* b, float* Xf, bf16* Xb, const float* part, int nk, const float* sbase, float alpha, float sc, int gw, int NGW, int lane) {
    f32x4 gv[4], bv[4];
#pragma unroll
    for (int j = 0; j < 4; ++j) { gv[j] = ((const GAS f32x4*)g)[lane + 64 * j]; bv[j] = ((const GAS f32x4*)b)[lane + 64 * j]; }
    for (int m = gw; m < M; m += NGW) {
        f32x4 v[4]; float s = 0.f;
        if (m < MP) {
            const GAS f32x4* zr = (const GAS f32x4*)(Z + (size_t)m * DM) + lane;
#pragma unroll
            for (int j = 0; j < 4; ++j) v[j] = zr[64 * j];
        } else {
            const GAS f32x4* br = (const GAS f32x4*)(sbase + (size_t)(m - MP) * DM) + lane; f32x4 a[4];
#pragma unroll
            for (int j = 0; j < 4; ++j) { v[j] = br[64 * j] * alpha; a[j] = (f32x4){0.f, 0.f, 0.f, 0.f}; }
            for (int k = 0; k < nk; ++k) { const GAS f32x4* pr = (const GAS f32x4*)(part + ((size_t)k * MS + (m - MP)) * DM) + lane;
#pragma unroll
                for (int j = 0; j < 4; ++j) a[j] += pr[64 * j]; }
#pragma unroll
            for (int j = 0; j < 4; ++j) v[j] += a[j] * sc;
        }
#pragma unroll
        for (int j = 0; j < 4; ++j) s += (v[j].x + v[j].y) + (v[j].z + v[j].w);
        const float mean = wave_sum(s) * (1.f / DM); float s2 = 0.f;
#pragma unroll
        for (int j = 0; j < 4; ++j) { v[j] = v[j] - mean; s2 += (v[j].x * v[j].x + v[j].y * v[j].y) + (v[j].z * v[j].z + v[j].w * v[j].w); }
        const float rstd = 1.f / sqrtf(wave_sum(s2) * (1.f / DM) + LN_EPS);
#pragma unroll
        for (int j = 0; j < 4; ++j) { v[j] = v[j] * rstd * gv[j] + bv[j]; }
        if (Xf) { GAS f32x4* o = (GAS f32x4*)(Xf + (size_t)m * DM) + lane;
#pragma unroll
            for (int j = 0; j < 4; ++j) o[64 * j] = v[j]; }
        if (Xb) { GAS v2u* o = (GAS v2u*)(Xb + (size_t)m * DM) + lane;
#pragma unroll
            for (int j = 0; j < 4; ++j) o[64 * j] = (v2u){pk2(v[j].x, v[j].y), pk2(v[j].z, v[j].w)}; }
    }
}

DI void prep_a(const Ptrs& P, int gw, int NGW, int lane) {
    unsigned char* ws = P.ws;
    const float* PROJ = (const float*)(ws + WS_PROJ);
    bf16* CQN = (bf16*)(ws + WS_CQN); bf16* CKVB = (bf16*)(ws + WS_CKVB); bf16* KRB = (bf16*)(ws + WS_KRB);
    float* RKV = (float*)(ws + WS_RKV); bf16* LA = (bf16*)(ws + WS_LA);
    const float* ct = (const float*)(ws + WS_ROPE); const float* st = ct + ROPE_N * 16;
    const float* qg = P.in[13]; const float* kg = P.in[15]; const float* mu = P.in[18]; const float* sshift = P.in[5];
    const f32x4 qg4 = ((const GAS f32x4*)qg)[lane]; const f32x2 kg2 = ((const GAS f32x2*)kg)[lane];
    f32x4 mu4[7];
#pragma unroll
    for (int i = 0; i < 7; ++i) mu4[i] = ((const GAS f32x4*)mu)[lane + 64 * i];
    for (int m = gw; m < M; m += NGW) {
        const bool samp = m >= MP; const int ms = m - MP;
        const int bb = samp ? (ms >> 3) : (m >> 13), t = samp ? (ms & 7) : (m & 8191), tix = samp ? 8192 + t : t;
        const float* pr = PROJ + (size_t)m * INP;
        { const f32x4 v = ((const GAS f32x4*)pr)[lane]; const float ss = wave_sum((v.x * v.x + v.y * v.y) + (v.z * v.z + v.w * v.w));
          const float rs = 1.f / sqrtf(ss * (1.f / QR) + RMS_EPS);
          ((GAS v2u*)(CQN + (size_t)m * QR))[lane] = (v2u){pk2(v.x * rs * qg4.x, v.y * rs * qg4.y), pk2(v.z * rs * qg4.z, v.w * rs * qg4.w)}; }
        { const f32x2 v = ((const GAS f32x2*)(pr + QR))[lane]; const float ss = wave_sum(v.x * v.x + v.y * v.y);
          const float rs = 1.f / sqrtf(ss * (1.f / KVR) + RMS_EPS); const float a = v.x * rs * kg2.x, b = v.y * rs * kg2.y;
          float* o = samp ? P.out + O_CKVS + (size_t)ms * KVR : P.out + O_CKVP + (size_t)m * KVR;
          ((GAS f32x2*)o)[lane] = (f32x2){a, b}; ((GAS unsigned*)(CKVB + (size_t)m * KVR))[lane] = pk2(a, b); }
        { const int l31 = lane & 31; const float v = pr[QR + KVR + l31]; const float pv = __shfl_xor(v, 16); const int p = lane & 15;
          const float c = ct[tix * 16 + p], s = st[tix * 16 + p];
          const float o = (l31 < 16) ? v * c - pv * s : pv * s + v * c;
          if (lane < 32) { float* op = samp ? P.out + O_KRS + (size_t)ms * RD : P.out + O_KRP + (size_t)m * RD; op[lane] = o; }
          const float ohi = __shfl_down(o, 16);
          if (lane < 16) ((GAS unsigned*)(KRB + (size_t)m * RD))[lane] = pk2(o, ohi); }
        { const GAS f32x4* rw4 = (const GAS f32x4*)(pr + (INC - RWC));
          const GAS f32x4* pv4 = (t == 0) ? (samp ? (const GAS f32x4*)(sshift + (size_t)bb * RWC) : (const GAS f32x4*)nullptr) : (const GAS f32x4*)(pr - INP + (INC - RWC));
          const bool last = samp ? (t == DS - 1) : (t == SEQ - 1);
          float* sh = samp ? P.out + O_SHS + (size_t)bb * RWC : P.out + O_SHP + (size_t)bb * RWC;
#pragma unroll
          for (int i = 0; i < 7; ++i) {
              if (i < 6 && !samp && !last) continue;
              const f32x4 r = rw4[lane + 64 * i]; const f32x4 pv = pv4 ? pv4[lane + 64 * i] : (f32x4){0.f, 0.f, 0.f, 0.f};
              const f32x4 x = r + (pv - r) * mu4[i];
              if (last) ((GAS f32x4*)sh)[lane + 64 * i] = r;
              if (i < 6) { if (samp) ((GAS f32x4*)(RKV + (size_t)m * 1536))[lane + 64 * i] = x; }
              else { f32x4 y;
                  if (lane < 16) { for (int j = 0; j < 4; ++j) { const float e = __expf(2.f * x[j]); y[j] = 1.f - 2.f / (e + 1.f); } }
                  else if (lane < 32) y = x;
                  else { for (int j = 0; j < 4; ++j) y[j] = 1.f / (1.f + __expf(-x[j])); }
                  ((GAS v2u*)(LA + (size_t)m * 256))[lane] = (v2u){pk2(y.x, y.y), pk2(y.z, y.w)}; }
          } }
    }
}

DI float red8(float v) { v += __shfl_xor(v, 1); v += __shfl_xor(v, 2); v += __shfl_xor(v, 4); return v; }
DI void prep_c(const Ptrs& P, int gw, int NGW, int lane) {
    unsigned char* ws = P.ws;
    const float* RKV = (const float*)(ws + WS_RKV); const float* LO = (const float*)(ws + WS_LO);
    float* SC5 = (float*)(ws + WS_SC5); float* G = (float*)(ws + WS_G); float* SCAL = (float*)(ws + WS_SCAL);
    constexpr size_t ASZ = (size_t)M * RWD;
    const int c0 = lane * 8;
    float w0v[8], a0v[8], kkv[8], kav[8], rkv[8];
#pragma unroll
    for (int j = 0; j < 8; ++j) { w0v[j] = P.in[19][c0 + j]; a0v[j] = P.in[21][c0 + j]; kkv[j] = P.in[24][c0 + j]; kav[j] = P.in[25][c0 + j]; rkv[j] = P.in[26][c0 + j]; }
    for (int m = MP + gw; m < M; m += NGW) {
        const float* rk = RKV + (size_t)m * 1536 + c0; const float* lo = LO + (size_t)m * 1536 + c0;
        float r[8], k[8], wl[8], al[8], gl[8];
        { const f32x4 a = ((const GAS f32x4*)rk)[0], b = ((const GAS f32x4*)rk)[1]; r[0]=a.x; r[1]=a.y; r[2]=a.z; r[3]=a.w; r[4]=b.x; r[5]=b.y; r[6]=b.z; r[7]=b.w; }
        { const f32x4 a = ((const GAS f32x4*)(rk + 512))[0], b = ((const GAS f32x4*)(rk + 512))[1]; k[0]=a.x; k[1]=a.y; k[2]=a.z; k[3]=a.w; k[4]=b.x; k[5]=b.y; k[6]=b.z; k[7]=b.w; }
        { const f32x4 a = ((const GAS f32x4*)lo)[0], b = ((const GAS f32x4*)lo)[1]; wl[0]=a.x; wl[1]=a.y; wl[2]=a.z; wl[3]=a.w; wl[4]=b.x; wl[5]=b.y; wl[6]=b.z; wl[7]=b.w; }
        { const f32x4 a = ((const GAS f32x4*)(lo + 512))[0], b = ((const GAS f32x4*)(lo + 512))[1]; al[0]=a.x; al[1]=a.y; al[2]=a.z; al[3]=a.w; al[4]=b.x; al[5]=b.y; al[6]=b.z; al[7]=b.w; }
        { const f32x4 a = ((const GAS f32x4*)(lo + 1024))[0], b = ((const GAS f32x4*)(lo + 1024))[1]; gl[0]=a.x; gl[1]=a.y; gl[2]=a.z; gl[3]=a.w; gl[4]=b.x; gl[5]=b.y; gl[6]=b.z; gl[7]=b.w; }
        float dec[8], av[8], kk[8], kp[8]; float nn = 0.f;
#pragma unroll
        for (int j = 0; j < 8; ++j) {
            const float z = -(w0v[j] + wl[j]);
            const float sp = fmaxf(z, 0.f) + log1pf(__expf(-fabsf(z)));
            const float w = -sp - 0.5f; dec[j] = __expf(-__expf(w));
            av[j] = 1.f / (1.f + __expf(-(a0v[j] + al[j])));
            kk[j] = k[j] * kkv[j]; nn += kk[j] * kk[j];
            kp[j] = k[j] * (1.f + (av[j] - 1.f) * kav[j]);
        }
        nn = red8(nn); const float inv = 1.f / fmaxf(sqrtf(nn), 1e-12f);
        float as[8], bs[8], wr[8]; float br = 0.f, kr = 0.f, bon = 0.f;
#pragma unroll
        for (int j = 0; j < 8; ++j) { const float kn = kk[j] * inv; as[j] = -kn; bs[j] = kn * av[j]; wr[j] = dec[j] * r[j]; br += bs[j] * r[j]; kr += kp[j] * r[j]; bon += r[j] * kp[j] * rkv[j]; }
        br = red8(br); kr = red8(kr); bon = red8(bon);
        float* o = SC5 + (size_t)m * RWD + c0;
        ((GAS f32x4*)o)[0] = (f32x4){as[0], as[1], as[2], as[3]}; ((GAS f32x4*)o)[1] = (f32x4){as[4], as[5], as[6], as[7]}; o += ASZ;
        ((GAS f32x4*)o)[0] = (f32x4){wr[0], wr[1], wr[2], wr[3]}; ((GAS f32x4*)o)[1] = (f32x4){wr[4], wr[5], wr[6], wr[7]}; o += ASZ;
        ((GAS f32x4*)o)[0] = (f32x4){dec[0], dec[1], dec[2], dec[3]}; ((GAS f32x4*)o)[1] = (f32x4){dec[4], dec[5], dec[6], dec[7]}; o += ASZ;
        ((GAS f32x4*)o)[0] = (f32x4){bs[0], bs[1], bs[2], bs[3]}; ((GAS f32x4*)o)[1] = (f32x4){bs[4], bs[5], bs[6], bs[7]}; o += ASZ;
        ((GAS f32x4*)o)[0] = (f32x4){kp[0], kp[1], kp[2], kp[3]}; ((GAS f32x4*)o)[1] = (f32x4){kp[4], kp[5], kp[6], kp[7]};
        if ((lane & 7) == 0) ((GAS f32x4*)(SCAL + ((size_t)m * 8 + (lane >> 3)) * 4))[0] = (f32x4){br * 0.0625f, kr * 0.0625f, bon, 0.f};
    }
}

DI void post_phase(const Ptrs& P, int gw, int NGW, int lane) {
    unsigned char* ws = P.ws;
    bf16* OM = (bf16*)(ws + WS_OM);
    { const float* PO = (const float*)(ws + WS_PO); const float* PML = (const float*)(ws + WS_PML);
      for (int it = gw; it < DB * 64; it += NGW) { const int b = it >> 6, qr = it & 63;
          float mi[8], li[8]; float mx = -3.0e38f;
#pragma unroll
          for (int s = 0; s < 8; ++s) { const f32x2 ml = ((const GAS f32x2*)PML)[(size_t)(b * 8 + s) * 64 + qr]; mi[s] = ml.x; li[s] = ml.y; mx = fmaxf(mx, ml.x); }
          float L = 0.f; f32x2 acc = {0.f, 0.f};
#pragma unroll
          for (int s = 0; s < 8; ++s) { const float w = __builtin_amdgcn_exp2f(mi[s] - mx); L += li[s] * w;
              const f32x2 o = ((const GAS f32x2*)(PO + ((size_t)(b * 8 + s) * 64 + qr) * 128))[lane]; acc += o * w; }
          const float inv = 1.f / L; const int tq = qr >> 3, hd = qr & 7;
          ((GAS unsigned*)(OM + (size_t)(MP + b * 8 + tq) * 1536 + hd * 128))[lane] = pk2(acc.x * inv, acc.y * inv); } }
    { const float* Y = (const float*)(ws + WS_Y); const float* RKV = (const float*)(ws + WS_RKV); const float* LO = (const float*)(ws + WS_LO); const float* SCAL = (const float*)(ws + WS_SCAL);
      const int c0 = lane * 8; float lg[8], lb[8];
#pragma unroll
      for (int j = 0; j < 8; ++j) { lg[j] = P.in[27][c0 + j]; lb[j] = P.in[28][c0 + j]; }
      const float* PROJ = (const float*)(ws + WS_PROJ); const f32x4 muv0 = ((const GAS f32x4*)(P.in[18] + 1024 + c0))[0], muv1 = ((const GAS f32x4*)(P.in[18] + 1024 + c0))[1];
      for (int m = gw; m < M; m += NGW) {
          float y[8], v[8], g[8];
          { const GAS f32x4* p = (const GAS f32x4*)(Y + (size_t)m * RWD + c0); const f32x4 a = p[0], b = p[1]; y[0]=a.x; y[1]=a.y; y[2]=a.z; y[3]=a.w; y[4]=b.x; y[5]=b.y; y[6]=b.z; y[7]=b.w; }
          if (m >= MP) { const GAS f32x4* p = (const GAS f32x4*)(RKV + (size_t)m * 1536 + 1024 + c0); const f32x4 a = p[0], b = p[1]; v[0]=a.x; v[1]=a.y; v[2]=a.z; v[3]=a.w; v[4]=b.x; v[5]=b.y; v[6]=b.z; v[7]=b.w; }
          else { const GAS f32x4* p = (const GAS f32x4*)(PROJ + (size_t)m * INP + (INC - RWC) + 1024 + c0); f32x4 a = p[0], b = p[1];
              f32x4 pa = {0.f, 0.f, 0.f, 0.f}, pb = pa; if ((m & (SEQ - 1)) != 0) { const GAS f32x4* pp = (const GAS f32x4*)(PROJ + (size_t)(m - 1) * INP + (INC - RWC) + 1024 + c0); pa = pp[0]; pb = pp[1]; }
              a = a + (pa - a) * muv0; b = b + (pb - b) * muv1; v[0]=a.x; v[1]=a.y; v[2]=a.z; v[3]=a.w; v[4]=b.x; v[5]=b.y; v[6]=b.z; v[7]=b.w; }
          { const GAS f32x4* p = (const GAS f32x4*)(LO + (size_t)m * 1536 + 1024 + c0); const f32x4 a = p[0], b = p[1]; g[0]=a.x; g[1]=a.y; g[2]=a.z; g[3]=a.w; g[4]=b.x; g[5]=b.y; g[6]=b.z; g[7]=b.w; }
          const float bon = SCAL[((size_t)m * 8 + (lane >> 3)) * 4 + 2];
          float s = 0.f;
#pragma unroll
          for (int j = 0; j < 8; ++j) s += y[j];
          const float mean = red8(s) * (1.f / 64.f); float q = 0.f;
#pragma unroll
          for (int j = 0; j < 8; ++j) { y[j] -= mean; q += y[j] * y[j]; }
          const float rstd = 1.f / sqrtf(red8(q) * (1.f / 64.f) + GN_EPS);
          float o[8];
#pragma unroll
          for (int j = 0; j < 8; ++j) o[j] = (y[j] * rstd * lg[j] + lb[j] + bon * v[j]) * g[j];
          *(GAS v4u*)(OM + (size_t)m * 1536 + 1024 + c0) = (v4u){pk2(o[0], o[1]), pk2(o[2], o[3]), pk2(o[4], o[5]), pk2(o[6], o[7])};
      } }
}
namespace cs {
typedef float f4 __attribute__((ext_vector_type(4)));
DI unsigned cvtpk(float lo, float hi) { typedef float f2 __attribute__((ext_vector_type(2))); typedef __bf16 b2 __attribute__((ext_vector_type(2))); f2 v = {lo, hi}; b2 b = __builtin_convertvector(v, b2); return __builtin_bit_cast(unsigned, b); }
DI unsigned short cvt1(float x) { return (unsigned short)(cvtpk(x, 0.f) & 0xffffu); }
DI float wsum64(float v) {
    { auto rr = __builtin_amdgcn_permlane32_swap(__float_as_uint(v), __float_as_uint(v), false, false); v = __uint_as_float(rr[0]) + __uint_as_float(rr[1]); }
    v += __builtin_bit_cast(float, __builtin_amdgcn_update_dpp(0, __builtin_bit_cast(int, v), 0x128, 0xf, 0xf, false));
    v += __builtin_bit_cast(float, __builtin_amdgcn_update_dpp(0, __builtin_bit_cast(int, v), 0x124, 0xf, 0xf, false));
    v += __builtin_bit_cast(float, __builtin_amdgcn_update_dpp(0, __builtin_bit_cast(int, v), 0x122, 0xf, 0xf, false));
    v += __builtin_bit_cast(float, __builtin_amdgcn_update_dpp(0, __builtin_bit_cast(int, v), 0x121, 0xf, 0xf, false));
    return __builtin_bit_cast(float, __builtin_amdgcn_readlane(__builtin_bit_cast(int, v), 0)) + __builtin_bit_cast(float, __builtin_amdgcn_readlane(__builtin_bit_cast(int, v), 16));
}
#define CS_MFMA(a, b, c) __builtin_amdgcn_mfma_f32_16x16x32_bf16((a), (b), (c), 0, 0, 0)
#define CS_LWAIT() asm volatile("s_waitcnt lgkmcnt(0)" ::: "memory")
constexpr int NCHUNK = SEQ / 16, NTASK = NB * 8 * NCHUNK;
constexpr int OPS_TASK = 10 * 1024;
constexpr int L_AT = 0, L_RT = 2048, L_BT = 4096, L_KT = 6144, L_BH = 8192, L_KH = 10240, L_AB = 12288, L_AK = 13312, L_RB = 14336, L_RK = 15360;

DI void chunk_prep(const float* PROJ, const float* mu, const float* LO, const float* pw0, const float* pa0, const float* pkk, const float* pka, const float* prk, float* SCAL, unsigned char* OPS, float* G15, LAS unsigned char* lds, int gw, int NGW, int wave, int lane) {
    LAS unsigned char* base = lds + wave * 16384;
    const int d = lane, x = lane & 15, q = lane >> 4;
    for (int task = gw; task < NTASK; task += NGW) {
        const int chain = task / NCHUNK, c = task - chain * NCHUNK, bb = chain >> 3, hd = chain & 7;
        const size_t m0 = (size_t)bb * SEQ + (size_t)c * 16;
        float a[16], b[16], k[16], r[16]; float g = 1.f;
        {
            const int ch = hd * 64 + d;
            const float w0v = ((const GAS float*)pw0)[ch], a0v = ((const GAS float*)pa0)[ch], kkv = ((const GAS float*)pkk)[ch], kav = ((const GAS float*)pka)[ch], rkv = ((const GAS float*)prk)[ch];
            const float mur = ((const GAS float*)mu)[ch], muk = ((const GAS float*)mu)[512 + ch];
            float w[16], wl[16], al[16];
            { const GAS float* pj = (const GAS float*)PROJ + m0 * INP + (INC - RWC) + ch;
              float pr_ = 0.f, pk_ = 0.f; if (c != 0) { pr_ = *(pj - INP); pk_ = *(pj - INP + 512); }
#pragma unroll
              for (int t = 0; t < 16; ++t) { const float xr = pj[(size_t)t * INP], xk = pj[(size_t)t * INP + 512]; r[t] = xr + (pr_ - xr) * mur; k[t] = xk + (pk_ - xk) * muk; pr_ = xr; pk_ = xk; } }
#pragma unroll
            for (int t = 0; t < 16; ++t) { const size_t o = (m0 + t) * 1536 + ch; wl[t] = ((const GAS float*)LO)[o]; al[t] = ((const GAS float*)LO)[o + 512]; }
#pragma unroll
            for (int t = 0; t < 16; ++t) {
                const float z = -(w0v + wl[t]); const float sp = fmaxf(z, 0.f) + __logf(1.f + __expf(-fabsf(z)));
                w[t] = __expf(-__expf(-sp - 0.5f));
                const float av = __builtin_amdgcn_rcpf(1.f + __expf(-(a0v + al[t])));
                const float kx = k[t] * kkv; const float nn = wsum64(kx * kx); const float kn = kx * __builtin_amdgcn_rsqf(fmaxf(nn, 1e-24f));
                const float kp = k[t] * (1.f + (av - 1.f) * kav);
                const float bon = wsum64(r[t] * kp * rkv);
                if (lane == 0) ((GAS float*)SCAL)[((m0 + t) * 8 + hd) * 4 + 2] = bon;
                a[t] = -kn; b[t] = kn * av; k[t] = kp;
            }
#pragma unroll
            for (int t = 0; t < 16; ++t) { const float gm1 = g; g *= w[t]; const float inv = __builtin_amdgcn_rcpf(g); a[t] *= gm1; r[t] *= g; b[t] *= inv; k[t] *= inv; }
        }
        ((GAS float*)G15)[(size_t)task * 64 + d] = g;
#pragma unroll
        for (int t = 0; t < 16; ++t) {
            *(LAS unsigned short*)(base + L_AT + (t * 64 + d) * 2) = cvt1(a[t]); *(LAS unsigned short*)(base + L_RT + (t * 64 + d) * 2) = cvt1(r[t]);
            *(LAS unsigned short*)(base + L_BT + (t * 64 + d) * 2) = cvt1(b[t]); *(LAS unsigned short*)(base + L_KT + (t * 64 + d) * 2) = cvt1(k[t]); }
        { v4u h0, h1, k0, k1;
          h0.x = cvtpk(b[0] * g, b[1] * g); h0.y = cvtpk(b[2] * g, b[3] * g); h0.z = cvtpk(b[4] * g, b[5] * g); h0.w = cvtpk(b[6] * g, b[7] * g);
          h1.x = cvtpk(b[8] * g, b[9] * g); h1.y = cvtpk(b[10] * g, b[11] * g); h1.z = cvtpk(b[12] * g, b[13] * g); h1.w = cvtpk(b[14] * g, b[15] * g);
          k0.x = cvtpk(k[0] * g, k[1] * g); k0.y = cvtpk(k[2] * g, k[3] * g); k0.z = cvtpk(k[4] * g, k[5] * g); k0.w = cvtpk(k[6] * g, k[7] * g);
          k1.x = cvtpk(k[8] * g, k[9] * g); k1.y = cvtpk(k[10] * g, k[11] * g); k1.z = cvtpk(k[12] * g, k[13] * g); k1.w = cvtpk(k[14] * g, k[15] * g);
          *(LAS v4u*)(base + L_BH + d * 32) = h0; *(LAS v4u*)(base + L_BH + d * 32 + 16) = h1; *(LAS v4u*)(base + L_KH + d * 32) = k0; *(LAS v4u*)(base + L_KH + d * 32 + 16) = k1; }
        CS_LWAIT();
        { f4 gab = {0.f, 0.f, 0.f, 0.f}, gak = gab, grb = gab, grk = gab;
#pragma unroll
          for (int kb = 0; kb < 2; ++kb) { const int fo = (x * 64 + 32 * kb + 8 * q) * 2;
              const bf16x8 fa = *(const LAS bf16x8*)(base + L_AT + fo), fr = *(const LAS bf16x8*)(base + L_RT + fo), fb = *(const LAS bf16x8*)(base + L_BT + fo), fk = *(const LAS bf16x8*)(base + L_KT + fo);
              gab = CS_MFMA(fb, fa, gab); gak = CS_MFMA(fk, fa, gak); grb = CS_MFMA(fb, fr, grb); grk = CS_MFMA(fk, fr, grk); }
#pragma unroll
          for (int rr = 0; rr < 4; ++rr) { const int u = 4 * q + rr; if (!(u < x)) { gab[rr] = 0.f; gak[rr] = 0.f; } if (!(u <= x)) { grb[rr] = 0.f; grk[rr] = 0.f; } }
          const int go = (x * 16 + 4 * q) * 4;
          *(LAS f4*)(base + L_AB + go) = gab; *(LAS f4*)(base + L_AK + go) = gak; *(LAS f4*)(base + L_RB + go) = grb; *(LAS f4*)(base + L_RK + go) = grk; }
        CS_LWAIT();
        float mm[16];
#pragma unroll
        for (int t = 0; t < 16; ++t) mm[t] = *(const LAS float*)(base + L_AK + (t * 16 + x) * 4);
#pragma unroll
        for (int t = 1; t < 16; ++t) {
            float ab[16];
#pragma unroll
            for (int u4 = 0; u4 < 4; ++u4) if (4 * u4 < t) { const f4 v = *(const LAS f4*)(base + L_AB + (t * 16 + 4 * u4) * 4); ab[4 * u4] = v.x; ab[4 * u4 + 1] = v.y; ab[4 * u4 + 2] = v.z; ab[4 * u4 + 3] = v.w; }
#pragma unroll
            for (int u = 0; u < 16; ++u) if (u < t) { a[t] = fmaf(a[u], ab[u], a[t]); mm[t] = fmaf(mm[u], ab[u], mm[t]); }
        }
        CS_LWAIT();
#pragma unroll
        for (int t = 0; t < 16; ++t) { *(LAS unsigned short*)(base + L_AT + (t * 64 + d) * 2) = cvt1(a[t]); *(LAS float*)(base + L_AK + (t * 16 + x) * 4) = mm[t]; }
        CS_LWAIT();
        unsigned char* ob = OPS + (size_t)task * OPS_TASK + lane * 16;
#pragma unroll
        for (int kb = 0; kb < 2; ++kb) { const int fo = (x * 64 + 32 * kb + 4 * q) * 2;
            const v2u w0 = *(const LAS v2u*)(base + L_AT + fo), w1 = *(const LAS v2u*)(base + L_AT + fo + 32), r0 = *(const LAS v2u*)(base + L_RT + fo), r1 = *(const LAS v2u*)(base + L_RT + fo + 32);
            *(GAS v4u*)(ob + kb * 1024) = (v4u){w0.x, w0.y, w1.x, w1.y}; *(GAS v4u*)(ob + (3 + kb) * 1024) = (v4u){r0.x, r0.y, r1.x, r1.y}; }
        { const int go = (x * 16 + 4 * q) * 4; const f4 m2 = *(const LAS f4*)(base + L_AK + go), rb = *(const LAS f4*)(base + L_RB + go), rk = *(const LAS f4*)(base + L_RK + go);
          *(GAS v4u*)(ob + 2 * 1024) = (v4u){0u, 0u, cvtpk(m2.x, m2.y), cvtpk(m2.z, m2.w)};
          *(GAS v4u*)(ob + 5 * 1024) = (v4u){cvtpk(rb.x, rb.y), cvtpk(rb.z, rb.w), cvtpk(rk.x, rk.y), cvtpk(rk.z, rk.w)}; }
#pragma unroll
        for (int dt = 0; dt < 4; ++dt) { const int fo = ((16 * dt + x) * 16 + 4 * q) * 2; const v2u h = *(const LAS v2u*)(base + L_BH + fo), kk = *(const LAS v2u*)(base + L_KH + fo);
            *(GAS v4u*)(ob + (6 + dt) * 1024) = (v4u){h.x, h.y, kk.x, kk.y}; }
        CS_LWAIT();
    }
}

constexpr int CBUF = 16384, CNBUF = 5, C_YOFF = CNBUF * CBUF, C_YBUF = 16 * 64 * 4;
static_assert(C_YOFF + 2 * C_YBUF <= RING_BYTES, "chunked scan LDS map");
DI void cscan_item(LAS unsigned char* lds, const unsigned char* OPS, const float* G15, const float* PROJ, const float* mu, float* Y, float* fin, int chain, int tid, int wave, int lane) {
    const int bb = chain >> 3, hd = chain & 7, i = lane & 15, q = lane >> 4, rowbase = 16 * (wave & 3);
    const bool comp = wave < 4;
    const size_t m0 = (size_t)bb * SEQ, task0 = (size_t)chain * NCHUNK;
    const char* sp[2]; unsigned sstr[2];
#pragma unroll
    for (int k2 = 0; k2 < 2; ++k2) { int slot = wave + 8 * k2; if (slot == 15) slot = 0;
        if (slot < 10) { sp[k2] = (const char*)(OPS + (task0 * 10 + slot) * 1024 + lane * 16); sstr[k2] = OPS_TASK; }
        else if (slot == 10) { sp[k2] = (const char*)(G15 + task0 * 64) + (lane & 15) * 16; sstr[k2] = 256; }
        else { sp[k2] = (const char*)(PROJ + (m0 + 4 * (slot - 11) + (lane >> 4)) * INP + (INC - RWC) + 1024 + hd * 64) + (lane & 15) * 16; sstr[k2] = 16 * INP * 4; } }
    const float muv = ((const GAS float*)mu)[1024 + hd * 64 + rowbase + i];
#define CS_DMA(c) do { const int cn_ = min((c), NCHUNK - 1); LAS unsigned char* db_ = lds + ((c) % CNBUF) * CBUF + wave * 1024; _Pragma("unroll") for (int k2 = 0; k2 < 2; ++k2) \
        __builtin_amdgcn_global_load_lds((const GAS unsigned*)(sp[k2] + (size_t)cn_ * sstr[k2]), (LAS unsigned*)(db_ + k2 * 8192), 16, 0, 0); } while (0)
#define CS_FLUSH(cc) do { const int t_ = (tid - 256) >> 4, c4_ = (tid - 256) & 15; \
        *(GAS f4*)(Y + (m0 + (size_t)(cc) * 16 + t_) * RWD + hd * 64 + 4 * c4_) = *(const LAS f4*)(lds + C_YOFF + ((cc) & 1) * C_YBUF + (t_ * 64 + 4 * c4_) * 4); } while (0)
    CS_DMA(0); CS_DMA(1); CS_DMA(2);
    asm volatile("s_waitcnt vmcnt(4) lgkmcnt(0)" ::: "memory"); __builtin_amdgcn_s_barrier(); asm volatile("" ::: "memory");
    f4 sacc[4];
#pragma unroll
    for (int dt = 0; dt < 4; ++dt) sacc[dt] = (f4){0.f, 0.f, 0.f, 0.f};
    for (int c = 0; c < NCHUNK; ++c) {
        CS_DMA(c + 3);
        if (comp) {
            const LAS unsigned char* buf = lds + (c % CNBUF) * CBUF;
            const LAS unsigned char* fb = buf + lane * 16;
            bf16x8 sb0, sb1;
            { v4u w; w.x = cvtpk(sacc[0].x, sacc[0].y); w.y = cvtpk(sacc[0].z, sacc[0].w); w.z = cvtpk(sacc[1].x, sacc[1].y); w.w = cvtpk(sacc[1].z, sacc[1].w); sb0 = __builtin_bit_cast(bf16x8, w);
              w.x = cvtpk(sacc[2].x, sacc[2].y); w.y = cvtpk(sacc[2].z, sacc[2].w); w.z = cvtpk(sacc[3].x, sacc[3].y); w.w = cvtpk(sacc[3].z, sacc[3].w); sb1 = __builtin_bit_cast(bf16x8, w); }
            const LAS float* vp = (const LAS float*)(buf + 11 * 1024) + (4 * q) * 64 + rowbase + i;
            float vm1 = 0.f;
            if (q != 0) vm1 = vp[-64]; else if (c != 0) vm1 = ((const LAS float*)(lds + ((c + CNBUF - 1) % CNBUF) * CBUF + 11 * 1024))[15 * 64 + rowbase + i];
            const float x0 = vp[0], x1 = vp[64], x2 = vp[128], x3 = vp[192];
            const float v0 = x0 + (vm1 - x0) * muv, v1 = x1 + (x0 - x1) * muv, v2 = x2 + (x1 - x2) * muv, v3 = x3 + (x2 - x3) * muv;
            const unsigned vlo = cvtpk(v0, v1), vhi = cvtpk(v2, v3);
            const bf16x8 uv0 = __builtin_bit_cast(bf16x8, (v4u){0u, 0u, vlo, vhi});
            f4 u = {0.f, 0.f, 0.f, 0.f};
            u = CS_MFMA(*(const LAS bf16x8*)(fb), sb0, u); u = CS_MFMA(*(const LAS bf16x8*)(fb + 1024), sb1, u); u = CS_MFMA(*(const LAS bf16x8*)(fb + 2048), uv0, u);
            const bf16x8 uv = __builtin_bit_cast(bf16x8, (v4u){cvtpk(u.x, u.y), cvtpk(u.z, u.w), vlo, vhi});
            f4 y = {0.f, 0.f, 0.f, 0.f};
            y = CS_MFMA(*(const LAS bf16x8*)(fb + 3072), sb0, y); y = CS_MFMA(*(const LAS bf16x8*)(fb + 4096), sb1, y); y = CS_MFMA(*(const LAS bf16x8*)(fb + 5120), uv, y);
            LAS float* yb = (LAS float*)(lds + C_YOFF + (c & 1) * C_YBUF) + (4 * q) * 64 + rowbase + i;
            yb[0] = y.x; yb[64] = y.y; yb[128] = y.z; yb[192] = y.w;
#pragma unroll
            for (int dt = 0; dt < 4; ++dt) { const f4 gg = *(const LAS f4*)(buf + 10 * 1024 + (16 * dt + 4 * q) * 4); sacc[dt] = CS_MFMA(*(const LAS bf16x8*)(fb + (6 + dt) * 1024), uv, sacc[dt] * gg); }
            asm volatile("s_waitcnt vmcnt(4) lgkmcnt(0)" ::: "memory");
        } else {
            if (c >= 1) CS_FLUSH(c - 1);
            if (c == 0) asm volatile("s_waitcnt vmcnt(4) lgkmcnt(0)" ::: "memory"); else if (c == 1) asm volatile("s_waitcnt vmcnt(5) lgkmcnt(0)" ::: "memory"); else asm volatile("s_waitcnt vmcnt(6) lgkmcnt(0)" ::: "memory");
        }
        __builtin_amdgcn_s_barrier(); asm volatile("" ::: "memory");
    }
    if (!comp) CS_FLUSH(NCHUNK - 1);
    else {
        float* fo = fin + (size_t)chain * 4096 + (size_t)(rowbase + i) * 64 + 4 * q;
#pragma unroll
        for (int dt = 0; dt < 4; ++dt) *(GAS f4*)(fo + 16 * dt) = sacc[dt];
    }
#undef CS_DMA
#undef CS_FLUSH
    asm volatile("s_waitcnt vmcnt(0) lgkmcnt(0)" ::: "memory"); __builtin_amdgcn_s_barrier(); asm volatile("" ::: "memory");
}
}
namespace att {
constexpr int KSTEP_B = 1152, SUB_BYTES = 10 * KSTEP_B;
DI unsigned img_off(unsigned row, unsigned ch) { return (unsigned)KSTEP_B * (ch >> 1) + 32u * row + 16u * ((ch & 1u) ^ ((row >> 3) & 1u)); }
DI unsigned kvmap(unsigned r) { return (r & ~12u) | ((r & 4u) << 1) | ((r & 8u) >> 1); }
DI unsigned row_base(unsigned lane) { const unsigned kr = kvmap(lane & 31u), h = lane >> 5; return 32u * kr + 16u * (h ^ ((kr >> 3) & 1u)); }
DI unsigned tr_base(unsigned lane) { const unsigned h = lane >> 5, blk = (lane >> 4) & 1u, q = (lane & 15u) >> 2, p = lane & 3u;
    return (unsigned)KSTEP_B * blk + 32u * (8u * h + q) + 16u * ((p >> 1) ^ h) + 8u * (p & 1u); }
DI unsigned cvtpk(float lo, float hi) { typedef float f2 __attribute__((ext_vector_type(2))); typedef __bf16 b2 __attribute__((ext_vector_type(2))); f2 v = {lo, hi}; b2 b = __builtin_convertvector(v, b2); return __builtin_bit_cast(unsigned, b); }
DI s16x4 vtr(const LAS unsigned char* p) { typedef short v4i16_t __attribute__((ext_vector_type(4))); return __builtin_bit_cast(s16x4, __builtin_amdgcn_ds_read_tr16_b64_v4i16((LAS v4i16_t*)p)); }
#define ATT_MFMA(a, b, c) __builtin_amdgcn_mfma_f32_32x32x16_bf16((a), (b), (c), 0, 0, 0)

constexpr float DEFER_THR = 8.0f;
DI float xhalf_max(float v) { auto rr = __builtin_amdgcn_permlane32_swap(__float_as_uint(v), __float_as_uint(v), false, false); return fmaxf(__uint_as_float(rr[0]), __uint_as_float(rr[1])); }
DI float xhalf_sum(float v) { auto rr = __builtin_amdgcn_permlane32_swap(__float_as_uint(v), __float_as_uint(v), false, false); return __uint_as_float(rr[0]) + __uint_as_float(rr[1]); }
DI bf16x8 pack8(const f32x16& x, int s) { v4u w; w.x = cvtpk(x[8 * s], x[8 * s + 1]); w.y = cvtpk(x[8 * s + 2], x[8 * s + 3]); w.z = cvtpk(x[8 * s + 4], x[8 * s + 5]); w.w = cvtpk(x[8 * s + 6], x[8 * s + 7]); return __builtin_bit_cast(bf16x8, w); }

template <bool MASK>
DI void subtile(const LAS unsigned char* img, const bf16x8 (&qf)[10], float& mrun, float& lrun, f32x16 (&o)[4], int lane, int qlim) {
    __builtin_amdgcn_sched_barrier(0);
    const unsigned h = lane >> 5;
    const LAS unsigned char* rb = img + row_base(lane); const LAS unsigned char* tb = img + tr_base(lane);
    f32x16 x;
#pragma unroll
    for (int i = 0; i < 16; ++i) x[i] = 0.f;
#pragma unroll
    for (int s = 0; s < 10; ++s) { const bf16x8 a = *(const LAS bf16x8*)(rb + KSTEP_B * s); x = ATT_MFMA(a, qf[s], x); }
    if (MASK) {
#pragma unroll
        for (int i = 0; i < 16; ++i) { const int kv = 16 * (i >> 3) + 8 * (int)h + (i & 7); if (kv > qlim) x[i] = -1e30f; }
    }
    float mx = x[0];
#pragma unroll
    for (int i = 1; i < 16; ++i) mx = fmaxf(mx, x[i]);
    mx = xhalf_max(mx);
    if (!__all(mx - mrun <= DEFER_THR)) {
        const float mn = fmaxf(mrun, mx), corr = __builtin_amdgcn_exp2f(mrun - mn); mrun = mn; lrun *= corr;
#pragma unroll
        for (int d = 0; d < 4; ++d)
#pragma unroll
            for (int i = 0; i < 16; ++i) o[d][i] *= corr;
    }
    float ls = 0.f;
#pragma unroll
    for (int i = 0; i < 16; ++i) { x[i] = __builtin_amdgcn_exp2f(x[i] - mrun); ls += x[i]; }
    lrun += ls;
    const bf16x8 pb0 = pack8(x, 0), pb1 = pack8(x, 1);
#pragma unroll
    for (int d = 0; d < 4; ++d) {
        { const s16x4 lo = vtr(tb + 2 * KSTEP_B * d), hi = vtr(tb + 2 * KSTEP_B * d + 128); o[d] = ATT_MFMA(__builtin_shufflevector(lo, hi, 0, 1, 2, 3, 4, 5, 6, 7), pb0, o[d]); }
        { const s16x4 lo = vtr(tb + 2 * KSTEP_B * d + 512), hi = vtr(tb + 2 * KSTEP_B * d + 512 + 128); o[d] = ATT_MFMA(__builtin_shufflevector(lo, hi, 0, 1, 2, 3, 4, 5, 6, 7), pb1, o[d]); }
    }
}
DI void tile64(const LAS unsigned char* img, const bf16x8 (&qf)[10], float& mrun, float& lrun, f32x16 (&o)[4], int lane) {
    __builtin_amdgcn_sched_barrier(0);
    const LAS unsigned char* rb = img + row_base(lane); const LAS unsigned char* tb = img + tr_base(lane);
    f32x16 p0, p1;
#pragma unroll
    for (int i = 0; i < 16; ++i) { p0[i] = 0.f; p1[i] = 0.f; }
#pragma unroll
    for (int s = 0; s < 10; ++s) {
        const bf16x8 a0 = *(const LAS bf16x8*)(rb + KSTEP_B * s), a1 = *(const LAS bf16x8*)(rb + SUB_BYTES + KSTEP_B * s);
        p0 = ATT_MFMA(a0, qf[s], p0); p1 = ATT_MFMA(a1, qf[s], p1);
    }
    float mx = fmaxf(p0[0], p1[0]);
#pragma unroll
    for (int i = 1; i < 16; ++i) mx = fmaxf(mx, fmaxf(p0[i], p1[i]));
    mx = xhalf_max(mx);
    if (!__all(mx - mrun <= DEFER_THR)) {
        const float mn = fmaxf(mrun, mx), corr = __builtin_amdgcn_exp2f(mrun - mn); mrun = mn; lrun *= corr;
#pragma unroll
        for (int d = 0; d < 4; ++d)
#pragma unroll
            for (int i = 0; i < 16; ++i) o[d][i] *= corr;
    }
    float ls = 0.f;
#pragma unroll
    for (int i = 0; i < 16; ++i) { p0[i] = __builtin_amdgcn_exp2f(p0[i] - mrun); ls += p0[i]; }
    const bf16x8 pa = pack8(p0, 0), pb = pack8(p0, 1);
#pragma unroll
    for (int d = 0; d < 4; ++d) {
        { const s16x4 lo = vtr(tb + 2 * KSTEP_B * d), hi = vtr(tb + 2 * KSTEP_B * d + 128); o[d] = ATT_MFMA(__builtin_shufflevector(lo, hi, 0, 1, 2, 3, 4, 5, 6, 7), pa, o[d]); }
        { const s16x4 lo = vtr(tb + 2 * KSTEP_B * d + 512), hi = vtr(tb + 2 * KSTEP_B * d + 512 + 128); o[d] = ATT_MFMA(__builtin_shufflevector(lo, hi, 0, 1, 2, 3, 4, 5, 6, 7), pb, o[d]); }
    }
#pragma unroll
    for (int i = 0; i < 16; ++i) { p1[i] = __builtin_amdgcn_exp2f(p1[i] - mrun); ls += p1[i]; }
    lrun += ls;
    const bf16x8 pc = pack8(p1, 0), pd = pack8(p1, 1);
#pragma unroll
    for (int d = 0; d < 4; ++d) {
        { const s16x4 lo = vtr(tb + SUB_BYTES + 2 * KSTEP_B * d), hi = vtr(tb + SUB_BYTES + 2 * KSTEP_B * d + 128); o[d] = ATT_MFMA(__builtin_shufflevector(lo, hi, 0, 1, 2, 3, 4, 5, 6, 7), pc, o[d]); }
        { const s16x4 lo = vtr(tb + SUB_BYTES + 2 * KSTEP_B * d + 512), hi = vtr(tb + SUB_BYTES + 2 * KSTEP_B * d + 512 + 128); o[d] = ATT_MFMA(__builtin_shufflevector(lo, hi, 0, 1, 2, 3, 4, 5, 6, 7), pd, o[d]); }
    }
}

DI void prompt_unit(LAS unsigned char* lds, const bf16* QB, const bf16* CKVB, const bf16* KRB, bf16* OM, int b, int qblk, int tid, int wave, int lane) {
    const int r = lane & 31, h = lane >> 5;
    const int row0 = b * SEQ + qblk * 32, kb = b * SEQ;
    bf16x8 qf[10];
    { const bf16* qp = QB + (size_t)(row0 + r) * 1280 + wave * 160 + 8 * h;
#pragma unroll
      for (int s = 0; s < 10; ++s) qf[s] = *(const GAS bf16x8*)(qp + 16 * s); }
    f32x16 o[4];
#pragma unroll
    for (int d = 0; d < 4; ++d)
#pragma unroll
        for (int i = 0; i < 16; ++i) o[d][i] = 0.f;
    float mrun = -1e30f, lrun = 0.f;
    const int nsub = qblk + 1, ntile = (nsub + 1) >> 1;
    const int lrow0 = tid >> 4, lch = tid & 15, lrow1 = lrow0 + 32;
    const unsigned ld0 = (unsigned)(lrow0 >> 5) * SUB_BYTES + img_off(lrow0 & 31, lch), ld1 = (unsigned)(lrow1 >> 5) * SUB_BYTES + img_off(lrow1 & 31, lch);
    const int rrow = tid >> 2, rc = tid & 3; const unsigned rd = (unsigned)(rrow >> 5) * SUB_BYTES + img_off(rrow & 31, 16 + rc);
    const bf16* g0 = CKVB + (size_t)(kb + lrow0) * KVR + lch * 8; const bf16* g1 = CKVB + (size_t)(kb + lrow1) * KVR + lch * 8; const bf16* g2 = KRB + (size_t)(kb + rrow) * RD + rc * 8;
    v4u s0 = *(const GAS v4u*)g0, s1 = *(const GAS v4u*)g1, s2 = (tid < 256) ? *(const GAS v4u*)g2 : (v4u){0u, 0u, 0u, 0u};
    *(LAS v4u*)(lds + ld0) = s0; *(LAS v4u*)(lds + ld1) = s1; if (tid < 256) *(LAS v4u*)(lds + rd) = s2;
    __syncthreads();
    const int nfull = qblk >> 1;
#define PU_LOAD(tn) do { const size_t adv = (size_t)(tn) * 64; s0 = *(const GAS v4u*)(g0 + adv * KVR); s1 = *(const GAS v4u*)(g1 + adv * KVR); if (tid < 256) s2 = *(const GAS v4u*)(g2 + adv * RD); } while (0)
#define PU_WRITE(par) do { LAS unsigned char* nb = lds + (par) * (2 * SUB_BYTES); *(LAS v4u*)(nb + ld0) = s0; *(LAS v4u*)(nb + ld1) = s1; if (tid < 256) *(LAS v4u*)(nb + rd) = s2; } while (0)
    for (int t = 0; t < nfull; ++t) {
        PU_LOAD(t + 1);
        const LAS unsigned char* img = lds + (t & 1) * (2 * SUB_BYTES);
        tile64(img, qf, mrun, lrun, o, lane);
        PU_WRITE((t + 1) & 1); __syncthreads();
    }
    { const LAS unsigned char* img = lds + (nfull & 1) * (2 * SUB_BYTES);
      if (qblk & 1) { subtile<false>(img, qf, mrun, lrun, o, lane, 0); img += SUB_BYTES; }
      subtile<true>(img, qf, mrun, lrun, o, lane, r);
      __syncthreads(); }
#undef PU_LOAD
#undef PU_WRITE
    const float inv = 1.f / xhalf_sum(lrun);
    bf16* op = OM + (size_t)(row0 + r) * 1536 + wave * 128 + 4 * h;
#pragma unroll
    for (int d = 0; d < 4; ++d)
#pragma unroll
        for (int g = 0; g < 4; ++g)
            *(GAS v2u*)(op + 32 * d + 8 * g) = (v2u){pk2(o[d][4 * g] * inv, o[d][4 * g + 1] * inv), pk2(o[d][4 * g + 2] * inv, o[d][4 * g + 3] * inv)};
}

DI void sample_unit(LAS unsigned char* lds, const bf16* QB, const bf16* CKVB, const bf16* KRB, const float* cckv, const float* ckr, const int* ptab, float* PO, float* PML,
                    int b, int sp, int tid, int wave, int lane) {
    const int r = lane & 31, h = lane >> 5, qt = wave & 1, ks = wave >> 1;
    const int qr = 32 * qt + r, tq = qr >> 3, hd = qr & 7;
    bf16x8 qf[10];
    { const bf16* qp = QB + (size_t)(MP + b * DS + tq) * 1280 + hd * 160 + 8 * h;
#pragma unroll
      for (int s = 0; s < 10; ++s) qf[s] = *(const GAS bf16x8*)(qp + 16 * s); }
    f32x16 o[4];
#pragma unroll
    for (int d = 0; d < 4; ++d)
#pragma unroll
        for (int i = 0; i < 16; ++i) o[d][i] = 0.f;
    float mrun = -1e30f, lrun = 0.f;
    constexpr int PBUF = 4 * SUB_BYTES;
    unsigned ldl[4];
#pragma unroll
    for (int i = 0; i < 4; ++i) { const int row = (tid >> 4) + 32 * i; ldl[i] = (unsigned)(row >> 5) * SUB_BYTES + img_off(row & 31, tid & 15); }
    const int rrow = tid >> 2; const unsigned ldr = (unsigned)(rrow >> 5) * SUB_BYTES + img_off(rrow & 31, 16 + (tid & 3));
    const int* pt = ptab + b * NPAGE + sp * 64;
    f32x4 sl[8], sr[2];
    { const int pg = pt[0]; const float* pl = cckv + (size_t)pg * (PAGE * KVR) + (size_t)(tid >> 4) * KVR + (tid & 15) * 8; const float* prp = ckr + (size_t)pg * (PAGE * RD) + (size_t)rrow * RD + (tid & 3) * 4;
#pragma unroll
      for (int i = 0; i < 4; ++i) { sl[2 * i] = *(const GAS f32x4*)(pl + (size_t)i * 32 * KVR); sl[2 * i + 1] = *(const GAS f32x4*)(pl + (size_t)i * 32 * KVR + 4); }
      sr[0] = *(const GAS f32x4*)prp; sr[1] = *(const GAS f32x4*)(prp + 16); }
#define SAMP_WRITE(buf) do { _Pragma("unroll") for (int i = 0; i < 4; ++i) *(LAS v4u*)((buf) + ldl[i]) = (v4u){cvtpk(sl[2*i].x, sl[2*i].y), cvtpk(sl[2*i].z, sl[2*i].w), cvtpk(sl[2*i+1].x, sl[2*i+1].y), cvtpk(sl[2*i+1].z, sl[2*i+1].w)}; \
        *(LAS v4u*)((buf) + ldr) = (v4u){cvtpk(sr[0].x, sr[1].x), cvtpk(sr[0].y, sr[1].y), cvtpk(sr[0].z, sr[1].z), cvtpk(sr[0].w, sr[1].w)}; } while (0)
    SAMP_WRITE(lds);
    __syncthreads();
    for (int p = 0; p < 64; ++p) {
        const bool more = p + 1 < 64;
        if (more) { const int pg = pt[p + 1]; const float* pl = cckv + (size_t)pg * (PAGE * KVR) + (size_t)(tid >> 4) * KVR + (tid & 15) * 8; const float* prp = ckr + (size_t)pg * (PAGE * RD) + (size_t)rrow * RD + (tid & 3) * 4;
#pragma unroll
            for (int i = 0; i < 4; ++i) { sl[2 * i] = *(const GAS f32x4*)(pl + (size_t)i * 32 * KVR); sl[2 * i + 1] = *(const GAS f32x4*)(pl + (size_t)i * 32 * KVR + 4); }
            sr[0] = *(const GAS f32x4*)prp; sr[1] = *(const GAS f32x4*)(prp + 16); }
        subtile<false>(lds + (p & 1) * PBUF + ks * SUB_BYTES, qf, mrun, lrun, o, lane, 0);
        if (more) { LAS unsigned char* nb = lds + ((p + 1) & 1) * PBUF; SAMP_WRITE(nb); }
        __syncthreads();
    }
#undef SAMP_WRITE
    if (sp == 0) {
        LAS unsigned char* nb = lds;
        { const int row = tid >> 4, ch = tid & 15; v4u v = {0u, 0u, 0u, 0u}; if (row < DS) v = *(const GAS v4u*)(CKVB + (size_t)(MP + b * DS + row) * KVR + ch * 8); *(LAS v4u*)(nb + img_off(row, ch)) = v; }
        if (tid < 128) { const int row = tid >> 2, c = tid & 3; v4u v = {0u, 0u, 0u, 0u}; if (row < DS) v = *(const GAS v4u*)(KRB + (size_t)(MP + b * DS + row) * RD + c * 8); *(LAS v4u*)(nb + img_off(row, 16 + c)) = v; }
        __syncthreads();
        if (ks == 0) subtile<true>(nb, qf, mrun, lrun, o, lane, tq);
        __syncthreads();
    }
    const float lt = xhalf_sum(lrun);
    const int idx = b * 8 + sp * 4 + ks;
    if (h == 0) ((GAS f32x2*)PML)[(size_t)idx * 64 + qr] = (f32x2){mrun, lt};
    float* op = PO + ((size_t)idx * 64 + qr) * 128 + 4 * h;
#pragma unroll
    for (int d = 0; d < 4; ++d)
#pragma unroll
        for (int g = 0; g < 4; ++g) *(GAS f32x4*)(op + 32 * d + 8 * g) = (f32x4){o[d][4 * g], o[d][4 * g + 1], o[d][4 * g + 2], o[d][4 * g + 3]};
}
}

DI float rowsum16(float v) {
    v += __builtin_bit_cast(float, __builtin_amdgcn_update_dpp(0, __builtin_bit_cast(int, v), 0x128, 0xf, 0xf, false));
    v += __builtin_bit_cast(float, __builtin_amdgcn_update_dpp(0, __builtin_bit_cast(int, v), 0x124, 0xf, 0xf, false));
    v += __builtin_bit_cast(float, __builtin_amdgcn_update_dpp(0, __builtin_bit_cast(int, v), 0x122, 0xf, 0xf, false));
    v += __builtin_bit_cast(float, __builtin_amdgcn_update_dpp(0, __builtin_bit_cast(int, v), 0x121, 0xf, 0xf, false));
    return v;
}
constexpr int SCAN_STRIDE = 340, SCAN_CHUNK = 16, SCAN_PIECES = 85, SCAN_NBUF = 5, SCAN_AHEAD = 3;
constexpr int SCAN_BUF = 1536 * 16, SCAN_YOFF = SCAN_NBUF * SCAN_BUF, SCAN_YBUF = SCAN_CHUNK * 16 * 4;
static_assert(SCAN_YOFF + 2 * SCAN_YBUF <= RING_BYTES && SCAN_CHUNK * SCAN_PIECES <= 1536, "scan LDS map");
DI float dot4(const f32x4& x, const f32x4& y) { return fmaf(x.y, y.y, x.x * y.x) + fmaf(x.w, y.w, x.z * y.z); }
template <int VAR> DI void scan_item(LAS unsigned char* lds, const float* SC5, const float* RKV, const float* SCAL, float* Y, const float* init, float* fin, int m0, int T, int hd, int quarter, int tid, int wave, int lane) {
    constexpr size_t ASZ = (size_t)M * RWD;
    const int j = lane & 15, rowl = (wave & 3) * 4 + (lane >> 4), row = quarter * 16 + rowl;
    const bool isA = wave < 4;
    const int nchunk = (T + SCAN_CHUNK - 1) / SCAN_CHUNK, nst0 = min(SCAN_CHUNK, T);
    const char* sp[3]; unsigned sstr[3];
#pragma unroll
    for (int i = 0; i < 3; ++i) { int q = tid + 512 * i; if (q >= nst0 * SCAN_PIECES) q = 0;
        const int st = q / SCAN_PIECES, pc = q - st * SCAN_PIECES; const size_t mm = (size_t)(m0 + st); const float* src;
        if (pc < 80) { src = SC5 + (size_t)(pc >> 4) * ASZ + mm * RWD + hd * 64 + (pc & 15) * 4; sstr[i] = SCAN_CHUNK * RWD * 4; }
        else if (pc < 84) { src = RKV + mm * 1536 + 1024 + hd * 64 + quarter * 16 + (pc - 80) * 4; sstr[i] = SCAN_CHUNK * 1536 * 4; }
        else { src = SCAL + (mm * 8 + hd) * 4; sstr[i] = SCAN_CHUNK * 32 * 4; }
        sp[i] = (const char*)src; }
#define SCAN_DMA(c) do { const int cn_ = min((c), nchunk - 1); LAS unsigned char* db_ = lds + ((c) % SCAN_NBUF) * SCAN_BUF + wave * 1024; _Pragma("unroll") for (int i = 0; i < 3; ++i) \
        __builtin_amdgcn_global_load_lds((const GAS unsigned*)(sp[i] + (size_t)cn_ * sstr[i]), (LAS unsigned*)(db_ + i * 8192), 16, 0, 0); } while (0)
#define SCAN_WAIT_BAR() do { asm volatile("s_waitcnt vmcnt(3) lgkmcnt(0)" ::: "memory"); __builtin_amdgcn_s_barrier(); asm volatile("" ::: "memory"); } while (0)
    SCAN_DMA(0); SCAN_DMA(1); SCAN_DMA(2);
    asm volatile("s_waitcnt vmcnt(3) lgkmcnt(0)" ::: "memory"); __builtin_amdgcn_s_barrier(); asm volatile("" ::: "memory");
    f32x4 s = (f32x4){0.f, 0.f, 0.f, 0.f}, t, bq; float sa = 0.f, P1 = 0.f, P2 = 0.f, ypv = 0.f, br16 = 0.f;
    f32x4 cw, ck, cwr, cb4, ca; float cvv = 0.f; f32x2 csc;
#define SCAN_OP(g, off) (*(const LAS f32x4*)(lds + (((g) >> 4) % SCAN_NBUF) * SCAN_BUF + ((g) & 15) * (SCAN_STRIDE * 4) + (off) * 4 + 16 * j))
    if (isA) {
        if (init) s = *(const GAS f32x4*)(init + (size_t)row * 64 + 4 * j);
        const f32x4 a0 = SCAN_OP(0, 0), wr0 = SCAN_OP(0, 64), w0 = SCAN_OP(0, 128), b0 = SCAN_OP(0, 192), k0 = SCAN_OP(0, 256), a1 = SCAN_OP(1, 0);
        const LAS float* m0p = (const LAS float*)lds; const float vv0 = m0p[320 + rowl]; const f32x2 sc0 = *(const LAS f32x2*)(m0p + 336);
        sa = rowsum16(dot4(s, a0));
        t = s * w0 + k0 * vv0; bq = b0;
        P2 = dot4(t, a1); P1 = dot4(b0, a1);
        ypv = fmaf(vv0, sc0.y, dot4(s, wr0)); br16 = sc0.x;
        cw = SCAN_OP(1, 128); ck = SCAN_OP(1, 256); cwr = SCAN_OP(1, 64); cb4 = SCAN_OP(1, 192); ca = SCAN_OP(2, 0);
        { const LAS float* p1 = (const LAS float*)(lds + SCAN_STRIDE * 4); cvv = p1[320 + rowl]; csc = *(const LAS f32x2*)(p1 + 336); }
    }
    for (int c = 0; c < nchunk; ++c) {
        SCAN_DMA(c + SCAN_AHEAD);
        if (!isA && c >= 1) {
            const int cc = c - 1, t_ = tid - 256, st = t_ >> 4, r16 = t_ & 15;
            if (st < min(SCAN_CHUNK, T - cc * SCAN_CHUNK))
                Y[(size_t)(m0 + cc * SCAN_CHUNK + st) * RWD + hd * 64 + quarter * 16 + r16] = *(const LAS float*)(lds + SCAN_YOFF + (cc & 1) * SCAN_YBUF + (st * 16 + r16) * 4);
        }
        if (isA) {
            const int nst = min(SCAN_CHUNK, T - c * SCAN_CHUNK);
            const LAS unsigned char* b0p = lds + (c % SCAN_NBUF) * SCAN_BUF + 16 * j; const LAS unsigned char* b1p = lds + ((c + 1) % SCAN_NBUF) * SCAN_BUF + 16 * j;
            LAS float* yb = (LAS float*)(lds + SCAN_YOFF + (c & 1) * SCAN_YBUF) + rowl;
#pragma unroll
            for (int st = 0; st < SCAN_CHUNK; ++st) {
                if (st >= nst) break;
                const LAS unsigned char* q2 = (st + 2 < SCAN_CHUNK ? b0p + (st + 2) * (SCAN_STRIDE * 4) : b1p + (st + 2 - SCAN_CHUNK) * (SCAN_STRIDE * 4));
                const LAS unsigned char* q3 = (st + 3 < SCAN_CHUNK ? b0p + (st + 3) * (SCAN_STRIDE * 4) : b1p + (st + 3 - SCAN_CHUNK) * (SCAN_STRIDE * 4));
                const f32x4 nw = *(const LAS f32x4*)(q2 + 512), nk = *(const LAS f32x4*)(q2 + 1024), nwr = *(const LAS f32x4*)(q2 + 256), nb4 = *(const LAS f32x4*)(q2 + 768), na = *(const LAS f32x4*)(q3);
                const float nvv = *(const LAS float*)(q2 - 16 * j + (320 + rowl) * 4); const f32x2 nsc = *(const LAS f32x2*)(q2 - 16 * j + 336 * 4);
                float part = fmaf(sa, P1, P2);
                float yp = fmaf(sa, br16, ypv);
                s = bq * sa + t;
                if (VAR == 3) { part *= 0.99f; yp *= 0.99f; } else if (VAR == 2) { part = rowsum16(part); yp *= 0.99f; } else { part = rowsum16(part); yp = rowsum16(yp); }
                yb[st * 16] = yp;
                t = s * cw + ck * cvv; bq = cb4;
                P2 = dot4(t, ca); P1 = dot4(cb4, ca);
                ypv = fmaf(cvv, csc.y, dot4(s, cwr)); br16 = csc.x;
                sa = part;
                cw = nw; ck = nk; cwr = nwr; cb4 = nb4; ca = na; cvv = nvv; csc = nsc;
            }
        }
        if (isA || c == 0) asm volatile("s_waitcnt vmcnt(3) lgkmcnt(0)" ::: "memory"); else if (c == 1) asm volatile("s_waitcnt vmcnt(4) lgkmcnt(0)" ::: "memory"); else asm volatile("s_waitcnt vmcnt(5) lgkmcnt(0)" ::: "memory");
        __builtin_amdgcn_s_barrier(); asm volatile("" ::: "memory");
    }
    if (!isA) { const int cc = nchunk - 1, t_ = tid - 256, st = t_ >> 4, r16 = t_ & 15;
        if (st < min(SCAN_CHUNK, T - cc * SCAN_CHUNK))
            Y[(size_t)(m0 + cc * SCAN_CHUNK + st) * RWD + hd * 64 + quarter * 16 + r16] = *(const LAS float*)(lds + SCAN_YOFF + (cc & 1) * SCAN_YBUF + (st * 16 + r16) * 4); }
#undef SCAN_DMA
#undef SCAN_WAIT_BAR
#undef SCAN_OP
    if (isA) *(GAS f32x4*)(fin + (size_t)row * 64 + 4 * j) = s;
    asm volatile("s_waitcnt vmcnt(0) lgkmcnt(0)" ::: "memory"); __builtin_amdgcn_s_barrier(); asm volatile("" ::: "memory");
}

constexpr int Q_PSCAN = 32, Q_SATT = 256, Q_PATT = 1024, Q_SSCAN = 4096, Q_TOTAL = Q_PSCAN + Q_SATT + Q_PATT + Q_SSCAN;
template <int MODE, int VAR> DI void mixer_phase(const Ptrs& P, LAS unsigned char* lds, volatile LAS unsigned* MISC, gu32* ctl, int tid, int wave, int lane) {
    unsigned char* ws = P.ws;
    const bf16* QB = (const bf16*)(ws + WS_QB); const bf16* CKVB = (const bf16*)(ws + WS_CKVB); const bf16* KRB = (const bf16*)(ws + WS_KRB); bf16* OM = (bf16*)(ws + WS_OM);
    const float* SC5 = (const float*)(ws + WS_SC5); const float* RKV = (const float*)(ws + WS_RKV); const float* SCAL = (const float*)(ws + WS_SCAL); float* Y = (float*)(ws + WS_Y);
#define Q_POP() do { if (tid == 0) MISC[0] = __hip_atomic_fetch_add(ctl + CW_QHEAD, 1u, RLX_AGENT); __syncthreads(); it = (int)MISC[0]; __syncthreads(); it = __builtin_amdgcn_readfirstlane(it); } while (0)
    int it; Q_POP();
#ifndef MK_SKIP_PSCAN
    if (MODE == 0 || MODE == 1)
    while (it < Q_PSCAN) {
        if (VAR == 0) cs::cscan_item(lds, ws + WS_OPS, (const float*)(ws + WS_G15), (const float*)(ws + WS_PROJ), P.in[18], Y, P.out + O_WKVP, it, tid, wave, lane);
        else cs::cscan_item(lds, ws + WS_OPS, (const float*)(ws + WS_G15), (const float*)(ws + WS_PROJ), P.in[18], (float*)(ws + WS_END), (float*)(ws + WS_END + 80 * MiB), it, tid, wave, lane);
        Q_POP(); }
#endif
    if (MODE == 2 || MODE == 3) { while (it < Q_PSCAN) Q_POP(); }
    if (MODE == 3) { while (it < Q_PSCAN + Q_SATT) Q_POP(); }
#ifndef MK_SKIP_SATT
    if (MODE == 0 || MODE == 2)
    while (it < Q_PSCAN + Q_SATT) {
        const int u = it - Q_PSCAN; att::sample_unit(lds, QB, CKVB, KRB, P.in[2], P.in[3], (const int*)P.in[6], (float*)(ws + WS_PO), (float*)(ws + WS_PML), u >> 1, u & 1, tid, wave, lane);
        Q_POP(); }
#endif
#ifndef MK_SKIP_PATT
    if (MODE == 0 || MODE == 3)
    while (it < Q_PSCAN + Q_SATT + Q_PATT) {
        const int u = it - Q_PSCAN - Q_SATT; att::prompt_unit(lds, QB, CKVB, KRB, OM, u & 3, 255 - (u >> 2), tid, wave, lane);
        Q_POP(); }
#endif
#ifndef MK_SKIP_SSCAN
    if (MODE == 0)
    while (it < Q_TOTAL) {
        const int u = it - Q_PSCAN - Q_SATT - Q_PATT, ch = u >> 2, qtr = u & 3, b = ch >> 3, hd = ch & 7;
        scan_item<0>(lds, SC5, RKV, SCAL, Y, P.in[4] + (size_t)ch * 4096, P.out + O_WKVS + (size_t)ch * 4096, MP + b * DS, DS, hd, qtr, tid, wave, lane);
        Q_POP(); }
#endif
#undef Q_POP
}
constexpr int N_PHASES = 15;
#ifndef MK_REP_MIX
#define MK_REP_MIX 1
#endif
#ifndef MK_DUP_PH
#define MK_DUP_PH -1
#endif
#define DUP_PH(k, ...) do { if (MK_DUP_PH == (k)) { xcd_barrier(bar); __VA_ARGS__ } } while (0)
#ifndef MK_DUP_VAR
#define MK_DUP_VAR 0
#endif
#ifndef MK_DUP_MODE
#define MK_DUP_MODE 0
#endif
#ifndef MK_REP_EW
#define MK_REP_EW 1
#endif
#ifndef MK_REP_GEMM
#define MK_REP_GEMM 1
#endif
#define DUP_1(...)
#define DUP_2(...) xcd_barrier(bar); __VA_ARGS__
#define DUP_CAT(a, b) a##b
#define DUP_SEL(n) DUP_CAT(DUP_, n)

__global__ void __launch_bounds__(NWAVES * 64, 2) mk_fwd(Args args) {
    extern __shared__ __attribute__((aligned(16))) unsigned char lds_raw[];
    LAS unsigned char* lds = (LAS unsigned char*)lds_raw;
    volatile LAS unsigned* MISC = (volatile LAS unsigned*)(lds + MISC_OFF);
    const int tid = threadIdx.x, lane = tid & 63, wave = __builtin_amdgcn_readfirstlane(tid >> 6);
    const int G = gridDim.x, bx = blockIdx.x;
    const int gw = bx * NWAVES + wave, NGW = G * NWAVES;
    unsigned char* ws = args.ws;
#define P (*args_here())
    gu32* ctl = (gu32*)(ws + WS_CTL);
    for (int u = tid; u < (LDS_BYTES - LDSCTL_OFF) / 4; u += NWAVES * 64) ((LAS unsigned*)(lds + LDSCTL_OFF))[u] = 0u;
    __syncthreads();
    const int lo = args.ph_lo, hi = args.ph_hi;
    const bool one_launch = (hi - lo) > 1;
    XcdBarrier bar; bar.bar = (unsigned*)(ctl + CW_BAR); bar.x = 0; bar.st = nullptr;
    if (one_launch) bar = xcd_barrier_post((unsigned*)(ctl + CW_BAR), MISC + 8);
#ifndef MK_ONLY
#define MK_ONLY -1
#endif
#define IN(k) ((MK_ONLY < 0 || (k) == MK_ONLY) && lo <= (k) && (k) < hi)
#define SEAM(k) do { if (IN(k) && IN((k) + 1)) xcd_barrier(bar); } while (0)
    bf16* XNB = (bf16*)(ws + WS_XNB); bf16* HB = (bf16*)(ws + WS_HB); float* Z = (float*)(ws + WS_Z); float* X1 = (float*)(ws + WS_X1); float* X2 = (float*)(ws + WS_X2);
    const float* cosT = (const float*)(ws + WS_ROPE); const float* sinT = cosT + ROPE_N * 16;

    if (IN(0)) { p0_prologue(P, lds, gw, NGW, wave, lane); SEAM(0); }
#define PH1_BODY do {    \
        pg8::Gemm g{XNB, (const bf16*)(ws + WS_WGUA), M, 2 * FF, DM}; pg8::StaticOrder S; S.init(M, 2 * FF, G, bx); \
        pg8::EpiSwiGLU E{HB, FF}; \
        pg8::gemm_phase<pg8::EpiSwiGLU, pg8::StaticOrder, true, true>(lds + RING_OFF, g, S, E); } while (0)
    if (IN(1)) { PH1_BODY; DUP_PH(1, PH1_BODY;); DUP_SEL(MK_REP_GEMM)(PH1_BODY;) SEAM(1); }
#define SPLIT_BODY(Aop, Wop, KFULL) do { int k256 = 256; asm volatile("" : "+s"(k256)); \
        pg8::Gemm g{Aop, Wop, M, DM, k256, KFULL}; pg8::SplitOrder S; S.init(MS / 256, DM / 256, (KFULL) / 256, MP / 256, G, bx); \
        pg8::EpiPart E{(float*)(ws + WS_PART), DM, MP, (size_t)MS * DM}; \
        pg8::gemm_phase<pg8::EpiPart, pg8::SplitOrder, true, true>(lds + RING_OFF, g, S, E); } while (0)
#define PH2_BODY do {    \
        { pg8::Gemm g{HB, (const bf16*)(ws + WS_WDA), MP, DM, FF, 0}; pg8::StaticOrder S; S.init(MP, DM, G, bx); \
          pg8::EpiResid E{P.in[0], P.in[0], MP, Z, DM, ALPHA, 0.5f}; \
          pg8::gemm_phase<pg8::EpiResid, pg8::StaticOrder, true, true>(lds + RING_OFF, g, S, E); } \
        SPLIT_BODY(HB, (const bf16*)(ws + WS_WDA), FF); } while (0)
    if (IN(2)) { PH2_BODY; DUP_PH(2, PH2_BODY;); DUP_SEL(MK_REP_GEMM)(PH2_BODY;) SEAM(2); }
#define PH3_BODY do { ln_phase(Z, P.in[7], P.in[8], X1, XNB, (const float*)(ws + WS_PART), FF / 256, P.in[1], ALPHA, 0.5f, gw, NGW, lane); } while (0)
    if (IN(3)) { PH3_BODY; DUP_PH(3, PH3_BODY;); DUP_SEL(MK_REP_EW)(PH3_BODY;) SEAM(3); }
#define PH4_BODY do {    \
        pg8::Gemm g{XNB, (const bf16*)(ws + WS_WIN), M, INP, DM}; pg8::StaticOrder S; S.init(M, INP, G, bx); \
        pg8::EpiF32 E{(float*)(ws + WS_PROJ), INP}; \
        pg8::gemm_phase<pg8::EpiF32, pg8::StaticOrder, true, true>(lds + RING_OFF, g, S, E); } while (0)
    if (IN(4)) { PH4_BODY; DUP_PH(4, PH4_BODY;); DUP_SEL(MK_REP_GEMM)(PH4_BODY;) SEAM(4); }
#define PH5_BODY do { prep_a(P, gw, NGW, lane); } while (0)
    if (IN(5)) { PH5_BODY; DUP_PH(5, PH5_BODY;); DUP_SEL(MK_REP_EW)(PH5_BODY;) SEAM(5); }
#define PH6_BODY do {    \
        int k256 = 256; asm volatile("" : "+s"(k256));           \
        { pg8::Gemm g{(const bf16*)(ws + WS_CQN), (const bf16*)(ws + WS_WQ), M, 1280, k256}; pg8::StaticOrder S; S.init(M, 1280, G, bx); \
          pg8::EpiQ E{(bf16*)(ws + WS_QB), cosT, sinT, QSCALE}; \
          pg8::gemm_phase<pg8::EpiQ, pg8::StaticOrder, true, true>(lds + RING_OFF, g, S, E); } \
        { pg8::Gemm g{(const bf16*)(ws + WS_LA), (const bf16*)(ws + WS_WL), M, 1536, k256}; pg8::StaticOrder S; S.init(M, 1536, G, bx); \
          pg8::EpiF32 E{(float*)(ws + WS_LO), 1536}; \
          pg8::gemm_phase<pg8::EpiF32, pg8::StaticOrder, true, true>(lds + RING_OFF, g, S, E); } \
        } while (0)
    if (IN(6)) { PH6_BODY; DUP_PH(6, PH6_BODY;); DUP_SEL(MK_REP_GEMM)(PH6_BODY;) SEAM(6); }
#define PH7_BODY do { prep_c(P, gw, NGW, lane); cs::chunk_prep((const float*)(ws + WS_PROJ), P.in[18], (const float*)(ws + WS_LO), P.in[19], P.in[21], P.in[24], P.in[25], P.in[26], (float*)(ws + WS_SCAL), ws + WS_OPS, (float*)(ws + WS_G15), lds, gw, NGW, wave, lane); } while (0)
    if (IN(7)) { PH7_BODY; DUP_PH(7, PH7_BODY;); DUP_SEL(MK_REP_EW)(PH7_BODY;) SEAM(7); }
    if (IN(8)) { mixer_phase<0, 0>(P, lds, MISC, ctl, tid, wave, lane); DUP_SEL(MK_REP_MIX)(mixer_phase<MK_DUP_MODE, MK_DUP_VAR>(P, lds, MISC, ctl + 64, tid, wave, lane);) SEAM(8); }
#define PH9_BODY do { post_phase(P, gw, NGW, lane); } while (0)
    if (IN(9)) { PH9_BODY; DUP_PH(9, PH9_BODY;); DUP_SEL(MK_REP_EW)(PH9_BODY;) SEAM(9); }
#define PH10_BODY do {   \
        { pg8::Gemm g{(const bf16*)(ws + WS_OM), (const bf16*)(ws + WS_WO), MP, DM, 1536, 0}; pg8::StaticOrder S; S.init(MP, DM, G, bx); \
          pg8::EpiResid E{X1, X1, M, Z, DM, ALPHA, 1.0f}; \
          pg8::gemm_phase<pg8::EpiResid, pg8::StaticOrder, true, true>(lds + RING_OFF, g, S, E); } \
        SPLIT_BODY((const bf16*)(ws + WS_OM), (const bf16*)(ws + WS_WO), 1536); } while (0)
    if (IN(10)) { PH10_BODY; DUP_PH(10, PH10_BODY;); DUP_SEL(MK_REP_GEMM)(PH10_BODY;) SEAM(10); }
#define PH11_BODY do { ln_phase(Z, P.in[30], P.in[31], X2, XNB, (const float*)(ws + WS_PART), 1536 / 256, X1 + (size_t)MP * DM, ALPHA, 1.0f, gw, NGW, lane); } while (0)
    if (IN(11)) { PH11_BODY; DUP_PH(11, PH11_BODY;); DUP_SEL(MK_REP_EW)(PH11_BODY;) SEAM(11); }
#define PH12_BODY do {   \
        pg8::Gemm g{XNB, (const bf16*)(ws + WS_WGUB), M, 2 * FF, DM}; pg8::StaticOrder S; S.init(M, 2 * FF, G, bx); \
        pg8::EpiSwiGLU E{HB, FF}; \
        pg8::gemm_phase<pg8::EpiSwiGLU, pg8::StaticOrder, true, true>(lds + RING_OFF, g, S, E); } while (0)
    if (IN(12)) { PH12_BODY; DUP_PH(12, PH12_BODY;); DUP_SEL(MK_REP_GEMM)(PH12_BODY;) SEAM(12); }
#define PH13_BODY do {   \
        { pg8::Gemm g{HB, (const bf16*)(ws + WS_WDB), MP, DM, FF, 0}; pg8::StaticOrder S; S.init(MP, DM, G, bx); \
          pg8::EpiResid E{X2, X2, M, Z, DM, ALPHA, 0.5f}; \
          pg8::gemm_phase<pg8::EpiResid, pg8::StaticOrder, true, true>(lds + RING_OFF, g, S, E); } \
        SPLIT_BODY(HB, (const bf16*)(ws + WS_WDB), FF); } while (0)
    if (IN(13)) { PH13_BODY; DUP_PH(13, PH13_BODY;); DUP_SEL(MK_REP_GEMM)(PH13_BODY;) SEAM(13); }
#define PH14_BODY do { ln_phase(Z, P.in[35], P.in[36], P.out + O_YP, nullptr, (const float*)(ws + WS_PART), FF / 256, X2 + (size_t)MP * DM, ALPHA, 0.5f, gw, NGW, lane); } while (0)
    if (IN(14)) { PH14_BODY; DUP_PH(14, PH14_BODY;); DUP_SEL(MK_REP_EW)(PH14_BODY;) }
#undef IN
#undef SEAM
#undef P
}

#ifndef MK_PER_PHASE
#define MK_PER_PHASE 0
#endif
extern "C" void kernel_launch(void* const* d_in, const int* in_sizes, int n_in, void* d_out, int out_size, void* d_ws, size_t ws_size, hipStream_t stream) {
    static int grid = 0;
    if (grid == 0) {
        if (n_in != 37 || (size_t)out_size != O_END || ws_size < WS_END) { fprintf(stderr, "kernel_launch: unexpected shapes: n_in %d out %d ws %zu\n", n_in, out_size, ws_size); grid = -1; return; }
        int dev = 0, cus = 0, per_cu = 0;
        if (hipGetDevice(&dev) != hipSuccess || hipDeviceGetAttribute(&cus, hipDeviceAttributeMultiprocessorCount, dev) != hipSuccess) { grid = -1; return; }
        if (hipFuncSetAttribute((const void*)mk_fwd, hipFuncAttributeMaxDynamicSharedMemorySize, LDS_BYTES) != hipSuccess) { fprintf(stderr, "kernel_launch: hipFuncSetAttribute failed\n"); grid = -1; return; }
        if (hipOccupancyMaxActiveBlocksPerMultiprocessor(&per_cu, (const void*)mk_fwd, NWAVES * 64, LDS_BYTES) != hipSuccess || per_cu < 1) { fprintf(stderr, "kernel_launch: occupancy query says %d\n", per_cu); }
        (void)hipGetLastError();
        grid = cus;
    }
    if (grid < 0) return;
    if (hipMemsetAsync((char*)d_ws + WS_CTL, 0, CTL_ZERO_BYTES, stream) != hipSuccess) return;
    Args a{};
    for (int i = 0; i < 37; ++i) a.in[i] = (const float*)d_in[i];
    a.out = (float*)d_out; a.ws = (unsigned char*)d_ws;
#if MK_PER_PHASE
    for (int p = 0; p < N_PHASES; ++p) { a.ph_lo = p; a.ph_hi = p + 1; hipLaunchKernelGGL(mk_fwd, dim3(grid), dim3(NWAVES * 64), LDS_BYTES, stream, a); }
#else
    a.ph_lo = 0; a.ph_hi = N_PHASES;
    hipLaunchKernelGGL(mk_fwd, dim3(grid), dim3(NWAVES * 64), LDS_BYTES, stream, a);
#endif
    const hipError_t le = hipPeekAtLastError();
    if (le != hipSuccess) fprintf(stderr, "kernel_launch: launch failed: %s\n", hipGetErrorName(le));
}
```

```cpp
#include <hip/hip_runtime.h>
#include <cstdio>
#include <cstdint>
namespace pg8 {
#define PG8_LAS __attribute__((address_space(3)))
typedef unsigned short bf16_t;
typedef short bf16x8 __attribute__((ext_vector_type(8)));
typedef float f32x4 __attribute__((ext_vector_type(4)));
typedef unsigned u32x4 __attribute__((ext_vector_type(4)));
constexpr int BM = 256, BK = 64, HALF = 128, HTB = HALF * BK * 2  , STAGE_BYTES = 8 * HTB, NXCD = 8, WGM = 8;

__host__ __device__ __forceinline__ int lds_byte(int r, int c) { const int st = (r >> 4) * 2 + (c >> 5), rr = r & 15, cc = c & 31, ob = rr * 64 + cc * 2; return st * 1024 + (ob ^ (((ob >> 9) & 1) << 5)); }
__host__ __device__ __forceinline__ void stage_rc(int b, int& R, int& C) { const int st = b / 1024, sb = b % 1024, swz = sb ^ (((sb >> 9) & 1) << 5); R = (st >> 1) * 16 + swz / 64; C = (st & 1) * 32 + (swz % 64) / 2; }
__host__ __device__ __forceinline__ int perm32(int rho) { const int n = rho >> 4, i = rho & 15; return 8 * (i >> 2) + 4 * n + (i & 3); }

struct Unit { int pm, pn, pk; };
struct Gemm { const bf16_t* A; const bf16_t* Bt; int M, N, K, ld; };

struct StaticOrder {
    int nM, nN, nwg, G, c;
    __host__ __device__ void init(int M, int N, int G_, int c_) { nM = M / BM; nN = N / BM; nwg = nM * nN; G = G_; c = c_; }
    __host__ __device__ bool next(int i, Unit& u) const {
        const long L = (long)i * G + c; if (L >= nwg) return false;
        int wgid = (int)L; { const int q = nwg / NXCD, r = nwg % NXCD, xcd = wgid % NXCD, off = wgid / NXCD; wgid = (xcd < r ? xcd * (q + 1) : r * (q + 1) + (xcd - r) * q) + off; }
        const int nig = WGM * nN, gid = wgid / nig, fm = gid * WGM, gsz = (nM - fm) < WGM ? (nM - fm) : WGM;
        u.pm = fm + ((wgid % nig) % gsz); u.pn = (wgid % nig) / gsz; u.pk = 0; return true;
    }
    __device__ __forceinline__ void a_ready(const Unit&) const {}
    __device__ __forceinline__ void done(const Unit&) const {}
};
struct SplitOrder {
    int nM, nN, nK, pm0, G, c;
    __host__ __device__ void init(int nM_, int nN_, int nK_, int pm0_, int G_, int c_) { nM = nM_; nN = nN_; nK = nK_; pm0 = pm0_; G = G_; c = c_; }
    __host__ __device__ bool next(int i, Unit& u) const {
        const int L = i * G + c; if (L >= nM * nN * nK) return false;
        const int per = nM * nN, r = L % per; u.pk = L / per; u.pm = pm0 + r / nN; u.pn = r % nN; return true;
    }
    __device__ __forceinline__ void a_ready(const Unit&) const {}
    __device__ __forceinline__ void done(const Unit&) const {}
};
__device__ __forceinline__ unsigned cvt_pk_bf16(float lo, float hi) { unsigned r; asm volatile("v_cvt_pk_bf16_f32 %0, %1, %2" : "=v"(r) : "v"(lo), "v"(hi)); return r; }
__device__ __forceinline__ float silu_mul(float g, float u) { const float e = __builtin_amdgcn_exp2f(-1.4426950408889634f * g); return g * __builtin_amdgcn_rcpf(1.0f + e) * u; }

struct EpiSwiGLU {
    static constexpr bool PERM = true, AFTER_DRAIN = false;
    bf16_t* O; int ldo;
    __device__ __forceinline__ void operator()(const f32x4 (&acc)[2][2][4][2], const Unit& u, int wr, int wc, int fr, int fq) const {
        const int row0 = u.pm * BM + wr * 64 + fr, col0 = u.pn * HALF + wc * 32 + 8 * fq;
#pragma unroll
        for (int ai = 0; ai < 2; ++ai)
#pragma unroll
            for (int m = 0; m < 4; ++m) {
                bf16_t* rowp = O + (size_t)(row0 + ai * HALF + m * 16) * ldo + col0;
                const f32x4 g0 = acc[ai][0][m][0], g1 = acc[ai][0][m][1], u0 = acc[ai][1][m][0], u1 = acc[ai][1][m][1];
                u32x4 w;
                w.x = cvt_pk_bf16(silu_mul(g0[0], u0[0]), silu_mul(g0[1], u0[1])); w.y = cvt_pk_bf16(silu_mul(g0[2], u0[2]), silu_mul(g0[3], u0[3]));
                w.z = cvt_pk_bf16(silu_mul(g1[0], u1[0]), silu_mul(g1[1], u1[1])); w.w = cvt_pk_bf16(silu_mul(g1[2], u1[2]), silu_mul(g1[3], u1[3]));
                *(u32x4*)rowp = w;
            }
    }
};
struct EpiResid {
    static constexpr bool PERM = false, AFTER_DRAIN = false;
    const float* base0; const float* base1; int split; float* Z; int ldc; float alpha, sc;
    __device__ __forceinline__ void operator()(const f32x4 (&acc)[2][2][4][2], const Unit& u, int wr, int wc, int fr, int fq) const {
        const int row0 = u.pm * BM + wr * 64 + fr, col0 = u.pn * BM + wc * 32 + 4 * fq;
        const float* bp = (u.pm * BM < split) ? base0 : base1 - (size_t)split * ldc;
#pragma unroll
        for (int ai = 0; ai < 2; ++ai)
#pragma unroll
            for (int m = 0; m < 4; ++m) {
                const size_t off = (size_t)(row0 + ai * HALF + m * 16) * ldc + col0;
#pragma unroll
                for (int bj = 0; bj < 2; ++bj)
#pragma unroll
                    for (int n = 0; n < 2; ++n) { const size_t o = off + bj * HALF + n * 16; const f32x4 b = *(const f32x4*)(bp + o); *(f32x4*)(Z + o) = b * alpha + acc[ai][bj][m][n] * sc; }
            }
    }
};
struct EpiResidB {
    static constexpr bool PERM = false, AFTER_DRAIN = false;
    const bf16_t* base; float* Z; int ldc; float alpha, sc;
    __device__ __forceinline__ void operator()(const f32x4 (&acc)[2][2][4][2], const Unit& u, int wr, int wc, int fr, int fq) const {
        typedef unsigned u32x2 __attribute__((ext_vector_type(2)));
        const int row0 = u.pm * BM + wr * 64 + fr, col0 = u.pn * BM + wc * 32 + 4 * fq;
#pragma unroll
        for (int ai = 0; ai < 2; ++ai)
#pragma unroll
            for (int m = 0; m < 4; ++m) {
                const size_t off = (size_t)(row0 + ai * HALF + m * 16) * ldc + col0;
#pragma unroll
                for (int bj = 0; bj < 2; ++bj)
#pragma unroll
                    for (int n = 0; n < 2; ++n) { const size_t o = off + bj * HALF + n * 16; const u32x2 w = *(const u32x2*)(base + o);
                        const f32x4 b = {__builtin_bit_cast(float, w.x << 16), __builtin_bit_cast(float, w.x & 0xffff0000u), __builtin_bit_cast(float, w.y << 16), __builtin_bit_cast(float, w.y & 0xffff0000u)};
                        *(f32x4*)(Z + o) = b * alpha + acc[ai][bj][m][n] * sc; }
            }
    }
};
struct EpiF32 {
    static constexpr bool PERM = false, AFTER_DRAIN = false;
    float* O; int ldc;
    __device__ __forceinline__ void operator()(const f32x4 (&acc)[2][2][4][2], const Unit& u, int wr, int wc, int fr, int fq) const {
        const int row0 = u.pm * BM + wr * 64 + fr, col0 = u.pn * BM + wc * 32 + 4 * fq;
#pragma unroll
        for (int ai = 0; ai < 2; ++ai)
#pragma unroll
            for (int m = 0; m < 4; ++m) {
                const size_t off = (size_t)(row0 + ai * HALF + m * 16) * ldc + col0;
#pragma unroll
                for (int bj = 0; bj < 2; ++bj)
#pragma unroll
                    for (int n = 0; n < 2; ++n) *(f32x4*)(O + off + bj * HALF + n * 16) = acc[ai][bj][m][n];
            }
    }
};
struct EpiPart {
    static constexpr bool PERM = false, AFTER_DRAIN = false;
    float* O; int ldc; int row0; size_t pstride;
    __device__ __forceinline__ void operator()(const f32x4 (&acc)[2][2][4][2], const Unit& u, int wr, int wc, int fr, int fq) const {
        const int rowb = u.pm * BM - row0 + wr * 64 + fr, col0 = u.pn * BM + wc * 32 + 4 * fq; float* Ob = O + (size_t)u.pk * pstride;
#pragma unroll
        for (int ai = 0; ai < 2; ++ai)
#pragma unroll
            for (int m = 0; m < 4; ++m) {
                const size_t off = (size_t)(rowb + ai * HALF + m * 16) * ldc + col0;
#pragma unroll
                for (int bj = 0; bj < 2; ++bj)
#pragma unroll
                    for (int n = 0; n < 2; ++n) *(f32x4*)(Ob + off + bj * HALF + n * 16) = acc[ai][bj][m][n];
            }
    }
};
struct EpiQ {
    static constexpr bool PERM = true, AFTER_DRAIN = false;
    bf16_t* Q; const float* cosT; const float* sinT; float qscale;
    __device__ __forceinline__ void operator()(const f32x4 (&acc)[2][2][4][2], const Unit& u, int wr, int wc, int fr, int fq) const {
        const int row0 = u.pm * BM + wr * 64 + fr;
        if (u.pn < 4) {
#pragma unroll
            for (int ai = 0; ai < 2; ++ai)
#pragma unroll
                for (int m = 0; m < 4; ++m) {
                    const int row = row0 + ai * HALF + m * 16;
#pragma unroll
                    for (int bj = 0; bj < 2; ++bj) {
                        bf16_t* p = Q + (size_t)row * 1280 + (2 * u.pn + bj) * 160 + wc * 32 + 8 * fq;
                        const f32x4 v0 = acc[ai][bj][m][0] * qscale, v1 = acc[ai][bj][m][1] * qscale;
                        u32x4 w; w.x = cvt_pk_bf16(v0[0], v0[1]); w.y = cvt_pk_bf16(v0[2], v0[3]); w.z = cvt_pk_bf16(v1[0], v1[1]); w.w = cvt_pk_bf16(v1[2], v1[3]);
                        *(u32x4*)p = w;
                    }
                }
        } else {
#pragma unroll
            for (int ai = 0; ai < 2; ++ai)
#pragma unroll
                for (int m = 0; m < 4; ++m) {
                    const int row = row0 + ai * HALF + m * 16;
                    const int tix = row < 32768 ? (row & 8191) : 8192 + ((row - 32768) & 7);
                    const f32x4 c = *(const f32x4*)(cosT + tix * 16 + 4 * fq), s = *(const f32x4*)(sinT + tix * 16 + 4 * fq);
#pragma unroll
                    for (int bj = 0; bj < 2; ++bj) {
                        bf16_t* p = Q + (size_t)row * 1280 + (4 * bj + wc) * 160 + 128 + 8 * fq;
                        const f32x4 v0 = acc[ai][bj][m][0], v1 = acc[ai][bj][m][1];
                        u32x4 w;
                        w.x = cvt_pk_bf16((v0[0] * c[0] - v0[1] * s[0]) * qscale, (v0[0] * s[0] + v0[1] * c[0]) * qscale);
                        w.y = cvt_pk_bf16((v0[2] * c[1] - v0[3] * s[1]) * qscale, (v0[2] * s[1] + v0[3] * c[1]) * qscale);
                        w.z = cvt_pk_bf16((v1[0] * c[2] - v1[1] * s[2]) * qscale, (v1[0] * s[2] + v1[1] * c[2]) * qscale);
                        w.w = cvt_pk_bf16((v1[2] * c[3] - v1[3] * s[3]) * qscale, (v1[2] * s[3] + v1[3] * c[3]) * qscale);
                        *(u32x4*)p = w;
                    }
                }
        }
    }
};
template <class Epi, class Sched, bool ALIGN_EPI = false, bool SP2 = false>
__device__ __forceinline__ void gemm_phase(PG8_LAS unsigned char* lds, const Gemm g, const Sched& S, const Epi& E) {
    int tid_ = threadIdx.x; asm volatile("" : "+v"(tid_));
    const int tid = tid_, wid = __builtin_amdgcn_readfirstlane(tid >> 6), lane = tid & 63, wr = wid >> 2, wc = wid & 3, fr = lane & 15, fq = lane >> 4;
    const int K = g.K, LD = g.ld ? g.ld : g.K, nt = K / BK;
    unsigned voffA[2], voffB[2];
#pragma unroll
    for (int i = 0; i < 2; ++i) { int R, C; stage_rc(tid * 16 + i * 8192, R, C); const int Rb = Epi::PERM ? ((R & ~31) + perm32(R & 31)) : R;
        voffA[i] = (unsigned)(R * LD + C) * 2u; voffB[i] = (unsigned)(Rb * LD + C) * 2u; }
    const size_t kstep = (size_t)(BK * 2);
    const size_t hstep = (size_t)HALF * LD * 2;
    const size_t tstep = 2 * hstep;
    const unsigned ldsw = (unsigned)wid * 1024u;
    const int aoff = lds_byte(wr * 64 + fr, fq * 8), boff = lds_byte(wc * 32 + fr, fq * 8);
#define PG8_SA(b, h) (((b) * 2 + (h)) * HTB)
#define PG8_SB(b, h) ((4 + (b) * 2 + (h)) * HTB)
#define PG8_STAGE(bufoff, gbase, voff) do { _Pragma("unroll") for (int _i = 0; _i < 2; ++_i) \
        __builtin_amdgcn_global_load_lds((const unsigned*)((const char*)(gbase) + (voff)[_i]), (PG8_LAS unsigned*)(lds + (bufoff) + ldsw + _i * 8192), 16, 0, 0); } while (0)
#define PG8_LDA(dst, b, h) do { _Pragma("unroll") for (int m = 0; m < 4; ++m) _Pragma("unroll") for (int k = 0; k < 2; ++k) dst[m][k] = *(const PG8_LAS bf16x8*)(lds + PG8_SA(b, h) + aoff + m * 2048 + k * 1024); } while (0)
#define PG8_LDB(dst, b, h) do { _Pragma("unroll") for (int n = 0; n < 2; ++n) _Pragma("unroll") for (int k = 0; k < 2; ++k) dst[n][k] = *(const PG8_LAS bf16x8*)(lds + PG8_SB(b, h) + boff + n * 2048 + k * 1024); } while (0)
#define PG8_MMA(ai, bj, At, Bt) do { __builtin_amdgcn_s_setprio(1); _Pragma("unroll") for (int m = 0; m < 4; ++m) _Pragma("unroll") for (int n = 0; n < 2; ++n) _Pragma("unroll") for (int k = 0; k < 2; ++k) \
        acc[ai][bj][m][n] = __builtin_amdgcn_mfma_f32_16x16x32_bf16(Bt[n][k], At[m][k], acc[ai][bj][m][n], 0, 0, 0); __builtin_amdgcn_s_setprio(0); } while (0)
#define PG8_WAIT_V(n) asm volatile("s_waitcnt vmcnt(" #n ")" ::: "memory")
#define PG8_WAIT_L(n) asm volatile("s_waitcnt lgkmcnt(" #n ")" ::: "memory")
#define PG8_BAR __builtin_amdgcn_s_barrier()
#define PG8_SCHED __builtin_amdgcn_sched_barrier(0)
    Unit cur, nxt; int ui = 0;
    if (!S.next(0, cur)) return;
    f32x4 acc[2][2][4][2];
#pragma unroll
    for (int a = 0; a < 2; ++a)
#pragma unroll
        for (int b = 0; b < 2; ++b)
#pragma unroll
            for (int m = 0; m < 4; ++m)
#pragma unroll
                for (int n = 0; n < 2; ++n) acc[a][b][m][n] = (f32x4){0.f, 0.f, 0.f, 0.f};
    bf16x8 At[4][2], B0[2][2], B1[2][2];
    const size_t sstep = (size_t)K * 2;
    const char* cA = (const char*)g.A + (size_t)cur.pm * tstep + (size_t)cur.pk * sstep; const char* cB = (const char*)g.Bt + (size_t)cur.pn * tstep + (size_t)cur.pk * sstep;
    S.a_ready(cur);
    if constexpr (SP2) {
        PG8_STAGE(PG8_SB(0, 0), cB, voffB); PG8_STAGE(PG8_SB(0, 1), cB + hstep, voffB); PG8_STAGE(PG8_SA(0, 0), cA, voffA); PG8_STAGE(PG8_SA(0, 1), cA + hstep, voffA);
        if (wr == 1) PG8_BAR;
        PG8_WAIT_V(2); PG8_BAR;
        PG8_STAGE(PG8_SB(1, 0), cB + kstep, voffB); PG8_STAGE(PG8_SA(1, 0), cA + kstep, voffA); PG8_STAGE(PG8_SB(1, 1), cB + hstep + kstep, voffB);
        PG8_WAIT_V(6); PG8_BAR;
    } else {
        PG8_STAGE(PG8_SB(0, 0), cB, voffB); PG8_STAGE(PG8_SA(0, 0), cA, voffA); PG8_STAGE(PG8_SB(0, 1), cB + hstep, voffB); PG8_STAGE(PG8_SA(0, 1), cA + hstep, voffA);
        if (wr == 1) PG8_BAR;
        PG8_WAIT_V(4); PG8_BAR;
        PG8_STAGE(PG8_SB(1, 0), cB + kstep, voffB); PG8_STAGE(PG8_SA(1, 0), cA + kstep, voffA); PG8_STAGE(PG8_SB(1, 1), cB + hstep + kstep, voffB);
        PG8_WAIT_V(6); PG8_BAR;
    }
    for (;;) {
        const bool has_next = S.next(ui + 1, nxt);
        const char* nA = has_next ? (const char*)g.A + (size_t)nxt.pm * tstep + (size_t)nxt.pk * sstep : cA; const char* nB = has_next ? (const char*)g.Bt + (size_t)nxt.pn * tstep + (size_t)nxt.pk * sstep : cB;
        for (int t = 0; t < nt; t += 2) {
            const bool last = (t == nt - 2);
            const char* a1 = cA + (size_t)(t + 1) * kstep;
            const char* a2 = last ? nA : cA + (size_t)(t + 2) * kstep; const char* b2 = last ? nB : cB + (size_t)(t + 2) * kstep;
            const char* a3 = a2 + kstep; const char* b3 = b2 + kstep;
            if (last && has_next) S.a_ready(nxt);
            if constexpr (SP2) {
            PG8_LDB(B0, 0, 0); PG8_LDB(B1, 0, 1); PG8_SCHED; PG8_LDA(At, 0, 0); PG8_STAGE(PG8_SA(1, 1), a1 + hstep, voffA);
            PG8_WAIT_V(8); PG8_WAIT_L(0); PG8_BAR; PG8_MMA(0, 0, At, B0); PG8_MMA(0, 1, At, B1); PG8_BAR; PG8_SCHED;
            PG8_LDA(At, 0, 1); PG8_STAGE(PG8_SB(0, 0), b2, voffB); PG8_STAGE(PG8_SB(0, 1), b2 + hstep, voffB); PG8_STAGE(PG8_SA(0, 0), a2, voffA);
            PG8_WAIT_V(8); PG8_WAIT_L(0); PG8_BAR; PG8_MMA(1, 0, At, B0); PG8_MMA(1, 1, At, B1); PG8_BAR; PG8_SCHED;
            PG8_LDB(B0, 1, 0); PG8_LDB(B1, 1, 1); PG8_SCHED; PG8_LDA(At, 1, 0); PG8_STAGE(PG8_SA(0, 1), a2 + hstep, voffA);
            PG8_WAIT_V(8); PG8_WAIT_L(0); PG8_BAR; PG8_MMA(0, 0, At, B0); PG8_MMA(0, 1, At, B1); PG8_BAR; PG8_SCHED;
            PG8_LDA(At, 1, 1); PG8_STAGE(PG8_SB(1, 0), b3, voffB); PG8_STAGE(PG8_SB(1, 1), b3 + hstep, voffB); PG8_STAGE(PG8_SA(1, 0), a3, voffA);
            PG8_WAIT_V(8); PG8_WAIT_L(0); PG8_BAR; PG8_MMA(1, 0, At, B0); PG8_MMA(1, 1, At, B1); PG8_BAR; PG8_SCHED;
            } else {
            PG8_LDB(B0, 0, 0); PG8_SCHED; PG8_LDA(At, 0, 0); PG8_STAGE(PG8_SA(1, 1), a1 + hstep, voffA);
            PG8_WAIT_L(8); PG8_BAR; PG8_WAIT_L(0); PG8_MMA(0, 0, At, B0); PG8_BAR; PG8_SCHED;
            PG8_LDB(B1, 0, 1); PG8_STAGE(PG8_SB(0, 0), b2, voffB);
            PG8_BAR; PG8_WAIT_L(0); PG8_MMA(0, 1, At, B1); PG8_BAR;
            PG8_LDA(At, 0, 1); PG8_STAGE(PG8_SA(0, 0), a2, voffA);
            PG8_BAR; PG8_WAIT_L(0); PG8_MMA(1, 0, At, B0); PG8_BAR; PG8_SCHED;
            PG8_STAGE(PG8_SB(0, 1), b2 + hstep, voffB);
            PG8_WAIT_V(6); PG8_BAR; PG8_MMA(1, 1, At, B1); PG8_BAR;
            PG8_LDB(B0, 1, 0); PG8_SCHED; PG8_LDA(At, 1, 0); PG8_STAGE(PG8_SA(0, 1), a2 + hstep, voffA);
            PG8_WAIT_L(8); PG8_BAR; PG8_WAIT_L(0); PG8_MMA(0, 0, At, B0); PG8_BAR; PG8_SCHED;
            PG8_LDB(B1, 1, 1); PG8_STAGE(PG8_SB(1, 0), b3, voffB);
            PG8_BAR; PG8_WAIT_L(0); PG8_MMA(0, 1, At, B1); PG8_BAR;
            PG8_LDA(At, 1, 1); PG8_STAGE(PG8_SA(1, 0), a3, voffA);
            PG8_BAR; PG8_WAIT_L(0); PG8_MMA(1, 0, At, B0); PG8_BAR; PG8_SCHED;
            PG8_STAGE(PG8_SB(1, 1), b3 + hstep, voffB);
            PG8_WAIT_V(6); PG8_BAR; PG8_MMA(1, 1, At, B1); PG8_BAR;
            }
        }
        if constexpr (ALIGN_EPI) { if (wr == 0) PG8_BAR; }
        if constexpr (!Epi::AFTER_DRAIN) { E(acc, cur, wr, wc, fr, fq); S.done(cur); }
        if (!has_next) break;
#pragma unroll
        for (int a = 0; a < 2; ++a)
#pragma unroll
            for (int b = 0; b < 2; ++b)
#pragma unroll
                for (int m = 0; m < 4; ++m)
#pragma unroll
                    for (int n = 0; n < 2; ++n) acc[a][b][m][n] = (f32x4){0.f, 0.f, 0.f, 0.f};
        cur = nxt; cA = nA; cB = nB; ++ui;
        if constexpr (ALIGN_EPI) { if (wr == 1) PG8_BAR; }
    }
    PG8_WAIT_V(0);
    if constexpr (!ALIGN_EPI) { if (wr == 0) PG8_BAR; }
    PG8_BAR;
    if constexpr (Epi::AFTER_DRAIN) { E.fused(acc, cur, wr, wc, fr, fq, lds, wid, lane); S.done(cur); }
#undef PG8_SA
#undef PG8_SB
#undef PG8_STAGE
#undef PG8_LDA
#undef PG8_LDB
#undef PG8_MMA
#undef PG8_WAIT_V
#undef PG8_WAIT_L
#undef PG8_BAR
#undef PG8_SCHED
}
}
constexpr int NWAVES = 8;
constexpr int DM = 1024, SEQ = 8192, NB = 4, DB = 128, DS = 8, FF = 2816;
constexpr int MP = NB * SEQ, MS = DB * DS, M = MP + MS;
constexpr int QR = 256, KVR = 128, RD = 32, RWC = 1792, INC = 2208, INP = 2304, RWD = 512;
constexpr int NPAGE = 128, PAGE = 128;
constexpr float ALPHA = 1.189207115002721f;
constexpr float QSCALE = 0.10206207261596577f * 1.4426950408889634f;
constexpr float LN_EPS = 1e-5f, RMS_EPS = 1e-6f, GN_EPS = 64e-5f;
constexpr size_t O_YP = 0, O_YS = 33554432, O_CKVP = 34603008, O_KRP = 38797312, O_WKVP = 39845888, O_SHP = 39976960,
                 O_CKVS = 39984128, O_KRS = 40115200, O_WKVS = 40147968, O_SHS = 44342272, O_END = 44571648;
constexpr size_t MiB = 1u << 20;
constexpr size_t WS_CTL = 0, CTL_ZERO_BYTES = 1 * MiB;
constexpr size_t WS_WGUA = 2 * MiB, WS_WDA = 13 * MiB, WS_WGUB = 19 * MiB, WS_WDB = 30 * MiB, WS_WIN = 36 * MiB, WS_WQ = 41 * MiB, WS_WO = 42 * MiB, WS_WL = 45 * MiB, WS_ROPE = 46 * MiB;
constexpr size_t WS_XNB = 48 * MiB, WS_HB = 114 * MiB, WS_Z = 296 * MiB, WS_X1 = 428 * MiB, WS_X2 = 560 * MiB, WS_PROJ = 692 * MiB, WS_CQN = 989 * MiB, WS_QB = 1006 * MiB;
constexpr size_t WS_CKVB = 1089 * MiB, WS_KRB = 1098 * MiB, WS_RKV = 1101 * MiB, WS_LA = 1299 * MiB, WS_LO = 1316 * MiB, WS_SC5 = 1514 * MiB, WS_G = 1844 * MiB, WS_SCAL = 1910 * MiB;
constexpr size_t WS_Y = 1915 * MiB, WS_OM = 1981 * MiB, WS_PO = 2080 * MiB, WS_PML = 2112 * MiB, WS_PART = 2113 * MiB, WS_OPS = 2161 * MiB, WS_G15 = 2321 * MiB, WS_END = 2325 * MiB;
constexpr int ROPE_N = 8200;
constexpr int CW_TMO = 0, CW_QHEAD = 64, CW_BAR = 4096;
constexpr int RING_OFF = 0, RING_BYTES = 131072, LDSCTL_OFF = RING_BYTES, MISC_OFF = LDSCTL_OFF + 320, LDS_BYTES = 147456;

#define GAS __attribute__((address_space(1)))
#define LAS __attribute__((address_space(3)))
typedef unsigned short bf16;
typedef unsigned v4u __attribute__((ext_vector_type(4)));
typedef unsigned v2u __attribute__((ext_vector_type(2)));
typedef float f32x4 __attribute__((ext_vector_type(4)));
typedef float f32x2 __attribute__((ext_vector_type(2)));
typedef short bf16x8 __attribute__((ext_vector_type(8)));
typedef short s16x4 __attribute__((ext_vector_type(4)));
typedef float f32x16 __attribute__((ext_vector_type(16)));
typedef GAS unsigned gu32;
#define RLX_AGENT __ATOMIC_RELAXED, __HIP_MEMORY_SCOPE_AGENT
#define DI __device__ __forceinline__
DI unsigned f2bf(float f) { unsigned u = __builtin_bit_cast(unsigned, f); return (u + 0x7fffu + ((u >> 16) & 1u)) >> 16; }
DI unsigned pk2(float lo, float hi) { return f2bf(lo) | (f2bf(hi) << 16); }
DI float wave_sum(float v) {
#pragma unroll
    for (int o = 1; o < 64; o <<= 1) v += __shfl_xor(v, o);
    return v;
}
#define XB_TMO      128
#define XB_XCNT(j)  (256  + 64 * (j))
#define XB_XSUB(j)  (1280 + 64 * (j))
#define XB_XGEN(j)  (2304 + 64 * (j))
#define XB_TOP      3328
#define XB_TOPGEN   3392
#define XCD_BAR_WORDS 3456
#define XB_SPIN_CAP (1u << 18)

__device__ __forceinline__ unsigned xb_ld(unsigned* p)              { return __hip_atomic_load(p, __ATOMIC_RELAXED, __HIP_MEMORY_SCOPE_AGENT); }
__device__ __forceinline__ unsigned xb_add(unsigned* p, unsigned v) { return __hip_atomic_fetch_add(p, v, __ATOMIC_RELAXED, __HIP_MEMORY_SCOPE_AGENT); }
__device__ __forceinline__ unsigned xb_xcc_id() { return (unsigned)__builtin_amdgcn_s_getreg((3 << 11) | 20) & 0xFu; }
#define XB_SPIN(cond, bar) do { unsigned _sp = 0; while (cond) { __builtin_amdgcn_s_sleep(1); \
    if ((++_sp & 255u) == 0u) { if (xb_ld(&(bar)[XB_TMO])) break; if (_sp > XB_SPIN_CAP) { atomicAdd(&(bar)[XB_TMO], 1u); break; } } } } while (0)

struct XcdBarrier {
    unsigned* bar; unsigned x;
    volatile LAS unsigned* st;
};

__device__ __forceinline__ XcdBarrier xcd_barrier_post(unsigned* bar, volatile LAS unsigned* st) {
    XcdBarrier b; b.bar = bar; b.x = xb_xcc_id(); b.st = st;
    if (threadIdx.x == 0) (void)xb_add(&bar[XB_XCNT(b.x)], 1u);
    return b;
}
__device__ __forceinline__ void xcd_barrier_complete(unsigned* bar, unsigned x, unsigned& nloc, unsigned& nx) {
    const unsigned G = gridDim.x * gridDim.y * gridDim.z;
    unsigned sum, cnt, mine, sp = 0u;
    for (;;) {
        sum = 0u; cnt = 0u; mine = 0u;
#pragma unroll
        for (unsigned j = 0; j < 16; ++j) { const unsigned c = xb_ld(&bar[XB_XCNT(j)]); sum += c; cnt += (c > 0u) ? 1u : 0u; mine = (j == x) ? c : mine; }
        if (sum == G) break;
        __builtin_amdgcn_s_sleep(1);
        if ((++sp & 255u) == 0u) { if (xb_ld(&bar[XB_TMO])) break; if (sp > XB_SPIN_CAP) { atomicAdd(&bar[XB_TMO], 1u); break; } }
    }
    nloc = mine > 0u ? mine : 1u; nx = cnt > 0u ? cnt : 1u;
}

__device__ __forceinline__ void xcd_barrier(const XcdBarrier& b) {
    asm volatile("s_waitcnt vmcnt(0)" ::: "memory");
    __syncthreads();
    if (threadIdx.x == 0) {
        unsigned* bar = b.bar;
        __builtin_amdgcn_s_waitcnt(0);
        unsigned nloc = b.st[0], nx = b.st[1];
        if (nloc == 0u) { xcd_barrier_complete(bar, b.x, nloc, nx); b.st[0] = nloc; b.st[1] = nx; }
        const unsigned old = xb_add(&bar[XB_XSUB(b.x)], 1u);
        const unsigned gen = old / nloc;
        if (old + 1u == (gen + 1u) * nloc) {
            __builtin_amdgcn_fence(__ATOMIC_RELEASE, "agent");
            asm volatile("s_waitcnt vmcnt(0)" ::: "memory");
            const unsigned og = xb_add(&bar[XB_TOP], 1u);
            const unsigned tg = og / nx;
            if (og + 1u == (tg + 1u) * nx) xb_add(&bar[XB_TOPGEN], 1u);
            else XB_SPIN(xb_ld(&bar[XB_TOPGEN]) == tg, bar);
            __builtin_amdgcn_fence(__ATOMIC_ACQUIRE, "agent");
            xb_add(&bar[XB_XGEN(b.x)], 1u);
            asm volatile("s_waitcnt vmcnt(0)" ::: "memory");
        } else {
            XB_SPIN(xb_ld(&bar[XB_XGEN(b.x)]) == gen, bar);
            __builtin_amdgcn_fence(__ATOMIC_ACQUIRE, "agent");
            asm volatile("s_waitcnt vmcnt(0)" ::: "memory");
        }
    }
    __syncthreads();
}
DI void p0_transpose_item(const float* W, int K, int N, bf16* WT, int kb, int nb, int drow0, LAS float* scr, int lane) {
    const int k0 = 64 * kb, n0 = 32 * nb;
#pragma unroll 8
    for (int i = 0; i < 32; ++i) { const int kk = 2 * i + (lane >> 5); scr[kk * 33 + (lane & 31)] = W[(size_t)(k0 + kk) * N + n0 + (lane & 31)]; }
    asm volatile("s_waitcnt lgkmcnt(0)" ::: "memory");
    const int c = lane & 7;
#pragma unroll
    for (int j = 0; j < 4; ++j) { const int n = (lane >> 3) + 8 * j; const LAS float* s = scr + (8 * c) * 33 + n;
        v4u o; o.x = pk2(s[0 * 33], s[1 * 33]); o.y = pk2(s[2 * 33], s[3 * 33]); o.z = pk2(s[4 * 33], s[5 * 33]); o.w = pk2(s[6 * 33], s[7 * 33]);
        *(GAS v4u*)(WT + (size_t)(drow0 + n) * K + k0 + 8 * c) = o; }
    asm volatile("s_waitcnt lgkmcnt(0)" ::: "memory");
}
DI int gu_row(int n, int up) { return 256 * (n >> 7) + (n & 127) + (up ? 128 : 0); }

DI void sincos_d(double r, double& s, double& c) {
    const double z = r * r;
    double ps = -9.18368986379554601e-29; ps = ps * z + 6.44695028438447359e-26; ps = ps * z - 3.86817017063068413e-23; ps = ps * z + 1.95729410633912626e-20; ps = ps * z - 8.22063524662432950e-18;
    ps = ps * z + 2.81145725434552060e-15; ps = ps * z - 7.64716373181981641e-13; ps = ps * z + 1.60590438368216133e-10; ps = ps * z - 2.50521083854417202e-08; ps = ps * z + 2.75573192239858925e-06;
    ps = ps * z - 1.98412698412698413e-04; ps = ps * z + 8.33333333333333322e-03; ps = ps * z - 1.66666666666666657e-01; ps = ps * z + 1.0; s = ps * r;
    double pc = 3.27988923706983776e-30; pc = pc * z - 2.47959626322479759e-27; pc = pc * z + 1.61173757109611839e-24; pc = pc * z - 8.89679139245057408e-22; pc = pc * z + 4.11031762331216484e-19;
    pc = pc * z - 1.56192069685862253e-16; pc = pc * z + 4.77947733238738525e-14; pc = pc * z - 1.14707455977297245e-11; pc = pc * z + 2.08767569878681002e-09; pc = pc * z - 2.75573192239858883e-07;
    pc = pc * z + 2.48015873015873016e-05; pc = pc * z - 1.38888888888888894e-03; pc = pc * z + 4.16666666666666644e-02; pc = pc * z - 0.5; pc = pc * z + 1.0; c = pc;
}

struct Args { const float* in[37]; float* out; unsigned char* ws; int ph_lo, ph_hi; };
static_assert(sizeof(Args) == 37 * 8 + 8 + 8 + 8, "Args has no padding");
typedef const __attribute__((address_space(4))) Args Ptrs;
DI Ptrs* args_here() { Ptrs* p = (Ptrs*)__builtin_amdgcn_kernarg_segment_ptr(); asm volatile("" : "+s"(p)); return p; }

DI void p0_prologue(const Ptrs& P, LAS unsigned char* lds, int gw, int NGW, int wave, int lane) {
    unsigned char* ws = P.ws;
    LAS float* scr = (LAS float*)(lds + RING_OFF + wave * 16384);
    constexpr int I_GU = (DM / 64) * (FF / 32), I_D = (FF / 64) * (DM / 32), I_IN = (DM / 64) * (INC / 32);
    constexpr int NITEMS = 6 * I_GU + I_IN;
    for (int it = gw; it < NITEMS; it += NGW) {
        int r = it;
        if (r < 4 * I_GU) {
            const int which = r / I_GU; r -= which * I_GU; const int nblk = FF / 32, kb = r / nblk, nb = r % nblk;
            const float* W = which == 0 ? P.in[9] : which == 1 ? P.in[10] : which == 2 ? P.in[32] : P.in[33];
            bf16* WT = (bf16*)(ws + (which < 2 ? WS_WGUA : WS_WGUB));
            p0_transpose_item(W, DM, FF, WT, kb, nb, gu_row(32 * nb, which & 1), scr, lane); continue; }
        r -= 4 * I_GU;
        if (r < 2 * I_D) { const int which = r / I_D; r -= which * I_D; const int nblk = DM / 32, kb = r / nblk, nb = r % nblk;
            p0_transpose_item(which ? P.in[34] : P.in[11], FF, DM, (bf16*)(ws + (which ? WS_WDB : WS_WDA)), kb, nb, 32 * nb, scr, lane); continue; }
        r -= 2 * I_D;
        { const int nblk = INC / 32, kb = r / nblk, nb = r % nblk; p0_transpose_item(P.in[12], DM, INC, (bf16*)(ws + WS_WIN), kb, nb, 32 * nb, scr, lane); }
    }
    const int gt = gw * 64 + lane, NGT = NGW * 64;
    { GAS v4u* z = (GAS v4u*)(ws + WS_WIN + (size_t)INC * DM * 2); for (int i = gt; i < (INP - INC) * DM * 2 / 16; i += NGT) z[i] = (v4u){0u, 0u, 0u, 0u}; }
    { bf16* WL = (bf16*)(ws + WS_WL); const float* wl = P.in[20]; const float* al = P.in[22]; const float* gl = P.in[23];
      for (int i = gt; i < 1536 * 256; i += NGT) { const int n = i >> 8, k = i & 255; float v = 0.f;
          if (n < 512) { if (k < 64) v = wl[k * 512 + n]; }
          else if (n < 1024) { if (k >= 64 && k < 128) v = al[(k - 64) * 512 + (n - 512)]; }
          else { if (k >= 128) v = gl[(k - 128) * 512 + (n - 1024)]; }
          WL[i] = (bf16)f2bf(v); } }
    { bf16* WQ = (bf16*)(ws + WS_WQ); const float* uq = P.in[14]; const float* uk = P.in[16];
      for (int i = gt; i < 1280 * 256; i += NGT) { const int n = i >> 8, c = i & 255; float v;
          if (n < 1024) { const int hd = n >> 7, r = n & 127; const float* a = uq + c * 768 + hd * 96; const float* b = uk + r * 512 + hd * 64; float s = 0.f;
              for (int j = 0; j < 64; ++j) s += a[j] * b[j]; v = s; }
          else { const int hd = (n - 1024) >> 5, cp = (n - 1024) & 31, p = (cp >> 1) + 16 * (cp & 1); v = uq[c * 768 + hd * 96 + 64 + p]; }
          WQ[i] = (bf16)f2bf(v); } }
    { bf16* WO = (bf16*)(ws + WS_WO); const float* uv = P.in[17]; const float* wo = P.in[29];
      for (int i = gt; i < 1536 * 1024; i += NGT) { const int k = i >> 10, n = i & 1023; float v;
          if (k < 1024) { const int hd = k >> 7, r = k & 127; const float* a = uv + r * 512 + hd * 64; const float* b = wo + (size_t)(hd * 64) * 1024 + n; float s = 0.f;
              for (int j = 0; j < 64; ++j) s += a[j] * b[(size_t)j * 1024]; v = s; }
          else v = wo[(size_t)(512 + k - 1024) * 1024 + n];
          WO[(size_t)n * 1536 + k] = (bf16)f2bf(v); } }
    { float* ct = (float*)(ws + WS_ROPE); float* st = ct + ROPE_N * 16;
      for (int i = gt; i < ROPE_N * 16; i += NGT) { const int tix = i >> 4, f = i & 15; const double pos = (double)(tix < 8192 ? tix : 16384 + (tix - 8192));
          double inv = 1.0; for (int q = 0; q < f; ++q) inv *= 0.5623413251903491;
          const double ang = pos * inv; const double kq = __builtin_rint(ang * 0.15915494309189535); const double r = __builtin_fma(-kq, 6.283185307179586, ang) - kq * 2.4492935982947064e-16;
          double s, c; sincos_d(r, s, c); ct[i] = (float)c; st[i] = (float)s; } }
    { bf16* XNB = (bf16*)(ws + WS_XNB);
      for (int m = gw; m < M; m += NGW) { const float* xr = m < MP ? P.in[0] + (size_t)m * DM : P.in[1] + (size_t)(m - MP) * DM;
          const GAS f32x4* x4 = (const GAS f32x4*)xr + lane; GAS v2u* o = (GAS v2u*)(XNB + (size_t)m * DM) + lane;
#pragma unroll
          for (int j = 0; j < 4; ++j) { const f32x4 v = x4[64 * j]; o[64 * j] = (v2u){pk2(v.x, v.y), pk2(v.z, v.w)}; } } }
}

DI void ln_phase(const float* Z, const float* g, const float* b, float* Xf, bf16* Xb, const float* part, int nk, const float* sbase, const bf16* sbaseb, float alpha, float sc, int gw, int NGW, int lane) {
    f32x4 gv[4], bv[4];
#pragma unroll
    for (int j = 0; j < 4; ++j) { gv[j] = ((const GAS f32x4*)g)[lane + 64 * j]; bv[j] = ((const GAS f32x4*)b)[lane + 64 * j]; }
    for (int m = gw; m < M; m += NGW) {
        f32x4 v[4]; float s = 0.f;
        if (m < MP) {
            const GAS f32x4* zr = (const GAS f32x4*)(Z + (size_t)m * DM) + lane;
#pragma unroll
            for (int j = 0; j < 4; ++j) v[j] = zr[64 * j];
        } else {
            f32x4 a[4];
            if (sbaseb) { const GAS v2u* bb = (const GAS v2u*)(sbaseb + (size_t)(m - MP) * DM) + lane;
#pragma unroll
                for (int j = 0; j < 4; ++j) { const v2u w = bb[64 * j]; v[j] = (f32x4){__builtin_bit_cast(float, w.x << 16), __builtin_bit_cast(float, w.x & 0xffff0000u), __builtin_bit_cast(float, w.y << 16), __builtin_bit_cast(float, w.y & 0xffff0000u)} * alpha; }
            } else { const GAS f32x4* br = (const GAS f32x4*)(sbase + (size_t)(m - MP) * DM) + lane;
#pragma unroll
                for (int j = 0; j < 4; ++j) v[j] = br[64 * j] * alpha; }
#pragma unroll
            for (int j = 0; j < 4; ++j) a[j] = (f32x4){0.f, 0.f, 0.f, 0.f};
            for (int k = 0; k < nk; ++k) { const GAS f32x4* pr = (const GAS f32x4*)(part + ((size_t)k * MS + (m - MP)) * DM) + lane;
#pragma unroll
                for (int j = 0; j < 4; ++j) a[j] += pr[64 * j]; }
#pragma unroll
            for (int j = 0; j < 4; ++j) v[j] += a[j] * sc;
        }
#pragma unroll
        for (int j = 0; j < 4; ++j) s += (v[j].x + v[j].y) + (v[j].z + v[j].w);
        const float mean = wave_sum(s) * (1.f / DM); float s2 = 0.f;
#pragma unroll
        for (int j = 0; j < 4; ++j) { v[j] = v[j] - mean; s2 += (v[j].x * v[j].x + v[j].y * v[j].y) + (v[j].z * v[j].z + v[j].w * v[j].w); }
        const float rstd = 1.f / sqrtf(wave_sum(s2) * (1.f / DM) + LN_EPS);
#pragma unroll
        for (int j = 0; j < 4; ++j) { v[j] = v[j] * rstd * gv[j] + bv[j]; }
        if (Xf) { GAS f32x4* o = (GAS f32x4*)(Xf + (size_t)m * DM) + lane;
#pragma unroll
            for (int j = 0; j < 4; ++j) o[64 * j] = v[j]; }
        if (Xb) { GAS v2u* o = (GAS v2u*)(Xb + (size_t)m * DM) + lane;
#pragma unroll
            for (int j = 0; j < 4; ++j) o[64 * j] = (v2u){pk2(v[j].x, v[j].y), pk2(v[j].z, v[j].w)}; }
    }
}

DI void prep_a(const Ptrs& P, int gw, int NGW, int lane) {
    unsigned char* ws = P.ws;
    const float* PROJ = (const float*)(ws + WS_PROJ);
    bf16* CQN = (bf16*)(ws + WS_CQN); bf16* CKVB = (bf16*)(ws + WS_CKVB); bf16* KRB = (bf16*)(ws + WS_KRB);
    float* RKV = (float*)(ws + WS_RKV); bf16* LA = (bf16*)(ws + WS_LA);
    const float* ct = (const float*)(ws + WS_ROPE); const float* st = ct + ROPE_N * 16;
    const float* qg = P.in[13]; const float* kg = P.in[15]; const float* mu = P.in[18]; const float* sshift = P.in[5];
    const f32x4 qg4 = ((const GAS f32x4*)qg)[lane]; const f32x2 kg2 = ((const GAS f32x2*)kg)[lane];
    f32x4 mu4[7];
#pragma unroll
    for (int i = 0; i < 7; ++i) mu4[i] = ((const GAS f32x4*)mu)[lane + 64 * i];
    for (int m = gw; m < M; m += NGW) {
        const bool samp = m >= MP; const int ms = m - MP;
        const int bb = samp ? (ms >> 3) : (m >> 13), t = samp ? (ms & 7) : (m & 8191), tix = samp ? 8192 + t : t;
        const float* pr = PROJ + (size_t)m * INP;
        { const f32x4 v = ((const GAS f32x4*)pr)[lane]; const float ss = wave_sum((v.x * v.x + v.y * v.y) + (v.z * v.z + v.w * v.w));
          const float rs = 1.f / sqrtf(ss * (1.f / QR) + RMS_EPS);
          ((GAS v2u*)(CQN + (size_t)m * QR))[lane] = (v2u){pk2(v.x * rs * qg4.x, v.y * rs * qg4.y), pk2(v.z * rs * qg4.z, v.w * rs * qg4.w)}; }
        { const f32x2 v = ((const GAS f32x2*)(pr + QR))[lane]; const float ss = wave_sum(v.x * v.x + v.y * v.y);
          const float rs = 1.f / sqrtf(ss * (1.f / KVR) + RMS_EPS); const float a = v.x * rs * kg2.x, b = v.y * rs * kg2.y;
          float* o = samp ? P.out + O_CKVS + (size_t)ms * KVR : P.out + O_CKVP + (size_t)m * KVR;
          ((GAS f32x2*)o)[lane] = (f32x2){a, b}; ((GAS unsigned*)(CKVB + (size_t)m * KVR))[lane] = pk2(a, b); }
        { const int l31 = lane & 31; const float v = pr[QR + KVR + l31]; const float pv = __shfl_xor(v, 16); const int p = lane & 15;
          const float c = ct[tix * 16 + p], s = st[tix * 16 + p];
          const float o = (l31 < 16) ? v * c - pv * s : pv * s + v * c;
          if (lane < 32) { float* op = samp ? P.out + O_KRS + (size_t)ms * RD : P.out + O_KRP + (size_t)m * RD; op[lane] = o; }
          const float ohi = __shfl_down(o, 16);
          if (lane < 16) ((GAS unsigned*)(KRB + (size_t)m * RD))[lane] = pk2(o, ohi); }
        { const GAS f32x4* rw4 = (const GAS f32x4*)(pr + (INC - RWC));
          const GAS f32x4* pv4 = (t == 0) ? (samp ? (const GAS f32x4*)(sshift + (size_t)bb * RWC) : (const GAS f32x4*)nullptr) : (const GAS f32x4*)(pr - INP + (INC - RWC));
          const bool last = samp ? (t == DS - 1) : (t == SEQ - 1);
          float* sh = samp ? P.out + O_SHS + (size_t)bb * RWC : P.out + O_SHP + (size_t)bb * RWC;
#pragma unroll
          for (int i = 0; i < 7; ++i) {
              if (i < 6 && !samp && !last) continue;
              const f32x4 r = rw4[lane + 64 * i]; const f32x4 pv = pv4 ? pv4[lane + 64 * i] : (f32x4){0.f, 0.f, 0.f, 0.f};
              const f32x4 x = r + (pv - r) * mu4[i];
              if (last) ((GAS f32x4*)sh)[lane + 64 * i] = r;
              if (i < 6) { if (samp) ((GAS f32x4*)(RKV + (size_t)m * 1536))[lane + 64 * i] = x; }
              else { f32x4 y;
                  if (lane < 16) { for (int j = 0; j < 4; ++j) { const float e = __expf(2.f * x[j]); y[j] = 1.f - 2.f / (e + 1.f); } }
                  else if (lane < 32) y = x;
                  else { for (int j = 0; j < 4; ++j) y[j] = 1.f / (1.f + __expf(-x[j])); }
                  ((GAS v2u*)(LA + (size_t)m * 256))[lane] = (v2u){pk2(y.x, y.y), pk2(y.z, y.w)}; }
          } }
    }
}

DI float red8(float v) { v += __shfl_xor(v, 1); v += __shfl_xor(v, 2); v += __shfl_xor(v, 4); return v; }
DI void prep_c(const Ptrs& P, int gw, int NGW, int lane) {
    unsigned char* ws = P.ws;
    const float* RKV = (const float*)(ws + WS_RKV); const float* LO = (const float*)(ws + WS_LO);
    float* SC5 = (float*)(ws + WS_SC5); float* G = (float*)(ws + WS_G); float* SCAL = (float*)(ws + WS_SCAL);
    constexpr size_t ASZ = (size_t)M * RWD;
    const int c0 = lane * 8;
    float w0v[8], a0v[8], kkv[8], kav[8], rkv[8];
#pragma unroll
    for (int j = 0; j < 8; ++j) { w0v[j] = P.in[19][c0 + j]; a0v[j] = P.in[21][c0 + j]; kkv[j] = P.in[24][c0 + j]; kav[j] = P.in[25][c0 + j]; rkv[j] = P.in[26][c0 + j]; }
    for (int m = MP + gw; m < M; m += NGW) {
        const float* rk = RKV + (size_t)m * 1536 + c0; const float* lo = LO + (size_t)m * 1536 + c0;
        float r[8], k[8], wl[8], al[8], gl[8];
        { const f32x4 a = ((const GAS f32x4*)rk)[0], b = ((const GAS f32x4*)rk)[1]; r[0]=a.x; r[1]=a.y; r[2]=a.z; r[3]=a.w; r[4]=b.x; r[5]=b.y; r[6]=b.z; r[7]=b.w; }
        { const f32x4 a = ((const GAS f32x4*)(rk + 512))[0], b = ((const GAS f32x4*)(rk + 512))[1]; k[0]=a.x; k[1]=a.y; k[2]=a.z; k[3]=a.w; k[4]=b.x; k[5]=b.y; k[6]=b.z; k[7]=b.w; }
        { const f32x4 a = ((const GAS f32x4*)lo)[0], b = ((const GAS f32x4*)lo)[1]; wl[0]=a.x; wl[1]=a.y; wl[2]=a.z; wl[3]=a.w; wl[4]=b.x; wl[5]=b.y; wl[6]=b.z; wl[7]=b.w; }
        { const f32x4 a = ((const GAS f32x4*)(lo + 512))[0], b = ((const GAS f32x4*)(lo + 512))[1]; al[0]=a.x; al[1]=a.y; al[2]=a.z; al[3]=a.w; al[4]=b.x; al[5]=b.y; al[6]=b.z; al[7]=b.w; }
        { const f32x4 a = ((const GAS f32x4*)(lo + 1024))[0], b = ((const GAS f32x4*)(lo + 1024))[1]; gl[0]=a.x; gl[1]=a.y; gl[2]=a.z; gl[3]=a.w; gl[4]=b.x; gl[5]=b.y; gl[6]=b.z; gl[7]=b.w; }
        float dec[8], av[8], kk[8], kp[8]; float nn = 0.f;
#pragma unroll
        for (int j = 0; j < 8; ++j) {
            const float z = -(w0v[j] + wl[j]);
            const float sp = fmaxf(z, 0.f) + log1pf(__expf(-fabsf(z)));
            const float w = -sp - 0.5f; dec[j] = __expf(-__expf(w));
            av[j] = 1.f / (1.f + __expf(-(a0v[j] + al[j])));
            kk[j] = k[j] * kkv[j]; nn += kk[j] * kk[j];
            kp[j] = k[j] * (1.f + (av[j] - 1.f) * kav[j]);
        }
        nn = red8(nn); const float inv = 1.f / fmaxf(sqrtf(nn), 1e-12f);
        float as[8], bs[8], wr[8]; float br = 0.f, kr = 0.f, bon = 0.f;
#pragma unroll
        for (int j = 0; j < 8; ++j) { const float kn = kk[j] * inv; as[j] = -kn; bs[j] = kn * av[j]; wr[j] = dec[j] * r[j]; br += bs[j] * r[j]; kr += kp[j] * r[j]; bon += r[j] * kp[j] * rkv[j]; }
        br = red8(br); kr = red8(kr); bon = red8(bon);
        float* o = SC5 + (size_t)m * RWD + c0;
        ((GAS f32x4*)o)[0] = (f32x4){as[0], as[1], as[2], as[3]}; ((GAS f32x4*)o)[1] = (f32x4){as[4], as[5], as[6], as[7]}; o += ASZ;
        ((GAS f32x4*)o)[0] = (f32x4){wr[0], wr[1], wr[2], wr[3]}; ((GAS f32x4*)o)[1] = (f32x4){wr[4], wr[5], wr[6], wr[7]}; o += ASZ;
        ((GAS f32x4*)o)[0] = (f32x4){dec[0], dec[1], dec[2], dec[3]}; ((GAS f32x4*)o)[1] = (f32x4){dec[4], dec[5], dec[6], dec[7]}; o += ASZ;
        ((GAS f32x4*)o)[0] = (f32x4){bs[0], bs[1], bs[2], bs[3]}; ((GAS f32x4*)o)[1] = (f32x4){bs[4], bs[5], bs[6], bs[7]}; o += ASZ;
        ((GAS f32x4*)o)[0] = (f32x4){kp[0], kp[1], kp[2], kp[3]}; ((GAS f32x4*)o)[1] = (f32x4){kp[4], kp[5], kp[6], kp[7]};
        if ((lane & 7) == 0) ((GAS f32x4*)(SCAL + ((size_t)m * 8 + (lane >> 3)) * 4))[0] = (f32x4){br * 0.0625f, kr * 0.0625f, bon, 0.f};
    }
}

DI void post_phase(const Ptrs& P, int gw, int NGW, int lane) {
    unsigned char* ws = P.ws;
    bf16* OM = (bf16*)(ws + WS_OM);
    { const float* PO = (const float*)(ws + WS_PO); const float* PML = (const float*)(ws + WS_PML);
      for (int it = gw; it < DB * 64; it += NGW) { const int b = it >> 6, qr = it & 63;
          float mi[8], li[8]; float mx = -3.0e38f;
#pragma unroll
          for (int s = 0; s < 8; ++s) { const f32x2 ml = ((const GAS f32x2*)PML)[(size_t)(b * 8 + s) * 64 + qr]; mi[s] = ml.x; li[s] = ml.y; mx = fmaxf(mx, ml.x); }
          float L = 0.f; f32x2 acc = {0.f, 0.f};
#pragma unroll
          for (int s = 0; s < 8; ++s) { const float w = __builtin_amdgcn_exp2f(mi[s] - mx); L += li[s] * w;
              const f32x2 o = ((const GAS f32x2*)(PO + ((size_t)(b * 8 + s) * 64 + qr) * 128))[lane]; acc += o * w; }
          const float inv = 1.f / L; const int tq = qr >> 3, hd = qr & 7;
          ((GAS unsigned*)(OM + (size_t)(MP + b * 8 + tq) * 1536 + hd * 128))[lane] = pk2(acc.x * inv, acc.y * inv); } }
    { const float* Y = (const float*)(ws + WS_Y); const float* RKV = (const float*)(ws + WS_RKV); const float* LO = (const float*)(ws + WS_LO); const float* SCAL = (const float*)(ws + WS_SCAL);
      const int c0 = lane * 8; float lg[8], lb[8];
#pragma unroll
      for (int j = 0; j < 8; ++j) { lg[j] = P.in[27][c0 + j]; lb[j] = P.in[28][c0 + j]; }
      const float* PROJ = (const float*)(ws + WS_PROJ); const f32x4 muv0 = ((const GAS f32x4*)(P.in[18] + 1024 + c0))[0], muv1 = ((const GAS f32x4*)(P.in[18] + 1024 + c0))[1];
      for (int m = gw; m < M; m += NGW) {
          float y[8], v[8], g[8];
          { const GAS f32x4* p = (const GAS f32x4*)(Y + (size_t)m * RWD + c0); const f32x4 a = p[0], b = p[1]; y[0]=a.x; y[1]=a.y; y[2]=a.z; y[3]=a.w; y[4]=b.x; y[5]=b.y; y[6]=b.z; y[7]=b.w; }
          if (m >= MP) { const GAS f32x4* p = (const GAS f32x4*)(RKV + (size_t)m * 1536 + 1024 + c0); const f32x4 a = p[0], b = p[1]; v[0]=a.x; v[1]=a.y; v[2]=a.z; v[3]=a.w; v[4]=b.x; v[5]=b.y; v[6]=b.z; v[7]=b.w; }
          else { const GAS f32x4* p = (const GAS f32x4*)(PROJ + (size_t)m * INP + (INC - RWC) + 1024 + c0); f32x4 a = p[0], b = p[1];
              f32x4 pa = {0.f, 0.f, 0.f, 0.f}, pb = pa; if ((m & (SEQ - 1)) != 0) { const GAS f32x4* pp = (const GAS f32x4*)(PROJ + (size_t)(m - 1) * INP + (INC - RWC) + 1024 + c0); pa = pp[0]; pb = pp[1]; }
              a = a + (pa - a) * muv0; b = b + (pb - b) * muv1; v[0]=a.x; v[1]=a.y; v[2]=a.z; v[3]=a.w; v[4]=b.x; v[5]=b.y; v[6]=b.z; v[7]=b.w; }
          { const GAS f32x4* p = (const GAS f32x4*)(LO + (size_t)m * 1536 + 1024 + c0); const f32x4 a = p[0], b = p[1]; g[0]=a.x; g[1]=a.y; g[2]=a.z; g[3]=a.w; g[4]=b.x; g[5]=b.y; g[6]=b.z; g[7]=b.w; }
          const float bon = SCAL[((size_t)m * 8 + (lane >> 3)) * 4 + 2];
          float s = 0.f;
#pragma unroll
          for (int j = 0; j < 8; ++j) s += y[j];
          const float mean = red8(s) * (1.f / 64.f); float q = 0.f;
#pragma unroll
          for (int j = 0; j < 8; ++j) { y[j] -= mean; q += y[j] * y[j]; }
          const float rstd = 1.f / sqrtf(red8(q) * (1.f / 64.f) + GN_EPS);
          float o[8];
#pragma unroll
          for (int j = 0; j < 8; ++j) o[j] = (y[j] * rstd * lg[j] + lb[j] + bon * v[j]) * g[j];
          *(GAS v4u*)(OM + (size_t)m * 1536 + 1024 + c0) = (v4u){pk2(o[0], o[1]), pk2(o[2], o[3]), pk2(o[4], o[5]), pk2(o[6], o[7])};
      } }
}
namespace cs {
typedef float f4 __attribute__((ext_vector_type(4)));
DI unsigned cvtpk(float lo, float hi) { typedef float f2 __attribute__((ext_vector_type(2))); typedef __bf16 b2 __attribute__((ext_vector_type(2))); f2 v = {lo, hi}; b2 b = __builtin_convertvector(v, b2); return __builtin_bit_cast(unsigned, b); }
DI unsigned short cvt1(float x) { return (unsigned short)(cvtpk(x, 0.f) & 0xffffu); }
DI float wsum64(float v) {
    { auto rr = __builtin_amdgcn_permlane32_swap(__float_as_uint(v), __float_as_uint(v), false, false); v = __uint_as_float(rr[0]) + __uint_as_float(rr[1]); }
    v += __builtin_bit_cast(float, __builtin_amdgcn_update_dpp(0, __builtin_bit_cast(int, v), 0x128, 0xf, 0xf, false));
    v += __builtin_bit_cast(float, __builtin_amdgcn_update_dpp(0, __builtin_bit_cast(int, v), 0x124, 0xf, 0xf, false));
    v += __builtin_bit_cast(float, __builtin_amdgcn_update_dpp(0, __builtin_bit_cast(int, v), 0x122, 0xf, 0xf, false));
    v += __builtin_bit_cast(float, __builtin_amdgcn_update_dpp(0, __builtin_bit_cast(int, v), 0x121, 0xf, 0xf, false));
    return __builtin_bit_cast(float, __builtin_amdgcn_readlane(__builtin_bit_cast(int, v), 0)) + __builtin_bit_cast(float, __builtin_amdgcn_readlane(__builtin_bit_cast(int, v), 16));
}
#define CS_MFMA(a, b, c) __builtin_amdgcn_mfma_f32_16x16x32_bf16((a), (b), (c), 0, 0, 0)
#define CS_LWAIT() asm volatile("s_waitcnt lgkmcnt(0)" ::: "memory")
constexpr int NCHUNK = SEQ / 16, NTASK = NB * 8 * NCHUNK;
constexpr int OPS_TASK = 10 * 1024;
constexpr int L_AT = 0, L_RT = 2048, L_BT = 4096, L_KT = 6144, L_BH = 8192, L_KH = 10240, L_AB = 12288, L_AK = 13312, L_RB = 14336, L_RK = 15360;

DI void chunk_prep(const float* PROJ, const float* mu, const float* LO, const float* pw0, const float* pa0, const float* pkk, const float* pka, const float* prk, float* SCAL, unsigned char* OPS, float* G15, LAS unsigned char* lds, int gw, int NGW, int wave, int lane) {
    LAS unsigned char* base = lds + wave * 16384;
    const int d = lane, x = lane & 15, q = lane >> 4;
    for (int task = gw; task < NTASK; task += NGW) {
        const int chain = task / NCHUNK, c = task - chain * NCHUNK, bb = chain >> 3, hd = chain & 7;
        const size_t m0 = (size_t)bb * SEQ + (size_t)c * 16;
        float a[16], b[16], k[16], r[16]; float g = 1.f;
        {
            const int ch = hd * 64 + d;
            const float w0v = ((const GAS float*)pw0)[ch], a0v = ((const GAS float*)pa0)[ch], kkv = ((const GAS float*)pkk)[ch], kav = ((const GAS float*)pka)[ch], rkv = ((const GAS float*)prk)[ch];
            const float mur = ((const GAS float*)mu)[ch], muk = ((const GAS float*)mu)[512 + ch];
            float w[16], wl[16], al[16];
            { const GAS float* pj = (const GAS float*)PROJ + m0 * INP + (INC - RWC) + ch;
              float pr_ = 0.f, pk_ = 0.f; if (c != 0) { pr_ = *(pj - INP); pk_ = *(pj - INP + 512); }
#pragma unroll
              for (int t = 0; t < 16; ++t) { const float xr = pj[(size_t)t * INP], xk = pj[(size_t)t * INP + 512]; r[t] = xr + (pr_ - xr) * mur; k[t] = xk + (pk_ - xk) * muk; pr_ = xr; pk_ = xk; } }
#pragma unroll
            for (int t = 0; t < 16; ++t) { const size_t o = (m0 + t) * 1536 + ch; wl[t] = ((const GAS float*)LO)[o]; al[t] = ((const GAS float*)LO)[o + 512]; }
#pragma unroll
            for (int t = 0; t < 16; ++t) {
                const float z = -(w0v + wl[t]); const float sp = fmaxf(z, 0.f) + __logf(1.f + __expf(-fabsf(z)));
                w[t] = __expf(-__expf(-sp - 0.5f));
                const float av = __builtin_amdgcn_rcpf(1.f + __expf(-(a0v + al[t])));
                const float kx = k[t] * kkv; const float nn = wsum64(kx * kx); const float kn = kx * __builtin_amdgcn_rsqf(fmaxf(nn, 1e-24f));
                const float kp = k[t] * (1.f + (av - 1.f) * kav);
                const float bon = wsum64(r[t] * kp * rkv);
                if (lane == 0) ((GAS float*)SCAL)[((m0 + t) * 8 + hd) * 4 + 2] = bon;
                a[t] = -kn; b[t] = kn * av; k[t] = kp;
            }
#pragma unroll
            for (int t = 0; t < 16; ++t) { const float gm1 = g; g *= w[t]; const float inv = __builtin_amdgcn_rcpf(g); a[t] *= gm1; r[t] *= g; b[t] *= inv; k[t] *= inv; }
        }
        ((GAS float*)G15)[(size_t)task * 64 + d] = g;
#pragma unroll
        for (int t = 0; t < 16; ++t) {
            *(LAS unsigned short*)(base + L_AT + (t * 64 + d) * 2) = cvt1(a[t]); *(LAS unsigned short*)(base + L_RT + (t * 64 + d) * 2) = cvt1(r[t]);
            *(LAS unsigned short*)(base + L_BT + (t * 64 + d) * 2) = cvt1(b[t]); *(LAS unsigned short*)(base + L_KT + (t * 64 + d) * 2) = cvt1(k[t]); }
        { v4u h0, h1, k0, k1;
          h0.x = cvtpk(b[0] * g, b[1] * g); h0.y = cvtpk(b[2] * g, b[3] * g); h0.z = cvtpk(b[4] * g, b[5] * g); h0.w = cvtpk(b[6] * g, b[7] * g);
          h1.x = cvtpk(b[8] * g, b[9] * g); h1.y = cvtpk(b[10] * g, b[11] * g); h1.z = cvtpk(b[12] * g, b[13] * g); h1.w = cvtpk(b[14] * g, b[15] * g);
          k0.x = cvtpk(k[0] * g, k[1] * g); k0.y = cvtpk(k[2] * g, k[3] * g); k0.z = cvtpk(k[4] * g, k[5] * g); k0.w = cvtpk(k[6] * g, k[7] * g);
          k1.x = cvtpk(k[8] * g, k[9] * g); k1.y = cvtpk(k[10] * g, k[11] * g); k1.z = cvtpk(k[12] * g, k[13] * g); k1.w = cvtpk(k[14] * g, k[15] * g);
          *(LAS v4u*)(base + L_BH + d * 32) = h0; *(LAS v4u*)(base + L_BH + d * 32 + 16) = h1; *(LAS v4u*)(base + L_KH + d * 32) = k0; *(LAS v4u*)(base + L_KH + d * 32 + 16) = k1; }
        CS_LWAIT();
        { f4 gab = {0.f, 0.f, 0.f, 0.f}, gak = gab, grb = gab, grk = gab;
#pragma unroll
          for (int kb = 0; kb < 2; ++kb) { const int fo = (x * 64 + 32 * kb + 8 * q) * 2;
              const bf16x8 fa = *(const LAS bf16x8*)(base + L_AT + fo), fr = *(const LAS bf16x8*)(base + L_RT + fo), fb = *(const LAS bf16x8*)(base + L_BT + fo), fk = *(const LAS bf16x8*)(base + L_KT + fo);
              gab = CS_MFMA(fb, fa, gab); gak = CS_MFMA(fk, fa, gak); grb = CS_MFMA(fb, fr, grb); grk = CS_MFMA(fk, fr, grk); }
#pragma unroll
          for (int rr = 0; rr < 4; ++rr) { const int u = 4 * q + rr; if (!(u < x)) { gab[rr] = 0.f; gak[rr] = 0.f; } if (!(u <= x)) { grb[rr] = 0.f; grk[rr] = 0.f; } }
          const int go = (x * 16 + 4 * q) * 4;
          *(LAS f4*)(base + L_AB + go) = gab; *(LAS f4*)(base + L_AK + go) = gak; *(LAS f4*)(base + L_RB + go) = grb; *(LAS f4*)(base + L_RK + go) = grk; }
        CS_LWAIT();
        float mm[16];
#pragma unroll
        for (int t = 0; t < 16; ++t) mm[t] = *(const LAS float*)(base + L_AK + (t * 16 + x) * 4);
#pragma unroll
        for (int t = 1; t < 16; ++t) {
            float ab[16];
#pragma unroll
            for (int u4 = 0; u4 < 4; ++u4) if (4 * u4 < t) { const f4 v = *(const LAS f4*)(base + L_AB + (t * 16 + 4 * u4) * 4); ab[4 * u4] = v.x; ab[4 * u4 + 1] = v.y; ab[4 * u4 + 2] = v.z; ab[4 * u4 + 3] = v.w; }
#pragma unroll
            for (int u = 0; u < 16; ++u) if (u < t) { a[t] = fmaf(a[u], ab[u], a[t]); mm[t] = fmaf(mm[u], ab[u], mm[t]); }
        }
        CS_LWAIT();
#pragma unroll
        for (int t = 0; t < 16; ++t) { *(LAS unsigned short*)(base + L_AT + (t * 64 + d) * 2) = cvt1(a[t]); *(LAS float*)(base + L_AK + (t * 16 + x) * 4) = mm[t]; }
        CS_LWAIT();
        unsigned char* ob = OPS + (size_t)task * OPS_TASK + lane * 16;
#pragma unroll
        for (int kb = 0; kb < 2; ++kb) { const int fo = (x * 64 + 32 * kb + 4 * q) * 2;
            const v2u w0 = *(const LAS v2u*)(base + L_AT + fo), w1 = *(const LAS v2u*)(base + L_AT + fo + 32), r0 = *(const LAS v2u*)(base + L_RT + fo), r1 = *(const LAS v2u*)(base + L_RT + fo + 32);
            *(GAS v4u*)(ob + kb * 1024) = (v4u){w0.x, w0.y, w1.x, w1.y}; *(GAS v4u*)(ob + (3 + kb) * 1024) = (v4u){r0.x, r0.y, r1.x, r1.y}; }
        { const int go = (x * 16 + 4 * q) * 4; const f4 m2 = *(const LAS f4*)(base + L_AK + go), rb = *(const LAS f4*)(base + L_RB + go), rk = *(const LAS f4*)(base + L_RK + go);
          *(GAS v4u*)(ob + 2 * 1024) = (v4u){0u, 0u, cvtpk(m2.x, m2.y), cvtpk(m2.z, m2.w)};
          *(GAS v4u*)(ob + 5 * 1024) = (v4u){cvtpk(rb.x, rb.y), cvtpk(rb.z, rb.w), cvtpk(rk.x, rk.y), cvtpk(rk.z, rk.w)}; }
#pragma unroll
        for (int dt = 0; dt < 4; ++dt) { const int fo = ((16 * dt + x) * 16 + 4 * q) * 2; const v2u h = *(const LAS v2u*)(base + L_BH + fo), kk = *(const LAS v2u*)(base + L_KH + fo);
            *(GAS v4u*)(ob + (6 + dt) * 1024) = (v4u){h.x, h.y, kk.x, kk.y}; }
        CS_LWAIT();
    }
}

constexpr int CBUF = 16384, CNBUF = 5, C_YOFF = CNBUF * CBUF, C_YBUF = 16 * 64 * 4;
static_assert(C_YOFF + 2 * C_YBUF <= RING_BYTES, "chunked scan LDS map");
DI void cscan_item(LAS unsigned char* lds, const unsigned char* OPS, const float* G15, const float* PROJ, const float* mu, float* Y, float* fin, int chain, int tid, int wave, int lane) {
    const int bb = chain >> 3, hd = chain & 7, i = lane & 15, q = lane >> 4, rowbase = 16 * (wave & 3);
    const bool comp = wave < 4;
    const size_t m0 = (size_t)bb * SEQ, task0 = (size_t)chain * NCHUNK;
    const char* sp[2]; unsigned sstr[2];
#pragma unroll
    for (int k2 = 0; k2 < 2; ++k2) { int slot = wave + 8 * k2; if (slot == 15) slot = 0;
        if (slot < 10) { sp[k2] = (const char*)(OPS + (task0 * 10 + slot) * 1024 + lane * 16); sstr[k2] = OPS_TASK; }
        else if (slot == 10) { sp[k2] = (const char*)(G15 + task0 * 64) + (lane & 15) * 16; sstr[k2] = 256; }
        else { sp[k2] = (const char*)(PROJ + (m0 + 4 * (slot - 11) + (lane >> 4)) * INP + (INC - RWC) + 1024 + hd * 64) + (lane & 15) * 16; sstr[k2] = 16 * INP * 4; } }
    const float muv = ((const GAS float*)mu)[1024 + hd * 64 + rowbase + i];
#define CS_DMA(c) do { const int cn_ = min((c), NCHUNK - 1); LAS unsigned char* db_ = lds + ((c) % CNBUF) * CBUF + wave * 1024; _Pragma("unroll") for (int k2 = 0; k2 < 2; ++k2) \
        __builtin_amdgcn_global_load_lds((const GAS unsigned*)(sp[k2] + (size_t)cn_ * sstr[k2]), (LAS unsigned*)(db_ + k2 * 8192), 16, 0, 0); } while (0)
#define CS_DMAK(c, kbuf) do { const int cn_ = min((c), NCHUNK - 1); LAS unsigned char* db_ = lds + (kbuf) * CBUF + wave * 1024; _Pragma("unroll") for (int k2 = 0; k2 < 2; ++k2) \
        __builtin_amdgcn_global_load_lds((const GAS unsigned*)(sp[k2] + (size_t)cn_ * sstr[k2]), (LAS unsigned*)(db_ + k2 * 8192), 16, 0, 0); } while (0)
#define CS_FLUSH(cc) do { const int t_ = (tid - 256) >> 4, c4_ = (tid - 256) & 15; \
        *(GAS f4*)(Y + (m0 + (size_t)(cc) * 16 + t_) * RWD + hd * 64 + 4 * c4_) = *(const LAS f4*)(lds + C_YOFF + ((cc) & 1) * C_YBUF + (t_ * 64 + 4 * c4_) * 4); } while (0)
    CS_DMA(0); CS_DMA(1); CS_DMA(2);
    asm volatile("s_waitcnt vmcnt(4) lgkmcnt(0)" ::: "memory"); __builtin_amdgcn_s_barrier(); asm volatile("" ::: "memory");
    f4 sacc[4];
#pragma unroll
    for (int dt = 0; dt < 4; ++dt) sacc[dt] = (f4){0.f, 0.f, 0.f, 0.f};
    for (int c0 = 0; c0 < NCHUNK; c0 += CNBUF) {
#pragma unroll
      for (int kb5 = 0; kb5 < CNBUF; ++kb5) {
        const int c = c0 + kb5; if (c >= NCHUNK) break;
        CS_DMAK(c + 3, (kb5 + 3) % CNBUF);
        if (comp) {
            const LAS unsigned char* buf = lds + kb5 * CBUF;
            const LAS unsigned char* fb = buf + lane * 16;
            bf16x8 sb0, sb1;
            { v4u w; w.x = cvtpk(sacc[0].x, sacc[0].y); w.y = cvtpk(sacc[0].z, sacc[0].w); w.z = cvtpk(sacc[1].x, sacc[1].y); w.w = cvtpk(sacc[1].z, sacc[1].w); sb0 = __builtin_bit_cast(bf16x8, w);
              w.x = cvtpk(sacc[2].x, sacc[2].y); w.y = cvtpk(sacc[2].z, sacc[2].w); w.z = cvtpk(sacc[3].x, sacc[3].y); w.w = cvtpk(sacc[3].z, sacc[3].w); sb1 = __builtin_bit_cast(bf16x8, w); }
            const LAS float* vp = (const LAS float*)(buf + 11 * 1024) + (4 * q) * 64 + rowbase + i;
            float vm1 = 0.f;
            if (q != 0) vm1 = vp[-64]; else if (c != 0) vm1 = ((const LAS float*)(lds + ((kb5 + CNBUF - 1) % CNBUF) * CBUF + 11 * 1024))[15 * 64 + rowbase + i];
            const float x0 = vp[0], x1 = vp[64], x2 = vp[128], x3 = vp[192];
            const float v0 = x0 + (vm1 - x0) * muv, v1 = x1 + (x0 - x1) * muv, v2 = x2 + (x1 - x2) * muv, v3 = x3 + (x2 - x3) * muv;
            const unsigned vlo = cvtpk(v0, v1), vhi = cvtpk(v2, v3);
            const bf16x8 uv0 = __builtin_bit_cast(bf16x8, (v4u){0u, 0u, vlo, vhi});
            f4 u = {0.f, 0.f, 0.f, 0.f};
            u = CS_MFMA(*(const LAS bf16x8*)(fb), sb0, u); u = CS_MFMA(*(const LAS bf16x8*)(fb + 1024), sb1, u); u = CS_MFMA(*(const LAS bf16x8*)(fb + 2048), uv0, u);
            const bf16x8 uv = __builtin_bit_cast(bf16x8, (v4u){cvtpk(u.x, u.y), cvtpk(u.z, u.w), vlo, vhi});
            f4 y = {0.f, 0.f, 0.f, 0.f};
            y = CS_MFMA(*(const LAS bf16x8*)(fb + 3072), sb0, y); y = CS_MFMA(*(const LAS bf16x8*)(fb + 4096), sb1, y); y = CS_MFMA(*(const LAS bf16x8*)(fb + 5120), uv, y);
            LAS float* yb = (LAS float*)(lds + C_YOFF + (c & 1) * C_YBUF) + (4 * q) * 64 + rowbase + i;
            yb[0] = y.x; yb[64] = y.y; yb[128] = y.z; yb[192] = y.w;
#pragma unroll
            for (int dt = 0; dt < 4; ++dt) { const f4 gg = *(const LAS f4*)(buf + 10 * 1024 + (16 * dt + 4 * q) * 4); sacc[dt] = CS_MFMA(*(const LAS bf16x8*)(fb + (6 + dt) * 1024), uv, sacc[dt] * gg); }
            asm volatile("s_waitcnt vmcnt(4) lgkmcnt(0)" ::: "memory");
        } else {
            if (c >= 1) CS_FLUSH(c - 1);
            if (c == 0) asm volatile("s_waitcnt vmcnt(4) lgkmcnt(0)" ::: "memory"); else if (c == 1) asm volatile("s_waitcnt vmcnt(5) lgkmcnt(0)" ::: "memory"); else asm volatile("s_waitcnt vmcnt(6) lgkmcnt(0)" ::: "memory");
        }
        __builtin_amdgcn_s_barrier(); asm volatile("" ::: "memory");
      }
    }
    if (!comp) CS_FLUSH(NCHUNK - 1);
    else {
        float* fo = fin + (size_t)chain * 4096 + (size_t)(rowbase + i) * 64 + 4 * q;
#pragma unroll
        for (int dt = 0; dt < 4; ++dt) *(GAS f4*)(fo + 16 * dt) = sacc[dt];
    }
#undef CS_DMA
#undef CS_FLUSH
    asm volatile("s_waitcnt vmcnt(0) lgkmcnt(0)" ::: "memory"); __builtin_amdgcn_s_barrier(); asm volatile("" ::: "memory");
}
}
namespace att {
constexpr int KSTEP_B = 1152, SUB_BYTES = 10 * KSTEP_B;
DI unsigned img_off(unsigned row, unsigned ch) { return (unsigned)KSTEP_B * (ch >> 1) + 32u * row + 16u * ((ch & 1u) ^ ((row >> 3) & 1u)); }
DI unsigned kvmap(unsigned r) { return (r & ~12u) | ((r & 4u) << 1) | ((r & 8u) >> 1); }
DI unsigned row_base(unsigned lane) { const unsigned kr = kvmap(lane & 31u), h = lane >> 5; return 32u * kr + 16u * (h ^ ((kr >> 3) & 1u)); }
DI unsigned tr_base(unsigned lane) { const unsigned h = lane >> 5, blk = (lane >> 4) & 1u, q = (lane & 15u) >> 2, p = lane & 3u;
    return (unsigned)KSTEP_B * blk + 32u * (8u * h + q) + 16u * ((p >> 1) ^ h) + 8u * (p & 1u); }
DI unsigned cvtpk(float lo, float hi) { typedef float f2 __attribute__((ext_vector_type(2))); typedef __bf16 b2 __attribute__((ext_vector_type(2))); f2 v = {lo, hi}; b2 b = __builtin_convertvector(v, b2); return __builtin_bit_cast(unsigned, b); }
DI s16x4 vtr(const LAS unsigned char* p) { typedef short v4i16_t __attribute__((ext_vector_type(4))); return __builtin_bit_cast(s16x4, __builtin_amdgcn_ds_read_tr16_b64_v4i16((LAS v4i16_t*)p)); }
#define ATT_MFMA(a, b, c) __builtin_amdgcn_mfma_f32_32x32x16_bf16((a), (b), (c), 0, 0, 0)

constexpr float DEFER_THR = 8.0f;
DI float xhalf_max(float v) { auto rr = __builtin_amdgcn_permlane32_swap(__float_as_uint(v), __float_as_uint(v), false, false); return fmaxf(__uint_as_float(rr[0]), __uint_as_float(rr[1])); }
DI float xhalf_sum(float v) { auto rr = __builtin_amdgcn_permlane32_swap(__float_as_uint(v), __float_as_uint(v), false, false); return __uint_as_float(rr[0]) + __uint_as_float(rr[1]); }
DI bf16x8 pack8(const f32x16& x, int s) { v4u w; w.x = cvtpk(x[8 * s], x[8 * s + 1]); w.y = cvtpk(x[8 * s + 2], x[8 * s + 3]); w.z = cvtpk(x[8 * s + 4], x[8 * s + 5]); w.w = cvtpk(x[8 * s + 6], x[8 * s + 7]); return __builtin_bit_cast(bf16x8, w); }

template <bool MASK>
DI void subtile(const LAS unsigned char* img, const bf16x8 (&qf)[10], float& mrun, float& lrun, f32x16 (&o)[4], int lane, int qlim) {
    __builtin_amdgcn_sched_barrier(0);
    const unsigned h = lane >> 5;
    const LAS unsigned char* rb = img + row_base(lane); const LAS unsigned char* tb = img + tr_base(lane);
    f32x16 x;
#pragma unroll
    for (int i = 0; i < 16; ++i) x[i] = 0.f;
#pragma unroll
    for (int s = 0; s < 10; ++s) { const bf16x8 a = *(const LAS bf16x8*)(rb + KSTEP_B * s); x = ATT_MFMA(a, qf[s], x); }
    if (MASK) {
#pragma unroll
        for (int i = 0; i < 16; ++i) { const int kv = 16 * (i >> 3) + 8 * (int)h + (i & 7); if (kv > qlim) x[i] = -1e30f; }
    }
    float mx = x[0];
#pragma unroll
    for (int i = 1; i < 16; ++i) mx = fmaxf(mx, x[i]);
    mx = xhalf_max(mx);
    if (!__all(mx - mrun <= DEFER_THR)) {
        const float mn = fmaxf(mrun, mx), corr = __builtin_amdgcn_exp2f(mrun - mn); mrun = mn; lrun *= corr;
#pragma unroll
        for (int d = 0; d < 4; ++d)
#pragma unroll
            for (int i = 0; i < 16; ++i) o[d][i] *= corr;
    }
    float ls = 0.f;
#pragma unroll
    for (int i = 0; i < 16; ++i) { x[i] = __builtin_amdgcn_exp2f(x[i] - mrun); ls += x[i]; }
    lrun += ls;
    const bf16x8 pb0 = pack8(x, 0), pb1 = pack8(x, 1);
#pragma unroll
    for (int d = 0; d < 4; ++d) {
        { const s16x4 lo = vtr(tb + 2 * KSTEP_B * d), hi = vtr(tb + 2 * KSTEP_B * d + 128); o[d] = ATT_MFMA(__builtin_shufflevector(lo, hi, 0, 1, 2, 3, 4, 5, 6, 7), pb0, o[d]); }
        { const s16x4 lo = vtr(tb + 2 * KSTEP_B * d + 512), hi = vtr(tb + 2 * KSTEP_B * d + 512 + 128); o[d] = ATT_MFMA(__builtin_shufflevector(lo, hi, 0, 1, 2, 3, 4, 5, 6, 7), pb1, o[d]); }
    }
}
DI void tile64(const LAS unsigned char* img, const bf16x8 (&qf)[10], float& mrun, float& lrun, f32x16 (&o)[4], int lane) {
    __builtin_amdgcn_sched_barrier(0);
    const LAS unsigned char* rb = img + row_base(lane); const LAS unsigned char* tb = img + tr_base(lane);
    f32x16 p0, p1;
#pragma unroll
    for (int i = 0; i < 16; ++i) { p0[i] = 0.f; p1[i] = 0.f; }
#pragma unroll
    for (int s = 0; s < 10; ++s) {
        const bf16x8 a0 = *(const LAS bf16x8*)(rb + KSTEP_B * s), a1 = *(const LAS bf16x8*)(rb + SUB_BYTES + KSTEP_B * s);
        p0 = ATT_MFMA(a0, qf[s], p0); p1 = ATT_MFMA(a1, qf[s], p1);
    }
    float mx = fmaxf(p0[0], p1[0]);
#pragma unroll
    for (int i = 1; i < 16; ++i) mx = fmaxf(mx, fmaxf(p0[i], p1[i]));
    mx = xhalf_max(mx);
    if (!__all(mx - mrun <= DEFER_THR)) {
        const float mn = fmaxf(mrun, mx), corr = __builtin_amdgcn_exp2f(mrun - mn); mrun = mn; lrun *= corr;
#pragma unroll
        for (int d = 0; d < 4; ++d)
#pragma unroll
            for (int i = 0; i < 16; ++i) o[d][i] *= corr;
    }
    float ls = 0.f;
#pragma unroll
    for (int i = 0; i < 16; ++i) { p0[i] = __builtin_amdgcn_exp2f(p0[i] - mrun); ls += p0[i]; }
    const bf16x8 pa = pack8(p0, 0), pb = pack8(p0, 1);
#pragma unroll
    for (int d = 0; d < 4; ++d) {
        { const s16x4 lo = vtr(tb + 2 * KSTEP_B * d), hi = vtr(tb + 2 * KSTEP_B * d + 128); o[d] = ATT_MFMA(__builtin_shufflevector(lo, hi, 0, 1, 2, 3, 4, 5, 6, 7), pa, o[d]); }
        { const s16x4 lo = vtr(tb + 2 * KSTEP_B * d + 512), hi = vtr(tb + 2 * KSTEP_B * d + 512 + 128); o[d] = ATT_MFMA(__builtin_shufflevector(lo, hi, 0, 1, 2, 3, 4, 5, 6, 7), pb, o[d]); }
    }
#pragma unroll
    for (int i = 0; i < 16; ++i) { p1[i] = __builtin_amdgcn_exp2f(p1[i] - mrun); ls += p1[i]; }
    lrun += ls;
    const bf16x8 pc = pack8(p1, 0), pd = pack8(p1, 1);
#pragma unroll
    for (int d = 0; d < 4; ++d) {
        { const s16x4 lo = vtr(tb + SUB_BYTES + 2 * KSTEP_B * d), hi = vtr(tb + SUB_BYTES + 2 * KSTEP_B * d + 128); o[d] = ATT_MFMA(__builtin_shufflevector(lo, hi, 0, 1, 2, 3, 4, 5, 6, 7), pc, o[d]); }
        { const s16x4 lo = vtr(tb + SUB_BYTES + 2 * KSTEP_B * d + 512), hi = vtr(tb + SUB_BYTES + 2 * KSTEP_B * d + 512 + 128); o[d] = ATT_MFMA(__builtin_shufflevector(lo, hi, 0, 1, 2, 3, 4, 5, 6, 7), pd, o[d]); }
    }
}

DI void prompt_unit(LAS unsigned char* lds, const bf16* QB, const bf16* CKVB, const bf16* KRB, bf16* OM, int b, int qblk, int tid, int wave, int lane) {
    const int r = lane & 31, h = lane >> 5;
    const int row0 = b * SEQ + qblk * 32, kb = b * SEQ;
    bf16x8 qf[10];
    { const bf16* qp = QB + (size_t)(row0 + r) * 1280 + wave * 160 + 8 * h;
#pragma unroll
      for (int s = 0; s < 10; ++s) qf[s] = *(const GAS bf16x8*)(qp + 16 * s); }
    f32x16 o[4];
#pragma unroll
    for (int d = 0; d < 4; ++d)
#pragma unroll
        for (int i = 0; i < 16; ++i) o[d][i] = 0.f;
    float mrun = -1e30f, lrun = 0.f;
    const int nsub = qblk + 1, ntile = (nsub + 1) >> 1;
    const int lrow0 = tid >> 4, lch = tid & 15, lrow1 = lrow0 + 32;
    const unsigned ld0 = (unsigned)(lrow0 >> 5) * SUB_BYTES + img_off(lrow0 & 31, lch), ld1 = (unsigned)(lrow1 >> 5) * SUB_BYTES + img_off(lrow1 & 31, lch);
    const int rrow = tid >> 2, rc = tid & 3; const unsigned rd = (unsigned)(rrow >> 5) * SUB_BYTES + img_off(rrow & 31, 16 + rc);
    const bf16* g0 = CKVB + (size_t)(kb + lrow0) * KVR + lch * 8; const bf16* g1 = CKVB + (size_t)(kb + lrow1) * KVR + lch * 8; const bf16* g2 = KRB + (size_t)(kb + rrow) * RD + rc * 8;
    v4u s0 = *(const GAS v4u*)g0, s1 = *(const GAS v4u*)g1, s2 = (tid < 256) ? *(const GAS v4u*)g2 : (v4u){0u, 0u, 0u, 0u};
    *(LAS v4u*)(lds + ld0) = s0; *(LAS v4u*)(lds + ld1) = s1; if (tid < 256) *(LAS v4u*)(lds + rd) = s2;
    __syncthreads();
    const int nfull = qblk >> 1;
#define PU_LOAD(tn) do { const size_t adv = (size_t)(tn) * 64; s0 = *(const GAS v4u*)(g0 + adv * KVR); s1 = *(const GAS v4u*)(g1 + adv * KVR); if (tid < 256) s2 = *(const GAS v4u*)(g2 + adv * RD); } while (0)
#define PU_WRITE(par) do { LAS unsigned char* nb = lds + (par) * (2 * SUB_BYTES); *(LAS v4u*)(nb + ld0) = s0; *(LAS v4u*)(nb + ld1) = s1; if (tid < 256) *(LAS v4u*)(nb + rd) = s2; } while (0)
    for (int t = 0; t < nfull; ++t) {
        PU_LOAD(t + 1);
        const LAS unsigned char* img = lds + (t & 1) * (2 * SUB_BYTES);
        tile64(img, qf, mrun, lrun, o, lane);
        PU_WRITE((t + 1) & 1); __syncthreads();
    }
    { const LAS unsigned char* img = lds + (nfull & 1) * (2 * SUB_BYTES);
      if (qblk & 1) { subtile<false>(img, qf, mrun, lrun, o, lane, 0); img += SUB_BYTES; }
      subtile<true>(img, qf, mrun, lrun, o, lane, r);
      __syncthreads(); }
#undef PU_LOAD
#undef PU_WRITE
    const float inv = 1.f / xhalf_sum(lrun);
    bf16* op = OM + (size_t)(row0 + r) * 1536 + wave * 128 + 4 * h;
#pragma unroll
    for (int d = 0; d < 4; ++d)
#pragma unroll
        for (int g = 0; g < 4; ++g)
            *(GAS v2u*)(op + 32 * d + 8 * g) = (v2u){pk2(o[d][4 * g] * inv, o[d][4 * g + 1] * inv), pk2(o[d][4 * g + 2] * inv, o[d][4 * g + 3] * inv)};
}

DI void sample_unit(LAS unsigned char* lds, const bf16* QB, const bf16* CKVB, const bf16* KRB, const float* cckv, const float* ckr, const int* ptab, float* PO, float* PML,
                    int b, int sp, int tid, int wave, int lane) {
    const int r = lane & 31, h = lane >> 5, qt = wave & 1, ks = wave >> 1;
    const int qr = 32 * qt + r, tq = qr >> 3, hd = qr & 7;
    bf16x8 qf[10];
    { const bf16* qp = QB + (size_t)(MP + b * DS + tq) * 1280 + hd * 160 + 8 * h;
#pragma unroll
      for (int s = 0; s < 10; ++s) qf[s] = *(const GAS bf16x8*)(qp + 16 * s); }
    f32x16 o[4];
#pragma unroll
    for (int d = 0; d < 4; ++d)
#pragma unroll
        for (int i = 0; i < 16; ++i) o[d][i] = 0.f;
    float mrun = -1e30f, lrun = 0.f;
    constexpr int PBUF = 4 * SUB_BYTES;
    unsigned ldl[4];
#pragma unroll
    for (int i = 0; i < 4; ++i) { const int row = (tid >> 4) + 32 * i; ldl[i] = (unsigned)(row >> 5) * SUB_BYTES + img_off(row & 31, tid & 15); }
    const int rrow = tid >> 2; const unsigned ldr = (unsigned)(rrow >> 5) * SUB_BYTES + img_off(rrow & 31, 16 + (tid & 3));
    const int* pt = ptab + b * NPAGE + sp * 64;
    f32x4 sl[8], sr[2];
    { const int pg = pt[0]; const float* pl = cckv + (size_t)pg * (PAGE * KVR) + (size_t)(tid >> 4) * KVR + (tid & 15) * 8; const float* prp = ckr + (size_t)pg * (PAGE * RD) + (size_t)rrow * RD + (tid & 3) * 4;
#pragma unroll
      for (int i = 0; i < 4; ++i) { sl[2 * i] = *(const GAS f32x4*)(pl + (size_t)i * 32 * KVR); sl[2 * i + 1] = *(const GAS f32x4*)(pl + (size_t)i * 32 * KVR + 4); }
      sr[0] = *(const GAS f32x4*)prp; sr[1] = *(const GAS f32x4*)(prp + 16); }
#define SAMP_WRITE(buf) do { _Pragma("unroll") for (int i = 0; i < 4; ++i) *(LAS v4u*)((buf) + ldl[i]) = (v4u){cvtpk(sl[2*i].x, sl[2*i].y), cvtpk(sl[2*i].z, sl[2*i].w), cvtpk(sl[2*i+1].x, sl[2*i+1].y), cvtpk(sl[2*i+1].z, sl[2*i+1].w)}; \
        *(LAS v4u*)((buf) + ldr) = (v4u){cvtpk(sr[0].x, sr[1].x), cvtpk(sr[0].y, sr[1].y), cvtpk(sr[0].z, sr[1].z), cvtpk(sr[0].w, sr[1].w)}; } while (0)
    SAMP_WRITE(lds);
    __syncthreads();
    for (int p = 0; p < 64; ++p) {
        const bool more = p + 1 < 64;
        if (more) { const int pg = pt[p + 1]; const float* pl = cckv + (size_t)pg * (PAGE * KVR) + (size_t)(tid >> 4) * KVR + (tid & 15) * 8; const float* prp = ckr + (size_t)pg * (PAGE * RD) + (size_t)rrow * RD + (tid & 3) * 4;
#pragma unroll
            for (int i = 0; i < 4; ++i) { sl[2 * i] = *(const GAS f32x4*)(pl + (size_t)i * 32 * KVR); sl[2 * i + 1] = *(const GAS f32x4*)(pl + (size_t)i * 32 * KVR + 4); }
            sr[0] = *(const GAS f32x4*)prp; sr[1] = *(const GAS f32x4*)(prp + 16); }
        subtile<false>(lds + (p & 1) * PBUF + ks * SUB_BYTES, qf, mrun, lrun, o, lane, 0);
        if (more) { LAS unsigned char* nb = lds + ((p + 1) & 1) * PBUF; SAMP_WRITE(nb); }
        __syncthreads();
    }
#undef SAMP_WRITE
    if (sp == 0) {
        LAS unsigned char* nb = lds;
        { const int row = tid >> 4, ch = tid & 15; v4u v = {0u, 0u, 0u, 0u}; if (row < DS) v = *(const GAS v4u*)(CKVB + (size_t)(MP + b * DS + row) * KVR + ch * 8); *(LAS v4u*)(nb + img_off(row, ch)) = v; }
        if (tid < 128) { const int row = tid >> 2, c = tid & 3; v4u v = {0u, 0u, 0u, 0u}; if (row < DS) v = *(const GAS v4u*)(KRB + (size_t)(MP + b * DS + row) * RD + c * 8); *(LAS v4u*)(nb + img_off(row, 16 + c)) = v; }
        __syncthreads();
        if (ks == 0) subtile<true>(nb, qf, mrun, lrun, o, lane, tq);
        __syncthreads();
    }
    const float lt = xhalf_sum(lrun);
    const int idx = b * 8 + sp * 4 + ks;
    if (h == 0) ((GAS f32x2*)PML)[(size_t)idx * 64 + qr] = (f32x2){mrun, lt};
    float* op = PO + ((size_t)idx * 64 + qr) * 128 + 4 * h;
#pragma unroll
    for (int d = 0; d < 4; ++d)
#pragma unroll
        for (int g = 0; g < 4; ++g) *(GAS f32x4*)(op + 32 * d + 8 * g) = (f32x4){o[d][4 * g], o[d][4 * g + 1], o[d][4 * g + 2], o[d][4 * g + 3]};
}
}

DI float rowsum16(float v) {
    v += __builtin_bit_cast(float, __builtin_amdgcn_update_dpp(0, __builtin_bit_cast(int, v), 0x128, 0xf, 0xf, false));
    v += __builtin_bit_cast(float, __builtin_amdgcn_update_dpp(0, __builtin_bit_cast(int, v), 0x124, 0xf, 0xf, false));
    v += __builtin_bit_cast(float, __builtin_amdgcn_update_dpp(0, __builtin_bit_cast(int, v), 0x122, 0xf, 0xf, false));
    v += __builtin_bit_cast(float, __builtin_amdgcn_update_dpp(0, __builtin_bit_cast(int, v), 0x121, 0xf, 0xf, false));
    return v;
}
constexpr int SCAN_STRIDE = 340, SCAN_CHUNK = 16, SCAN_PIECES = 85, SCAN_NBUF = 5, SCAN_AHEAD = 3;
constexpr int SCAN_BUF = 1536 * 16, SCAN_YOFF = SCAN_NBUF * SCAN_BUF, SCAN_YBUF = SCAN_CHUNK * 16 * 4;
static_assert(SCAN_YOFF + 2 * SCAN_YBUF <= RING_BYTES && SCAN_CHUNK * SCAN_PIECES <= 1536, "scan LDS map");
DI float dot4(const f32x4& x, const f32x4& y) { return fmaf(x.y, y.y, x.x * y.x) + fmaf(x.w, y.w, x.z * y.z); }
template <int VAR> DI void scan_item(LAS unsigned char* lds, const float* SC5, const float* RKV, const float* SCAL, float* Y, const float* init, float* fin, int m0, int T, int hd, int quarter, int tid, int wave, int lane) {
    constexpr size_t ASZ = (size_t)M * RWD;
    const int j = lane & 15, rowl = (wave & 3) * 4 + (lane >> 4), row = quarter * 16 + rowl;
    const bool isA = wave < 4;
    const int nchunk = (T + SCAN_CHUNK - 1) / SCAN_CHUNK, nst0 = min(SCAN_CHUNK, T);
    const char* sp[3]; unsigned sstr[3];
#pragma unroll
    for (int i = 0; i < 3; ++i) { int q = tid + 512 * i; if (q >= nst0 * SCAN_PIECES) q = 0;
        const int st = q / SCAN_PIECES, pc = q - st * SCAN_PIECES; const size_t mm = (size_t)(m0 + st); const float* src;
        if (pc < 80) { src = SC5 + (size_t)(pc >> 4) * ASZ + mm * RWD + hd * 64 + (pc & 15) * 4; sstr[i] = SCAN_CHUNK * RWD * 4; }
        else if (pc < 84) { src = RKV + mm * 1536 + 1024 + hd * 64 + quarter * 16 + (pc - 80) * 4; sstr[i] = SCAN_CHUNK * 1536 * 4; }
        else { src = SCAL + (mm * 8 + hd) * 4; sstr[i] = SCAN_CHUNK * 32 * 4; }
        sp[i] = (const char*)src; }
#define SCAN_DMA(c) do { const int cn_ = min((c), nchunk - 1); LAS unsigned char* db_ = lds + ((c) % SCAN_NBUF) * SCAN_BUF + wave * 1024; _Pragma("unroll") for (int i = 0; i < 3; ++i) \
        __builtin_amdgcn_global_load_lds((const GAS unsigned*)(sp[i] + (size_t)cn_ * sstr[i]), (LAS unsigned*)(db_ + i * 8192), 16, 0, 0); } while (0)
#define SCAN_WAIT_BAR() do { asm volatile("s_waitcnt vmcnt(3) lgkmcnt(0)" ::: "memory"); __builtin_amdgcn_s_barrier(); asm volatile("" ::: "memory"); } while (0)
    SCAN_DMA(0); SCAN_DMA(1); SCAN_DMA(2);
    asm volatile("s_waitcnt vmcnt(3) lgkmcnt(0)" ::: "memory"); __builtin_amdgcn_s_barrier(); asm volatile("" ::: "memory");
    f32x4 s = (f32x4){0.f, 0.f, 0.f, 0.f}, t, bq; float sa = 0.f, P1 = 0.f, P2 = 0.f, ypv = 0.f, br16 = 0.f;
    f32x4 cw, ck, cwr, cb4, ca; float cvv = 0.f; f32x2 csc;
#define SCAN_OP(g, off) (*(const LAS f32x4*)(lds + (((g) >> 4) % SCAN_NBUF) * SCAN_BUF + ((g) & 15) * (SCAN_STRIDE * 4) + (off) * 4 + 16 * j))
    if (isA) {
        if (init) s = *(const GAS f32x4*)(init + (size_t)row * 64 + 4 * j);
        const f32x4 a0 = SCAN_OP(0, 0), wr0 = SCAN_OP(0, 64), w0 = SCAN_OP(0, 128), b0 = SCAN_OP(0, 192), k0 = SCAN_OP(0, 256), a1 = SCAN_OP(1, 0);
        const LAS float* m0p = (const LAS float*)lds; const float vv0 = m0p[320 + rowl]; const f32x2 sc0 = *(const LAS f32x2*)(m0p + 336);
        sa = rowsum16(dot4(s, a0));
        t = s * w0 + k0 * vv0; bq = b0;
        P2 = dot4(t, a1); P1 = dot4(b0, a1);
        ypv = fmaf(vv0, sc0.y, dot4(s, wr0)); br16 = sc0.x;
        cw = SCAN_OP(1, 128); ck = SCAN_OP(1, 256); cwr = SCAN_OP(1, 64); cb4 = SCAN_OP(1, 192); ca = SCAN_OP(2, 0);
        { const LAS float* p1 = (const LAS float*)(lds + SCAN_STRIDE * 4); cvv = p1[320 + rowl]; csc = *(const LAS f32x2*)(p1 + 336); }
    }
    for (int c = 0; c < nchunk; ++c) {
        SCAN_DMA(c + SCAN_AHEAD);
        if (!isA && c >= 1) {
            const int cc = c - 1, t_ = tid - 256, st = t_ >> 4, r16 = t_ & 15;
            if (st < min(SCAN_CHUNK, T - cc * SCAN_CHUNK))
                Y[(size_t)(m0 + cc * SCAN_CHUNK + st) * RWD + hd * 64 + quarter * 16 + r16] = *(const LAS float*)(lds + SCAN_YOFF + (cc & 1) * SCAN_YBUF + (st * 16 + r16) * 4);
        }
        if (isA) {
            const int nst = min(SCAN_CHUNK, T - c * SCAN_CHUNK);
            const LAS unsigned char* b0p = lds + (c % SCAN_NBUF) * SCAN_BUF + 16 * j; const LAS unsigned char* b1p = lds + ((c + 1) % SCAN_NBUF) * SCAN_BUF + 16 * j;
            LAS float* yb = (LAS float*)(lds + SCAN_YOFF + (c & 1) * SCAN_YBUF) + rowl;
#pragma unroll
            for (int st = 0; st < SCAN_CHUNK; ++st) {
                if (st >= nst) break;
                const LAS unsigned char* q2 = (st + 2 < SCAN_CHUNK ? b0p + (st + 2) * (SCAN_STRIDE * 4) : b1p + (st + 2 - SCAN_CHUNK) * (SCAN_STRIDE * 4));
                const LAS unsigned char* q3 = (st + 3 < SCAN_CHUNK ? b0p + (st + 3) * (SCAN_STRIDE * 4) : b1p + (st + 3 - SCAN_CHUNK) * (SCAN_STRIDE * 4));
                const f32x4 nw = *(const LAS f32x4*)(q2 + 512), nk = *(const LAS f32x4*)(q2 + 1024), nwr = *(const LAS f32x4*)(q2 + 256), nb4 = *(const LAS f32x4*)(q2 + 768), na = *(const LAS f32x4*)(q3);
                const float nvv = *(const LAS float*)(q2 - 16 * j + (320 + rowl) * 4); const f32x2 nsc = *(const LAS f32x2*)(q2 - 16 * j + 336 * 4);
                float part = fmaf(sa, P1, P2);
                float yp = fmaf(sa, br16, ypv);
                s = bq * sa + t;
                if (VAR == 3) { part *= 0.99f; yp *= 0.99f; } else if (VAR == 2) { part = rowsum16(part); yp *= 0.99f; } else { part = rowsum16(part); yp = rowsum16(yp); }
                yb[st * 16] = yp;
                t = s * cw + ck * cvv; bq = cb4;
                P2 = dot4(t, ca); P1 = dot4(cb4, ca);
                ypv = fmaf(cvv, csc.y, dot4(s, cwr)); br16 = csc.x;
                sa = part;
                cw = nw; ck = nk; cwr = nwr; cb4 = nb4; ca = na; cvv = nvv; csc = nsc;
            }
        }
        if (isA || c == 0) asm volatile("s_waitcnt vmcnt(3) lgkmcnt(0)" ::: "memory"); else if (c == 1) asm volatile("s_waitcnt vmcnt(4) lgkmcnt(0)" ::: "memory"); else asm volatile("s_waitcnt vmcnt(5) lgkmcnt(0)" ::: "memory");
        __builtin_amdgcn_s_barrier(); asm volatile("" ::: "memory");
    }
    if (!isA) { const int cc = nchunk - 1, t_ = tid - 256, st = t_ >> 4, r16 = t_ & 15;
        if (st < min(SCAN_CHUNK, T - cc * SCAN_CHUNK))
            Y[(size_t)(m0 + cc * SCAN_CHUNK + st) * RWD + hd * 64 + quarter * 16 + r16] = *(const LAS float*)(lds + SCAN_YOFF + (cc & 1) * SCAN_YBUF + (st * 16 + r16) * 4); }
#undef SCAN_DMA
#undef SCAN_WAIT_BAR
#undef SCAN_OP
    if (isA) *(GAS f32x4*)(fin + (size_t)row * 64 + 4 * j) = s;
    asm volatile("s_waitcnt vmcnt(0) lgkmcnt(0)" ::: "memory"); __builtin_amdgcn_s_barrier(); asm volatile("" ::: "memory");
}

constexpr int Q_PSCAN = 32, Q_SATT = 256, Q_PATT = 1024, Q_SSCAN = 4096, Q_PTOTAL = Q_PSCAN + Q_PATT + Q_SSCAN;
template <int MODE, int VAR> DI void mixer_phase(const Ptrs& P, LAS unsigned char* lds, volatile LAS unsigned* MISC, gu32* ctl, int tid, int wave, int lane) {
    unsigned char* ws = P.ws;
    const bf16* QB = (const bf16*)(ws + WS_QB); const bf16* CKVB = (const bf16*)(ws + WS_CKVB); const bf16* KRB = (const bf16*)(ws + WS_KRB); bf16* OM = (bf16*)(ws + WS_OM);
    const float* SC5 = (const float*)(ws + WS_SC5); const float* RKV = (const float*)(ws + WS_RKV); const float* SCAL = (const float*)(ws + WS_SCAL); float* Y = (float*)(ws + WS_Y);
#define Q_POP(var, word) do { if (tid == 0) MISC[0] = __hip_atomic_fetch_add(ctl + CW_QHEAD + (word), 1u, RLX_AGENT); __syncthreads(); var = (int)MISC[0]; __syncthreads(); var = __builtin_amdgcn_readfirstlane(var); } while (0)
    int is_ = Q_SATT, it;
    if ((MODE == 0) && (blockIdx.x & 3) == 0) {
        Q_POP(is_, 16);
        while (is_ < Q_SATT) {
            att::sample_unit(lds, QB, CKVB, KRB, P.in[2], P.in[3], (const int*)P.in[6], (float*)(ws + WS_PO), (float*)(ws + WS_PML), is_ >> 1, is_ & 1, tid, wave, lane);
            Q_POP(is_, 16); }
    }
    Q_POP(it, 0);
    if (MODE == 0 || MODE == 1)
    while (it < Q_PSCAN) {
        if (VAR == 0) cs::cscan_item(lds, ws + WS_OPS, (const float*)(ws + WS_G15), (const float*)(ws + WS_PROJ), P.in[18], Y, P.out + O_WKVP, it, tid, wave, lane);
        else cs::cscan_item(lds, ws + WS_OPS, (const float*)(ws + WS_G15), (const float*)(ws + WS_PROJ), P.in[18], (float*)(ws + WS_END), (float*)(ws + WS_END + 80 * MiB), it, tid, wave, lane);
        Q_POP(it, 0); }
    if (MODE == 3) { while (it < Q_PSCAN) Q_POP(it, 0); }
    if (MODE == 0 || MODE == 3)
    while (it < Q_PSCAN + Q_PATT) {
        const int u = it - Q_PSCAN; att::prompt_unit(lds, QB, CKVB, KRB, OM, u & 3, 255 - (u >> 2), tid, wave, lane);
        Q_POP(it, 0); }
    if (MODE == 0)
    while (it < Q_PTOTAL) {
        const int u = it - Q_PSCAN - Q_PATT, ch = u >> 2, qtr = u & 3, b = ch >> 3, hd = ch & 7;
        scan_item<0>(lds, SC5, RKV, SCAL, Y, P.in[4] + (size_t)ch * 4096, P.out + O_WKVS + (size_t)ch * 4096, MP + b * DS, DS, hd, qtr, tid, wave, lane);
        Q_POP(it, 0); }
    if (MODE == 0 || MODE == 2) {
        Q_POP(is_, 16);
        while (is_ < Q_SATT) {
            att::sample_unit(lds, QB, CKVB, KRB, P.in[2], P.in[3], (const int*)P.in[6], (float*)(ws + WS_PO), (float*)(ws + WS_PML), is_ >> 1, is_ & 1, tid, wave, lane);
            Q_POP(is_, 16); }
    }
#undef Q_POP
}
constexpr int N_PHASES = 15;
#ifndef MK_REP_MIX
#define MK_REP_MIX 1
#endif
#ifndef MK_DUP_PH
#define MK_DUP_PH -1
#endif
#define DUP_PH(k, ...) do { if (MK_DUP_PH == (k)) { xcd_barrier(bar); __VA_ARGS__ } } while (0)
#ifndef MK_DUP_VAR
#define MK_DUP_VAR 0
#endif
#ifndef MK_DUP_MODE
#define MK_DUP_MODE 0
#endif
#ifndef MK_REP_EW
#define MK_REP_EW 1
#endif
#ifndef MK_REP_GEMM
#define MK_REP_GEMM 1
#endif
#define DUP_1(...)
#define DUP_2(...) xcd_barrier(bar); __VA_ARGS__
#define DUP_CAT(a, b) a##b
#define DUP_SEL(n) DUP_CAT(DUP_, n)

__global__ void __launch_bounds__(NWAVES * 64, 2) mk_fwd(Args args) {
    extern __shared__ __attribute__((aligned(16))) unsigned char lds_raw[];
    LAS unsigned char* lds = (LAS unsigned char*)lds_raw;
    volatile LAS unsigned* MISC = (volatile LAS unsigned*)(lds + MISC_OFF);
    const int tid = threadIdx.x, lane = tid & 63, wave = __builtin_amdgcn_readfirstlane(tid >> 6);
    const int G = gridDim.x, bx = blockIdx.x;
    const int gw = bx * NWAVES + wave, NGW = G * NWAVES;
    unsigned char* ws = args.ws;
#define P (*args_here())
    gu32* ctl = (gu32*)(ws + WS_CTL);
    for (int u = tid; u < (LDS_BYTES - LDSCTL_OFF) / 4; u += NWAVES * 64) ((LAS unsigned*)(lds + LDSCTL_OFF))[u] = 0u;
    __syncthreads();
    const int lo = args.ph_lo, hi = args.ph_hi;
    const bool one_launch = (hi - lo) > 1;
    XcdBarrier bar; bar.bar = (unsigned*)(ctl + CW_BAR); bar.x = 0; bar.st = nullptr;
    if (one_launch) bar = xcd_barrier_post((unsigned*)(ctl + CW_BAR), MISC + 8);
#ifndef MK_ONLY
#define MK_ONLY -1
#endif
#define IN(k) ((MK_ONLY < 0 || (k) == MK_ONLY) && lo <= (k) && (k) < hi)
#define SEAM(k) do { if (IN(k) && IN((k) + 1)) xcd_barrier(bar); } while (0)
    bf16* XNB = (bf16*)(ws + WS_XNB); bf16* HB = (bf16*)(ws + WS_HB); float* Z = (float*)(ws + WS_Z); float* X1 = (float*)(ws + WS_X1); float* X2 = (float*)(ws + WS_X2);
    const float* cosT = (const float*)(ws + WS_ROPE); const float* sinT = cosT + ROPE_N * 16;

    if (IN(0)) { p0_prologue(P, lds, gw, NGW, wave, lane); DUP_PH(0, p0_prologue(P, lds, gw, NGW, wave, lane);); SEAM(0); }
#define PH1_BODY do {    \
        pg8::Gemm g{XNB, (const bf16*)(ws + WS_WGUA), M, 2 * FF, DM}; pg8::StaticOrder S; S.init(M, 2 * FF, G, bx); \
        pg8::EpiSwiGLU E{HB, FF}; \
        pg8::gemm_phase<pg8::EpiSwiGLU, pg8::StaticOrder, true, true>(lds + RING_OFF, g, S, E); } while (0)
    if (IN(1)) { PH1_BODY; DUP_PH(1, PH1_BODY;); DUP_SEL(MK_REP_GEMM)(PH1_BODY;) SEAM(1); }
#define SPLIT_BODY(Aop, Wop, KFULL) do { int k256 = 256; asm volatile("" : "+s"(k256)); \
        pg8::Gemm g{Aop, Wop, M, DM, k256, KFULL}; pg8::SplitOrder S; S.init(MS / 256, DM / 256, (KFULL) / 256, MP / 256, G, bx); \
        pg8::EpiPart E{(float*)(ws + WS_PART), DM, MP, (size_t)MS * DM}; \
        pg8::gemm_phase<pg8::EpiPart, pg8::SplitOrder, true, true>(lds + RING_OFF, g, S, E); } while (0)
#define PH2_BODY do {    \
        { pg8::Gemm g{HB, (const bf16*)(ws + WS_WDA), MP, DM, FF, 0}; pg8::StaticOrder S; S.init(MP, DM, G, bx); \
          pg8::EpiResid E{P.in[0], P.in[0], MP, Z, DM, ALPHA, 0.5f}; \
          pg8::gemm_phase<pg8::EpiResid, pg8::StaticOrder, true, true>(lds + RING_OFF, g, S, E); } \
        SPLIT_BODY(HB, (const bf16*)(ws + WS_WDA), FF); } while (0)
    if (IN(2)) { PH2_BODY; DUP_PH(2, PH2_BODY;); DUP_SEL(MK_REP_GEMM)(PH2_BODY;) SEAM(2); }
#define PH3_BODY do { ln_phase(Z, P.in[7], P.in[8], nullptr, XNB, (const float*)(ws + WS_PART), FF / 256, P.in[1], nullptr, ALPHA, 0.5f, gw, NGW, lane); } while (0)
    if (IN(3)) { PH3_BODY; DUP_PH(3, PH3_BODY;); DUP_SEL(MK_REP_EW)(PH3_BODY;) SEAM(3); }
#define PH4_BODY do {    \
        pg8::Gemm g{XNB, (const bf16*)(ws + WS_WIN), M, INP, DM}; pg8::StaticOrder S; S.init(M, INP, G, bx); \
        pg8::EpiF32 E{(float*)(ws + WS_PROJ), INP}; \
        pg8::gemm_phase<pg8::EpiF32, pg8::StaticOrder, true, true>(lds + RING_OFF, g, S, E); } while (0)
    if (IN(4)) { PH4_BODY; DUP_PH(4, PH4_BODY;); DUP_SEL(MK_REP_GEMM)(PH4_BODY;) SEAM(4); }
#define PH5_BODY do { prep_a(P, gw, NGW, lane); } while (0)
    if (IN(5)) { PH5_BODY; DUP_PH(5, PH5_BODY;); DUP_SEL(MK_REP_EW)(PH5_BODY;) SEAM(5); }
#define PH6_BODY do {    \
        int k256 = 256; asm volatile("" : "+s"(k256));           \
        { pg8::Gemm g{(const bf16*)(ws + WS_CQN), (const bf16*)(ws + WS_WQ), M, 1280, k256}; pg8::StaticOrder S; S.init(M, 1280, G, bx); \
          pg8::EpiQ E{(bf16*)(ws + WS_QB), cosT, sinT, QSCALE}; \
          pg8::gemm_phase<pg8::EpiQ, pg8::StaticOrder, true, true>(lds + RING_OFF, g, S, E); } \
        { pg8::Gemm g{(const bf16*)(ws + WS_LA), (const bf16*)(ws + WS_WL), M, 1536, k256}; pg8::StaticOrder S; S.init(M, 1536, G, bx); \
          pg8::EpiF32 E{(float*)(ws + WS_LO), 1536}; \
          pg8::gemm_phase<pg8::EpiF32, pg8::StaticOrder, true, true>(lds + RING_OFF, g, S, E); } \
        } while (0)
    if (IN(6)) { PH6_BODY; DUP_PH(6, PH6_BODY;); DUP_SEL(MK_REP_GEMM)(PH6_BODY;) SEAM(6); }
#define PH7_BODY do { prep_c(P, gw, NGW, lane); cs::chunk_prep((const float*)(ws + WS_PROJ), P.in[18], (const float*)(ws + WS_LO), P.in[19], P.in[21], P.in[24], P.in[25], P.in[26], (float*)(ws + WS_SCAL), ws + WS_OPS, (float*)(ws + WS_G15), lds, gw, NGW, wave, lane); } while (0)
    if (IN(7)) { PH7_BODY; DUP_PH(7, PH7_BODY;); DUP_SEL(MK_REP_EW)(PH7_BODY;) SEAM(7); }
    if (IN(8)) { mixer_phase<0, 0>(P, lds, MISC, ctl, tid, wave, lane); DUP_SEL(MK_REP_MIX)(mixer_phase<MK_DUP_MODE, MK_DUP_VAR>(P, lds, MISC, ctl + 128, tid, wave, lane);) SEAM(8); }
#define PH9_BODY do { post_phase(P, gw, NGW, lane); } while (0)
    if (IN(9)) { PH9_BODY; DUP_PH(9, PH9_BODY;); DUP_SEL(MK_REP_EW)(PH9_BODY;) SEAM(9); }
#define PH10_BODY do {   \
        { pg8::Gemm g{(const bf16*)(ws + WS_OM), (const bf16*)(ws + WS_WO), MP, DM, 1536, 0}; pg8::StaticOrder S; S.init(MP, DM, G, bx); \
          pg8::EpiResidB E{XNB, Z, DM, ALPHA, 1.0f}; \
          pg8::gemm_phase<pg8::EpiResidB, pg8::StaticOrder, true, true>(lds + RING_OFF, g, S, E); } \
        SPLIT_BODY((const bf16*)(ws + WS_OM), (const bf16*)(ws + WS_WO), 1536); } while (0)
    if (IN(10)) { PH10_BODY; DUP_PH(10, PH10_BODY;); DUP_SEL(MK_REP_GEMM)(PH10_BODY;) SEAM(10); }
#define PH11_BODY do { ln_phase(Z, P.in[30], P.in[31], nullptr, XNB, (const float*)(ws + WS_PART), 1536 / 256, nullptr, XNB + (size_t)MP * DM, ALPHA, 1.0f, gw, NGW, lane); } while (0)
    if (IN(11)) { PH11_BODY; DUP_PH(11, PH11_BODY;); DUP_SEL(MK_REP_EW)(PH11_BODY;) SEAM(11); }
#define PH12_BODY do {   \
        pg8::Gemm g{XNB, (const bf16*)(ws + WS_WGUB), M, 2 * FF, DM}; pg8::StaticOrder S; S.init(M, 2 * FF, G, bx); \
        pg8::EpiSwiGLU E{HB, FF}; \
        pg8::gemm_phase<pg8::EpiSwiGLU, pg8::StaticOrder, true, true>(lds + RING_OFF, g, S, E); } while (0)
    if (IN(12)) { PH12_BODY; DUP_PH(12, PH12_BODY;); DUP_SEL(MK_REP_GEMM)(PH12_BODY;) SEAM(12); }
#define PH13_BODY do {   \
        { pg8::Gemm g{HB, (const bf16*)(ws + WS_WDB), MP, DM, FF, 0}; pg8::StaticOrder S; S.init(MP, DM, G, bx); \
          pg8::EpiResidB E{XNB, Z, DM, ALPHA, 0.5f}; \
          pg8::gemm_phase<pg8::EpiResidB, pg8::StaticOrder, true, true>(lds + RING_OFF, g, S, E); } \
        SPLIT_BODY(HB, (const bf16*)(ws + WS_WDB), FF); } while (0)
    if (IN(13)) { PH13_BODY; DUP_PH(13, PH13_BODY;); DUP_SEL(MK_REP_GEMM)(PH13_BODY;) SEAM(13); }
#define PH14_BODY do { ln_phase(Z, P.in[35], P.in[36], P.out + O_YP, nullptr, (const float*)(ws + WS_PART), FF / 256, nullptr, XNB + (size_t)MP * DM, ALPHA, 0.5f, gw, NGW, lane); } while (0)
    if (IN(14)) { PH14_BODY; DUP_PH(14, PH14_BODY;); DUP_SEL(MK_REP_EW)(PH14_BODY;) }
#undef IN
#undef SEAM
#undef P
}

#ifndef MK_PER_PHASE
#define MK_PER_PHASE 0
#endif
extern "C" void kernel_launch(void* const* d_in, const int* in_sizes, int n_in, void* d_out, int out_size, void* d_ws, size_t ws_size, hipStream_t stream) {
    static int grid = 0;
    if (grid == 0) {
        if (n_in != 37 || (size_t)out_size != O_END || ws_size < WS_END) { fprintf(stderr, "kernel_launch: unexpected shapes: n_in %d out %d ws %zu\n", n_in, out_size, ws_size); grid = -1; return; }
        int dev = 0, cus = 0, per_cu = 0;
        if (hipGetDevice(&dev) != hipSuccess || hipDeviceGetAttribute(&cus, hipDeviceAttributeMultiprocessorCount, dev) != hipSuccess) { grid = -1; return; }
        if (hipFuncSetAttribute((const void*)mk_fwd, hipFuncAttributeMaxDynamicSharedMemorySize, LDS_BYTES) != hipSuccess) { fprintf(stderr, "kernel_launch: hipFuncSetAttribute failed\n"); grid = -1; return; }
        if (hipOccupancyMaxActiveBlocksPerMultiprocessor(&per_cu, (const void*)mk_fwd, NWAVES * 64, LDS_BYTES) != hipSuccess || per_cu < 1) { fprintf(stderr, "kernel_launch: occupancy query says %d\n", per_cu); }
        (void)hipGetLastError();
        grid = cus;
    }
    if (grid < 0) return;
    if (hipMemsetAsync((char*)d_ws + WS_CTL, 0, CTL_ZERO_BYTES, stream) != hipSuccess) return;
    Args a{};
    for (int i = 0; i < 37; ++i) a.in[i] = (const float*)d_in[i];
    a.out = (float*)d_out; a.ws = (unsigned char*)d_ws;
#if MK_PER_PHASE
    for (int p = 0; p < N_PHASES; ++p) { a.ph_lo = p; a.ph_hi = p + 1; hipLaunchKernelGGL(mk_fwd, dim3(grid), dim3(NWAVES * 64), LDS_BYTES, stream, a); }
#else
    a.ph_lo = 0; a.ph_hi = N_PHASES;
    hipLaunchKernelGGL(mk_fwd, dim3(grid), dim3(NWAVES * 64), LDS_BYTES, stream, a);
#endif
    const hipError_t le = hipPeekAtLastError();
    if (le != hipSuccess) fprintf(stderr, "kernel_launch: launch failed: %s\n", hipGetErrorName(le));
}
```
